# Optimizing an MI355X kernel written in HIP

```python
import math
import jax
import jax.numpy as jnp
from jax import lax
import numpy as np

D_MODEL = 1024
BATCH = 2
SEQ = 16384
DEPTH = 4

HEAD_DIM = 64
SB_HEADS = 4
GLA_HEADS = 4
GLA_KEY_DIM = 32
GLA_VAL_DIM = 64
GLA_LOW_RANK = 16
GLA_GATE_NORM = 16.0
GLA_CHUNK = 16
DN_HEADS = 4
DN_CONV = 4
DN_CHUNK = 64
DIL_HEADS = 4
DIL_PATTERNS = ((128, 1), (512, 4), (2048, 16))
DIL_BLOCK = 128
SB_BLOCK = 128
N_BRANCH = 4
BRANCH_WIDTH = 4 * HEAD_DIM
ROPE_THETA = 500000.0
ROT_DIM = HEAD_DIM // 4
D_FF = 4 * D_MODEL
EPS = 1e-6

IN_SIZES = (
    SB_HEADS * HEAD_DIM, SB_HEADS * HEAD_DIM, SB_HEADS * HEAD_DIM,
    GLA_HEADS * GLA_KEY_DIM, GLA_HEADS * GLA_KEY_DIM, GLA_HEADS * GLA_VAL_DIM, GLA_LOW_RANK, GLA_HEADS * GLA_VAL_DIM,
    3 * DN_HEADS * HEAD_DIM, DN_HEADS, DN_HEADS, DN_HEADS * HEAD_DIM,
    DIL_HEADS * HEAD_DIM, DIL_HEADS * HEAD_DIM, DIL_HEADS * HEAD_DIM,
    N_BRANCH * D_MODEL,
)
N_IN = sum(IN_SIZES)
IN_OFFSETS = tuple(int(o) for o in np.cumsum(IN_SIZES)[:-1])

kernel_name = 'hybrid_sb_gla_gdn_dilated_trunk'


def rms_norm(x, g):
    xf = x.astype(jnp.float32)
    y = xf * lax.rsqrt(jnp.mean(xf * xf, axis=-1, keepdims=True) + EPS)
    return (y * g.astype(jnp.float32)).astype(x.dtype)


def l2norm(x):
    xf = x.astype(jnp.float32)
    return xf * lax.rsqrt(jnp.sum(xf * xf, axis=-1, keepdims=True) + EPS)


def rope_partial(x, pos):
    half = ROT_DIM // 2
    inv_freq = ROPE_THETA ** (-jnp.arange(half, dtype=jnp.float32) / half)
    ang = pos.astype(jnp.float32)[:, None] * inv_freq[None, :]
    cos = jnp.cos(ang)[None, :, None, :]
    sin = jnp.sin(ang)[None, :, None, :]
    x1 = x[..., :half].astype(jnp.float32)
    x2 = x[..., half:ROT_DIM].astype(jnp.float32)
    rot = jnp.concatenate([x1 * cos - x2 * sin, x2 * cos + x1 * sin], axis=-1).astype(x.dtype)
    return jnp.concatenate([rot, x[..., ROT_DIM:]], axis=-1)


def _chunk(t, c):
    B, S = t.shape[:2]
    t = t.reshape(B, S // c, c, *t.shape[2:]).astype(jnp.float32)
    return jnp.moveaxis(t, [1, 3], [0, 2])


def _unchunk(t):
    nc, B, H, c, d = t.shape
    return jnp.moveaxis(t, [0, 2], [1, 3]).reshape(B, nc * c, H, d)


def causal_conv(x, w):
    K = w.shape[-1]
    rhs = w.T[:, None, :].astype(x.dtype)
    return lax.conv_general_dilated(x, rhs, window_strides=(1,), padding=[(K - 1, 0)],
                                    dimension_numbers=('NWC', 'WIO', 'NWC'), feature_group_count=x.shape[-1])


def stick_breaking_attention(q, k, v):
    B, S, H, dh = q.shape
    nb = S // SB_BLOCK
    scale = dh ** -0.5

    def blocks(t):
        return t.reshape(B, nb, SB_BLOCK, H, dh).transpose(1, 0, 3, 2, 4)

    qb, kb, vb = blocks(q), blocks(k), blocks(v)
    pq_np, pk_np = np.tril_indices(nb)
    pq = jnp.asarray(pq_np, dtype=jnp.int32)
    pk = jnp.asarray(pk_np, dtype=jnp.int32)
    r_idx = jnp.arange(SB_BLOCK, dtype=jnp.int32)
    later = (r_idx[:, None] > r_idx[None, :]).astype(jnp.float32)

    def pair(args):
        i, j = args
        z = jnp.einsum('bhqc,bhkc->bhqk', qb[i], kb[j]).astype(jnp.float32) * scale
        causal = (j * SB_BLOCK + r_idx)[None, :] < (i * SB_BLOCK + r_idx)[:, None]
        z = jnp.where(causal, z, -jnp.inf)
        sp = jax.nn.softplus(z)
        between = -jnp.einsum('bhqk,kc->bhqc', sp, later)
        w = jnp.exp(z - sp + between)
        o = jnp.einsum('bhqk,bhkc->bhqc', w, vb[j].astype(jnp.float32))
        return o, -jnp.sum(sp, axis=-1)

    o_all, r_all = lax.map(pair, (pq, pk))
    R = jnp.zeros((nb, nb, B, H, SB_BLOCK), jnp.float32).at[pq, pk].set(r_all)
    later_blocks = lax.cumsum(R, axis=1, reverse=True) - R
    factor = jnp.exp(later_blocks[pq, pk])
    out = jax.ops.segment_sum(factor[..., None] * o_all, pq, num_segments=nb)
    return out.transpose(1, 0, 3, 2, 4).reshape(B, S, H, dh).astype(v.dtype)


def gla_chunked(q, k, v, log_a):
    B, S, H, dk = q.shape
    dv = v.shape[-1]
    c = GLA_CHUNK
    qc, kc, vc = _chunk(q, c), _chunk(k, c), _chunk(v, c)
    b = jnp.cumsum(_chunk(log_a, c), axis=-2)
    causal = jnp.tril(jnp.ones((c, c), dtype=bool))
    decay = jnp.exp(jnp.where(causal[:, :, None], b[..., :, None, :] - b[..., None, :, :], -jnp.inf))
    scores = jnp.einsum('nbhic,nbhjc,nbhijc->nbhij', qc, kc, decay)
    o_intra = jnp.einsum('nbhij,nbhjd->nbhid', scores, vc)
    q_in = qc * jnp.exp(b)
    k_up = kc * jnp.exp(b[..., -1:, :] - b)
    a_last = jnp.exp(b[..., -1, :])

    def step(state, inp):
        q_i, k_i, v_i, a_i = inp
        o_i = jnp.einsum('bhic,bhcd->bhid', q_i, state)
        state = a_i[..., None] * state + jnp.einsum('bhic,bhid->bhcd', k_i, v_i)
        return state, o_i

    _, o_inter = lax.scan(step, jnp.zeros((B, H, dk, dv), jnp.float32), (q_in, k_up, vc, a_last))
    return _unchunk(o_intra + o_inter).astype(v.dtype)


def gla_branch(q, k, v, lr, r, w_lr2, b_lr, norm_g):
    B, S, H, dk = q.shape
    log_a = jax.nn.log_sigmoid((lr @ w_lr2 + b_lr).astype(jnp.float32)) / GLA_GATE_NORM
    o = gla_chunked(q * dk ** -0.5, k, v, log_a.reshape(B, S, H, dk))
    return rms_norm(o, norm_g) * jax.nn.silu(r)


def gated_delta_chunked(q, k, v, g, beta):
    B, S, H, dk = q.shape
    dv = v.shape[-1]
    c = DN_CHUNK
    qc, kc, vc = _chunk(q, c), _chunk(k, c), _chunk(v, c)
    bc = _chunk(beta, c)
    G = jnp.cumsum(_chunk(g, c), axis=-1)
    incl = jnp.tril(jnp.ones((c, c), dtype=bool))
    strict = jnp.tril(jnp.ones((c, c), dtype=bool), -1)
    decay = jnp.exp(jnp.where(incl, G[..., :, None] - G[..., None, :], -jnp.inf))
    kb = kc * bc[..., None]
    lower = jnp.where(strict, jnp.einsum('nbhic,nbhjc->nbhij', kb, kc) * decay, 0.0)
    rhs = jnp.concatenate([vc * bc[..., None], kb * jnp.exp(G)[..., None]], axis=-1)
    sol = lax.linalg.triangular_solve(jnp.eye(c, dtype=jnp.float32) + lower, rhs,
                                      left_side=True, lower=True, unit_diagonal=True)
    u, w = sol[..., :dv], sol[..., dv:]
    scores = jnp.where(incl, jnp.einsum('nbhic,nbhjc->nbhij', qc, kc) * decay, 0.0)
    q_in = qc * jnp.exp(G)[..., None]
    k_up = kc * jnp.exp(G[..., -1:] - G)[..., None]
    a_last = jnp.exp(G[..., -1])

    def step(state, inp):
        q_i, k_i, u_i, w_i, s_i, a_i = inp
        v_new = u_i - jnp.einsum('bhic,bhcd->bhid', w_i, state)
        o_i = jnp.einsum('bhic,bhcd->bhid', q_i, state) + jnp.einsum('bhij,bhjd->bhid', s_i, v_new)
        state = a_i[..., None, None] * state + jnp.einsum('bhic,bhid->bhcd', k_i, v_new)
        return state, o_i

    _, o = lax.scan(step, jnp.zeros((B, H, dk, dv), jnp.float32), (q_in, k_up, u, w, scores, a_last))
    return _unchunk(o).astype(v.dtype)


def deltanet_branch(qkv, a, b, gate, conv_w, a_log, dt_bias, norm_g):
    B, S, _ = qkv.shape
    qkv = jax.nn.silu(causal_conv(qkv, conv_w))
    q, k, v = [t.reshape(B, S, DN_HEADS, HEAD_DIM) for t in jnp.split(qkv, 3, axis=-1)]
    q = l2norm(q) * HEAD_DIM ** -0.5
    k = l2norm(k)
    beta = jax.nn.sigmoid(b.astype(jnp.float32))
    g = -jnp.exp(a_log.astype(jnp.float32)) * jax.nn.softplus(a.astype(jnp.float32) + dt_bias.astype(jnp.float32))
    o = gated_delta_chunked(q, k, v, g, beta)
    return rms_norm(o, norm_g) * jax.nn.silu(gate)


def dilated_pattern(q, k, v, dil, n_keys):
    B, S, H, dh = q.shape
    L = S // dil
    nb = -(-L // DIL_BLOCK)
    Lp = nb * DIL_BLOCK

    def strided(t):
        t = t.reshape(B, L, dil, H, dh).transpose(0, 2, 3, 1, 4)
        t = jnp.pad(t, ((0, 0), (0, 0), (0, 0), (0, Lp - L), (0, 0)))
        return t.reshape(B, dil, H, nb, DIL_BLOCK, dh)

    def with_prev(t):
        prev = jnp.pad(t[:, :, :, :-1], ((0, 0), (0, 0), (0, 0), (1, 0), (0, 0), (0, 0)))
        return jnp.concatenate([prev, t], axis=-2)

    qs = strided(q)
    kk = with_prev(strided(k))
    vv = with_prev(strided(v)).astype(jnp.float32)
    s = jnp.einsum('brhnqc,brhnkc->brhnqk', qs, kk).astype(jnp.float32) * HEAD_DIM ** -0.5
    qi = jnp.arange(DIL_BLOCK)[:, None]
    kj = jnp.arange(2 * DIL_BLOCK)[None, :]
    m = qi + DIL_BLOCK - kj
    key_n = jnp.arange(nb)[:, None, None] * DIL_BLOCK - DIL_BLOCK + kj[None]
    valid = (m >= 0) & (m <= n_keys) & (key_n >= 0)
    s = jnp.where(valid, s, -jnp.inf)
    mx = jnp.max(s, axis=-1)
    p = jnp.exp(s - mx[..., None])
    den = jnp.sum(p, axis=-1)
    num = jnp.einsum('brhnqk,brhnkc->brhnqc', p, vv)

    def unstrided(t):
        t = t.reshape(B, dil, H, Lp, *t.shape[5:])[:, :, :, :L]
        t = jnp.moveaxis(t, 3, 1)
        return t.reshape(B, S, H, *t.shape[4:])

    return unstrided(mx), unstrided(den), unstrided(num)


def dilated_branch(q, k, v, q_g, k_g):
    S = q.shape[1]
    pos = jnp.arange(S, dtype=jnp.int32)
    q = rope_partial(rms_norm(q, q_g), pos)
    k = rope_partial(rms_norm(k, k_g), pos)
    stats = [dilated_pattern(q, k, v, dil, window // dil) for window, dil in DIL_PATTERNS]
    mx = jnp.stack([st[0] for st in stats])
    den = jnp.stack([st[1] for st in stats])
    num = jnp.stack([st[2] for st in stats])
    w = jnp.exp(mx - jnp.max(mx, axis=0, keepdims=True))
    out = jnp.sum(w[..., None] * num, axis=0) / jnp.sum(w * den, axis=0)[..., None]
    return out.astype(v.dtype)


def hybrid_layer(x, g_mix, g_mlp, w_in, gla_w_lr2, gla_b_lr, gla_norm_g, dn_conv_w, dn_a_log, dn_dt_bias,
                 dn_norm_g, dil_q_g, dil_k_g, w_branch, w_out, w_mlp_in, w_mlp_out):
    B, S, _ = x.shape
    h = rms_norm(x, g_mix)
    (sb_q, sb_k, sb_v, gla_q, gla_k, gla_v, gla_lr, gla_r, dn_qkv, dn_a, dn_b, dn_gate,
     dil_q, dil_k, dil_v, gate_logits) = jnp.split(h @ w_in, IN_OFFSETS, axis=-1)

    def heads(t, n):
        return t.reshape(B, S, n, -1)

    o_sb = stick_breaking_attention(heads(sb_q, SB_HEADS), heads(sb_k, SB_HEADS), heads(sb_v, SB_HEADS))
    o_gla = gla_branch(heads(gla_q, GLA_HEADS), heads(gla_k, GLA_HEADS), heads(gla_v, GLA_HEADS), gla_lr,
                       heads(gla_r, GLA_HEADS), gla_w_lr2, gla_b_lr, gla_norm_g)
    o_dn = deltanet_branch(dn_qkv, dn_a, dn_b, heads(dn_gate, DN_HEADS), dn_conv_w, dn_a_log, dn_dt_bias, dn_norm_g)
    o_dil = dilated_branch(heads(dil_q, DIL_HEADS), heads(dil_k, DIL_HEADS), heads(dil_v, DIL_HEADS), dil_q_g, dil_k_g)

    gates = jax.nn.sigmoid(gate_logits.reshape(B, S, N_BRANCH, D_MODEL))
    merged = jnp.zeros_like(x)
    for n, o in enumerate((o_sb, o_gla, o_dn, o_dil)):
        merged = merged + gates[:, :, n] * (o.reshape(B, S, BRANCH_WIDTH) @ w_branch[n])
    x = x + merged @ w_out
    h = rms_norm(x, g_mlp)
    return x + jnp.square(jax.nn.relu(h @ w_mlp_in)) @ w_mlp_out


def setup_inputs(seed: int = 0) -> dict:
    key = jax.random.key(seed)
    ks = jax.random.split(key, 18)
    f32 = jnp.float32

    def nrm(k, shape, scale):
        return scale * jax.random.normal(k, shape, f32)

    dt = jnp.exp(jax.random.uniform(ks[8], (DEPTH, DN_HEADS), f32, math.log(1e-3), math.log(1e-1)))
    return {
        'x': jax.random.normal(ks[0], (BATCH, SEQ, D_MODEL), f32),
        'norm_mix_g': 1.0 + nrm(ks[1], (DEPTH, D_MODEL), 0.02),
        'norm_mlp_g': 1.0 + nrm(ks[2], (DEPTH, D_MODEL), 0.02),
        'w_in': nrm(ks[3], (DEPTH, D_MODEL, N_IN), D_MODEL ** -0.5),
        'gla_w_lr2': nrm(ks[4], (DEPTH, GLA_LOW_RANK, GLA_HEADS * GLA_KEY_DIM), GLA_LOW_RANK ** -0.5),
        'gla_b_lr': nrm(ks[5], (DEPTH, GLA_HEADS * GLA_KEY_DIM), 0.1),
        'gla_norm_g': 1.0 + nrm(ks[6], (DEPTH, GLA_VAL_DIM), 0.02),
        'dn_conv_w': nrm(ks[7], (DEPTH, 3 * DN_HEADS * HEAD_DIM, DN_CONV), DN_CONV ** -0.5),
        'dn_a_log': jnp.log(jax.random.uniform(ks[9], (DEPTH, DN_HEADS), f32, 1.0, 16.0)),
        'dn_dt_bias': dt + jnp.log(-jnp.expm1(-dt)),
        'dn_norm_g': 1.0 + nrm(ks[10], (DEPTH, HEAD_DIM), 0.02),
        'dil_q_norm_g': 1.0 + nrm(ks[11], (DEPTH, HEAD_DIM), 0.02),
        'dil_k_norm_g': 1.0 + nrm(ks[12], (DEPTH, HEAD_DIM), 0.02),
        'w_branch': nrm(ks[13], (DEPTH, N_BRANCH, BRANCH_WIDTH, D_MODEL), BRANCH_WIDTH ** -0.5),
        'w_out': nrm(ks[14], (DEPTH, D_MODEL, D_MODEL), D_MODEL ** -0.5),
        'w_mlp_in': nrm(ks[15], (DEPTH, D_MODEL, D_FF), D_MODEL ** -0.5),
        'w_mlp_out': nrm(ks[16], (DEPTH, D_FF, D_MODEL), 0.5 * D_FF ** -0.5),
    }


def reference(x, norm_mix_g, norm_mlp_g, w_in, gla_w_lr2, gla_b_lr, gla_norm_g, dn_conv_w, dn_a_log, dn_dt_bias,
              dn_norm_g, dil_q_norm_g, dil_k_norm_g, w_branch, w_out, w_mlp_in, w_mlp_out):
    for l in range(DEPTH):
        x = hybrid_layer(x, norm_mix_g[l], norm_mlp_g[l], w_in[l], gla_w_lr2[l], gla_b_lr[l], gla_norm_g[l],
                         dn_conv_w[l], dn_a_log[l], dn_dt_bias[l], dn_norm_g[l], dil_q_norm_g[l], dil_k_norm_g[l],
                         w_branch[l], w_out[l], w_mlp_in[l], w_mlp_out[l])
    return x
```

```cpp
#include <hip/hip_runtime.h>
#include <hip/hip_cooperative_groups.h>
#include <cstdio>
namespace cg = cooperative_groups;

#define LAS __attribute__((address_space(3)))
typedef unsigned short bf16_t;
typedef short bf16x8 __attribute__((ext_vector_type(8)));
typedef short bf16x4 __attribute__((ext_vector_type(4)));
typedef float f32x4 __attribute__((ext_vector_type(4)));
typedef unsigned u32x4 __attribute__((ext_vector_type(4)));
typedef unsigned u32x2 __attribute__((ext_vector_type(2)));

constexpr int T_TOK = 32768, SEQ = 16384, DM = 1024, NP = 3584, DFF = 4096;
constexpr int C_SBQ = 0, C_SBK = 256, C_SBV = 512, C_GQ = 768, C_GK = 896, C_GV = 1024, C_GLR = 1280, C_GR = 1296, C_DQKV = 1552, C_DA = 2320, C_DB = 2324,
              C_DG = 2328, C_LQ = 2584, C_LK = 2840, C_LV = 3096, C_GATE = 3352, N_IN = 7448;
constexpr int O_SB = 0, O_GLA = 256, O_DN = 512, O_DIL = 768;
constexpr float EPS = 1e-6f;
constexpr int NLAYER = 4, NPH = 11;
constexpr size_t SZ_WIN = (size_t)NP * DM * 2, SZ_WG = (size_t)4096 * DM * 2, SZ_WB = (size_t)4096 * 256 * 2, SZ_WO = (size_t)DM * DM * 2, SZ_W1 = (size_t)DFF * DM * 2, SZ_W2 = (size_t)DM * DFF * 2;
constexpr size_t OFF_WIN = 0, OFF_WG = OFF_WIN + SZ_WIN, OFF_WB = OFF_WG + SZ_WG, OFF_WO = OFF_WB + SZ_WB, OFF_W1 = OFF_WO + SZ_WO, OFF_W2 = OFF_W1 + SZ_W1;
constexpr size_t OFF_B = OFF_W2 + SZ_W2;
constexpr size_t SZ_B = (size_t)T_TOK * 4096 * 2;
constexpr size_t OFF_GLAU = OFF_B + (size_t)T_TOK * NP * 2;
constexpr size_t OFF_GLAA = OFF_GLAU + (size_t)2048 * 2048 * 4;
constexpr size_t OFF_DSTAT = OFF_GLAA + (size_t)2048 * 32 * 4;
constexpr size_t OFF_DNA = OFF_DSTAT + (size_t)T_TOK * 4 * 2 * 4;
constexpr size_t OFF_H = OFF_B + SZ_B;
constexpr size_t OFF_O = OFF_H + (size_t)T_TOK * DM * 2;
constexpr size_t OFF_DN = OFF_O + (size_t)T_TOK * DM * 2;
constexpr size_t OFF_CNT = OFF_DN + (size_t)2048 * 5 * 8192;
constexpr size_t OFF_BAR = OFF_CNT + 256;
constexpr size_t WS_END = OFF_BAR + 16384;
static_assert(OFF_DNA + 2048 * 4 <= OFF_H, "region B overflow");
constexpr int LDS_BYTES = 131072, LDS_TOTAL = LDS_BYTES + 64;

struct Params {
    const float* x; const float* g_mix; const float* g_mlp; const float* w_in; const float* gla_w_lr2; const float* gla_b_lr; const float* gla_norm_g;
    const float* dn_conv_w; const float* dn_a_log; const float* dn_dt_bias; const float* dn_norm_g; const float* dil_q_g; const float* dil_k_g;
    const float* w_branch; const float* w_out; const float* w_mlp_in; const float* w_mlp_out;
    float* out; unsigned char* ws; int ph_lo, ph_hi;
};

typedef __bf16 bf16v2_t __attribute__((ext_vector_type(2)));
typedef float f32v2_t __attribute__((ext_vector_type(2)));
__device__ __forceinline__ unsigned pk2(float lo, float hi) { f32v2_t v = {lo, hi}; bf16v2_t b = __builtin_convertvector(v, bf16v2_t); return __builtin_bit_cast(unsigned, b); }
__device__ __forceinline__ float bf2f(bf16_t b) { return __uint_as_float(((unsigned)b) << 16); }
__device__ __forceinline__ float bflo(unsigned u) { return __uint_as_float(u << 16); }
__device__ __forceinline__ float bfhi(unsigned u) { return __uint_as_float(u & 0xffff0000u); }
__device__ __forceinline__ bf16_t f2bf(float f) { return (bf16_t)(pk2(f, 0.f) & 0xffffu); }
__device__ __forceinline__ float wave_sum(float v) {
#pragma unroll
    for (int o = 1; o < 64; o <<= 1) v += __shfl_xor(v, o);
    return v;
}
__device__ __forceinline__ float sigmoidf_(float x) { return 1.f / (1.f + __expf(-x)); }
__device__ __forceinline__ float sigmoid_fast(float x) { return __builtin_amdgcn_rcpf(1.f + __expf(-x)); }
__device__ __forceinline__ float softplusf_(float z) { return fmaxf(z, 0.f) + __logf(1.f + __expf(-fabsf(z))); }
__device__ __forceinline__ bf16x8 mk8(u32x2 a, u32x2 b) { u32x4 t; t.x = a.x; t.y = a.y; t.z = b.x; t.w = b.y; return __builtin_bit_cast(bf16x8, t); }
__device__ __forceinline__ bf16x8 pk8(f32x4 a, f32x4 b) { u32x4 t; t.x = pk2(a[0], a[1]); t.y = pk2(a[2], a[3]); t.z = pk2(b[0], b[1]); t.w = pk2(b[2], b[3]); return __builtin_bit_cast(bf16x8, t); }
__device__ __forceinline__ int tid_opaque() { int t = (int)threadIdx.x; asm volatile("" : "+v"(t)); return t; }
#define TIDX tid_opaque()
#define MFMA16(a, b, c) __builtin_amdgcn_mfma_f32_16x16x32_bf16((a), (b), (c), 0, 0, 0)

namespace pg8 {
constexpr int BM = 256, BK = 64, HALF = 128, HTB = HALF * BK * 2, NXCD = 8, WGM = 8;
__device__ __forceinline__ int lds_byte(int r, int c) { const int st = (r >> 4) * 2 + (c >> 5), rr = r & 15, cc = c & 31, ob = rr * 64 + cc * 2; return st * 1024 + (ob ^ (((ob >> 9) & 1) << 5)); }
__device__ __forceinline__ void stage_rc(int b, int& R, int& C) { const int st = b / 1024, sb = b % 1024, swz = sb ^ (((sb >> 9) & 1) << 5); R = (st >> 1) * 16 + swz / 64; C = (st & 1) * 32 + (swz % 64) / 2; }
__device__ __forceinline__ int perm32(int rho) { const int n = rho >> 4, i = rho & 15; return 8 * (i >> 2) + 4 * n + (i & 3); }
struct Unit { int pm, pn; };
struct Gemm { const bf16_t* A; const bf16_t* Bt; int M, N, K, lda, a_sh, a_mul; };
struct StaticOrder {
    int nM, nN, nwg, G, c;
    __device__ void init(int M, int N, int G_, int c_) { nM = M / BM; nN = N / BM; nwg = nM * nN; G = G_; c = c_; }
    __device__ bool next(int i, Unit& u) const {
        const long L = (long)i * G + c; if (L >= nwg) return false;
        int wgid = (int)L; { const int q = nwg / NXCD, r = nwg % NXCD, xcd = wgid % NXCD, off = wgid / NXCD; wgid = (xcd < r ? xcd * (q + 1) : r * (q + 1) + (xcd - r) * q) + off; }
        const int nig = WGM * nN, gid = wgid / nig, fm = gid * WGM, gsz = (nM - fm) < WGM ? (nM - fm) : WGM;
        u.pm = fm + ((wgid % nig) % gsz); u.pn = (wgid % nig) / gsz; return true;
    }
};
struct Epi {
    int mode; bf16_t* O; int ldc; const float* Xin; float* Xout; const bf16_t* Y;
    __device__ __forceinline__ void operator()(const f32x4 (&acc)[2][2][4][2], const Unit& u, int wr, int wc, int fr, int fq) const {
        const int row0 = u.pm * BM + wr * 64 + fr;
        if (mode < 2) {
            const int col0 = u.pn * BM + wc * 32 + 8 * fq;
#pragma unroll
            for (int ai = 0; ai < 2; ++ai)
#pragma unroll
                for (int m = 0; m < 4; ++m) { bf16_t* rowp = O + (size_t)(row0 + ai * HALF + m * 16) * ldc + col0;
#pragma unroll
                    for (int bj = 0; bj < 2; ++bj) { f32x4 v0 = acc[ai][bj][m][0], v1 = acc[ai][bj][m][1];
                        if (mode == 1) {
#pragma unroll
                            for (int j = 0; j < 4; ++j) { float a = fmaxf(v0[j], 0.f), b = fmaxf(v1[j], 0.f); v0[j] = a * a; v1[j] = b * b; } }
                        u32x4 o; o.x = pk2(v0[0], v0[1]); o.y = pk2(v0[2], v0[3]); o.z = pk2(v1[0], v1[1]); o.w = pk2(v1[2], v1[3]);
                        *(u32x4*)(rowp + bj * HALF) = o; } }
        } else if (mode == 2) {
            const int col0 = u.pn * BM + wc * 32 + 4 * fq;
#pragma unroll
            for (int ai = 0; ai < 2; ++ai) { f32x4 xi[4][2][2];
#pragma unroll
                for (int m = 0; m < 4; ++m) { const size_t ro = (size_t)(row0 + ai * HALF + m * 16) * DM + col0;
#pragma unroll
                    for (int bj = 0; bj < 2; ++bj)
#pragma unroll
                        for (int n = 0; n < 2; ++n) xi[m][bj][n] = *(const f32x4*)(Xin + ro + bj * HALF + n * 16); }
                __builtin_amdgcn_sched_barrier(0);
#pragma unroll
                for (int m = 0; m < 4; ++m) { const size_t ro = (size_t)(row0 + ai * HALF + m * 16) * DM + col0;
#pragma unroll
                    for (int bj = 0; bj < 2; ++bj)
#pragma unroll
                        for (int n = 0; n < 2; ++n) *(f32x4*)(Xout + ro + bj * HALF + n * 16) = xi[m][bj][n] + acc[ai][bj][m][n]; }
                __builtin_amdgcn_sched_barrier(0); }
        } else {
            const int ch0 = u.pn * 64 + wc * 16 + 4 * fq;
#pragma unroll
            for (int ai = 0; ai < 2; ++ai) { u32x2 y[4][2][2];
#pragma unroll
                for (int m = 0; m < 4; ++m) { const size_t row = (size_t)(row0 + ai * HALF + m * 16);
#pragma unroll
                    for (int bj = 0; bj < 2; ++bj)
#pragma unroll
                        for (int n = 0; n < 2; ++n) y[m][bj][n] = *(const u32x2*)(Y + row * 4096 + (2 * bj + n) * 1024 + ch0); }
                __builtin_amdgcn_sched_barrier(0);
#pragma unroll
                for (int m = 0; m < 4; ++m) { const size_t row = (size_t)(row0 + ai * HALF + m * 16); f32x4 s = {0.f, 0.f, 0.f, 0.f};
#pragma unroll
                    for (int bj = 0; bj < 2; ++bj)
#pragma unroll
                        for (int n = 0; n < 2; ++n) { const u32x2 yy = y[m][bj][n]; const f32x4 a = acc[ai][bj][m][n];
                            s[0] += sigmoid_fast(a[0]) * bflo(yy.x); s[1] += sigmoid_fast(a[1]) * bfhi(yy.x); s[2] += sigmoid_fast(a[2]) * bflo(yy.y); s[3] += sigmoid_fast(a[3]) * bfhi(yy.y); }
                    u32x2 o; o.x = pk2(s[0], s[1]); o.y = pk2(s[2], s[3]); *(u32x2*)(O + row * DM + ch0) = o; }
                __builtin_amdgcn_sched_barrier(0); }
        }
    }
};

__device__ __forceinline__ void gemm_phase(LAS unsigned char* lds, const Gemm g, const StaticOrder& S, const Epi& E) {
    const int tid = TIDX, wid = __builtin_amdgcn_readfirstlane(tid >> 6), lane = tid & 63, wr = wid >> 2, wc = wid & 3, fr = lane & 15, fq = lane >> 4;
    const int K = g.K, nt = K / BK, lda = g.lda;
    unsigned voffA[2], voffB[2];
#pragma unroll
    for (int i = 0; i < 2; ++i) { int R, C; stage_rc(tid * 16 + i * 8192, R, C); const int Rb = (E.mode < 2) ? ((R & ~31) + perm32(R & 31)) : R;
        voffA[i] = (unsigned)(R * lda + C) * 2u; voffB[i] = (unsigned)(Rb * K + C) * 2u; }
    const size_t kstep = (size_t)(BK * 2);
    const size_t hstepA = (size_t)HALF * lda * 2, hstepB = (size_t)HALF * K * 2;
    const size_t tstepA = 2 * hstepA, tstepB = 2 * hstepB;
    const unsigned ldsw = (unsigned)wid * 1024u;
    const int aoff = lds_byte(wr * 64 + fr, fq * 8), boff = lds_byte(wc * 32 + fr, fq * 8);
#define PG8_SA(b, h) (((b) * 2 + (h)) * HTB)
#define PG8_SB(b, h) ((4 + (b) * 2 + (h)) * HTB)
#define PG8_STAGE(bufoff, gbase, voff) do { _Pragma("unroll") for (int _i = 0; _i < 2; ++_i) \
        __builtin_amdgcn_global_load_lds((const unsigned*)((const char*)(gbase) + (voff)[_i]), (LAS unsigned*)(lds + (bufoff) + ldsw + _i * 8192), 16, 0, 0); } while (0)
#define PG8_LDA(dst, b, h) do { _Pragma("unroll") for (int m = 0; m < 4; ++m) _Pragma("unroll") for (int k = 0; k < 2; ++k) dst[m][k] = *(const LAS bf16x8*)(lds + PG8_SA(b, h) + aoff + m * 2048 + k * 1024); } while (0)
#define PG8_LDB(dst, b, h) do { _Pragma("unroll") for (int n = 0; n < 2; ++n) _Pragma("unroll") for (int k = 0; k < 2; ++k) dst[n][k] = *(const LAS bf16x8*)(lds + PG8_SB(b, h) + boff + n * 2048 + k * 1024); } while (0)
#define PG8_MMA(ai, bj, At, Bt) do { __builtin_amdgcn_s_setprio(1); _Pragma("unroll") for (int m = 0; m < 4; ++m) _Pragma("unroll") for (int n = 0; n < 2; ++n) _Pragma("unroll") for (int k = 0; k < 2; ++k) \
        acc[ai][bj][m][n] = __builtin_amdgcn_mfma_f32_16x16x32_bf16(Bt[n][k], At[m][k], acc[ai][bj][m][n], 0, 0, 0); __builtin_amdgcn_s_setprio(0); } while (0)
#define PG8_WAIT_V(n) asm volatile("s_waitcnt vmcnt(" #n ")" ::: "memory")
#define PG8_WAIT_L(n) asm volatile("s_waitcnt lgkmcnt(" #n ")" ::: "memory")
#define PG8_BAR __builtin_amdgcn_s_barrier()
#define PG8_SCHED __builtin_amdgcn_sched_barrier(0)
#define PG8_APTR(u) ((const char*)g.A + (size_t)(u).pm * tstepA + (size_t)(((u).pn >> g.a_sh) * g.a_mul) * 2)
    Unit cur, nxt; int ui = 0;
    if (!S.next(0, cur)) return;
    f32x4 acc[2][2][4][2];
#pragma unroll
    for (int a = 0; a < 2; ++a)
#pragma unroll
        for (int b = 0; b < 2; ++b)
#pragma unroll
            for (int m = 0; m < 4; ++m)
#pragma unroll
                for (int n = 0; n < 2; ++n) acc[a][b][m][n] = (f32x4){0.f, 0.f, 0.f, 0.f};
    bf16x8 At[4][2], B0[2][2], B1[2][2];
    const char* cA = PG8_APTR(cur); const char* cB = (const char*)g.Bt + (size_t)cur.pn * tstepB;
    PG8_STAGE(PG8_SB(0, 0), cB, voffB); PG8_STAGE(PG8_SA(0, 0), cA, voffA); PG8_STAGE(PG8_SB(0, 1), cB + hstepB, voffB); PG8_STAGE(PG8_SA(0, 1), cA + hstepA, voffA);
    if (wr == 1) PG8_BAR;
    PG8_WAIT_V(4); PG8_BAR;
    PG8_STAGE(PG8_SB(1, 0), cB + kstep, voffB); PG8_STAGE(PG8_SA(1, 0), cA + kstep, voffA); PG8_STAGE(PG8_SB(1, 1), cB + hstepB + kstep, voffB);
    PG8_WAIT_V(6); PG8_BAR;
    for (;;) {
        const bool has_next = S.next(ui + 1, nxt);
        const char* nA = has_next ? PG8_APTR(nxt) : cA; const char* nB = has_next ? (const char*)g.Bt + (size_t)nxt.pn * tstepB : cB;
        for (int t = 0; t < nt; t += 2) {
            const bool last = (t == nt - 2);
            const char* a1 = cA + (size_t)(t + 1) * kstep;
            const char* a2 = last ? nA : cA + (size_t)(t + 2) * kstep; const char* b2 = last ? nB : cB + (size_t)(t + 2) * kstep;
            const char* a3 = a2 + kstep; const char* b3 = b2 + kstep;
            PG8_LDB(B0, 0, 0); PG8_SCHED; PG8_LDA(At, 0, 0); PG8_STAGE(PG8_SA(1, 1), a1 + hstepA, voffA);
            PG8_WAIT_L(8); PG8_BAR; PG8_WAIT_L(0); PG8_MMA(0, 0, At, B0); PG8_BAR; PG8_SCHED;
            PG8_LDB(B1, 0, 1); PG8_STAGE(PG8_SB(0, 0), b2, voffB);
            PG8_BAR; PG8_WAIT_L(0); PG8_MMA(0, 1, At, B1); PG8_BAR;
            PG8_LDA(At, 0, 1); PG8_STAGE(PG8_SA(0, 0), a2, voffA);
            PG8_BAR; PG8_WAIT_L(0); PG8_MMA(1, 0, At, B0); PG8_BAR; PG8_SCHED;
            PG8_STAGE(PG8_SB(0, 1), b2 + hstepB, voffB);
            PG8_WAIT_V(6); PG8_BAR; PG8_MMA(1, 1, At, B1); PG8_BAR;
            PG8_LDB(B0, 1, 0); PG8_SCHED; PG8_LDA(At, 1, 0); PG8_STAGE(PG8_SA(0, 1), a2 + hstepA, voffA);
            PG8_WAIT_L(8); PG8_BAR; PG8_WAIT_L(0); PG8_MMA(0, 0, At, B0); PG8_BAR; PG8_SCHED;
            PG8_LDB(B1, 1, 1); PG8_STAGE(PG8_SB(1, 0), b3, voffB);
            PG8_BAR; PG8_WAIT_L(0); PG8_MMA(0, 1, At, B1); PG8_BAR;
            PG8_LDA(At, 1, 1); PG8_STAGE(PG8_SA(1, 0), a3, voffA);
            PG8_BAR; PG8_WAIT_L(0); PG8_MMA(1, 0, At, B0); PG8_BAR; PG8_SCHED;
            PG8_STAGE(PG8_SB(1, 1), b3 + hstepB, voffB);
            PG8_WAIT_V(6); PG8_BAR; PG8_MMA(1, 1, At, B1); PG8_BAR;
        }
        E(acc, cur, wr, wc, fr, fq);
        if (!has_next) break;
#pragma unroll
        for (int a = 0; a < 2; ++a)
#pragma unroll
            for (int b = 0; b < 2; ++b)
#pragma unroll
                for (int m = 0; m < 4; ++m)
#pragma unroll
                    for (int n = 0; n < 2; ++n) acc[a][b][m][n] = (f32x4){0.f, 0.f, 0.f, 0.f};
        cur = nxt; cA = nA; cB = nB; ++ui;
    }
    PG8_WAIT_V(0);
    if (wr == 0) PG8_BAR;
    PG8_BAR;
#undef PG8_SA
#undef PG8_SB
#undef PG8_STAGE
#undef PG8_LDA
#undef PG8_LDB
#undef PG8_MMA
#undef PG8_WAIT_V
#undef PG8_WAIT_L
#undef PG8_BAR
#undef PG8_SCHED
#undef PG8_APTR
}
}

__device__ __forceinline__ void run_gemm(LAS unsigned char* lds, const bf16_t* A, int lda, int a_sh, int a_mul, const bf16_t* Bt, int N, int K, const pg8::Epi& E) {
    pg8::Gemm g; g.A = A; g.Bt = Bt; g.M = T_TOK; g.N = N; g.K = K; g.lda = lda; g.a_sh = a_sh; g.a_mul = a_mul;
    pg8::StaticOrder S; S.init(T_TOK, N, (int)gridDim.x, (int)blockIdx.x);
    pg8::gemm_phase(lds, g, S, E);
}

__device__ __forceinline__ void rmsnorm_phase(const float* X, const float* g, bf16_t* H) {
    const int lane = TIDX & 63, gw = blockIdx.x * 8 + (TIDX >> 6), NW = gridDim.x * 8;
    f32x4 gv[4];
#pragma unroll
    for (int j = 0; j < 4; ++j) gv[j] = *(const f32x4*)(g + 4 * (lane + 64 * j));
    for (int row = gw; row < T_TOK; row += 4 * NW) {
        f32x4 v[4][4];
#pragma unroll
        for (int q = 0; q < 4; ++q) { const int rr = row + q * NW; if (rr < T_TOK) {
#pragma unroll
            for (int j = 0; j < 4; ++j) v[q][j] = *(const f32x4*)(X + (size_t)rr * DM + 4 * (lane + 64 * j)); } }
#pragma unroll
        for (int q = 0; q < 4; ++q) { const int rr = row + q * NW; if (rr < T_TOK) { float s = 0.f;
#pragma unroll
            for (int j = 0; j < 4; ++j) s += v[q][j][0] * v[q][j][0] + v[q][j][1] * v[q][j][1] + v[q][j][2] * v[q][j][2] + v[q][j][3] * v[q][j][3];
            const float rstd = rsqrtf(wave_sum(s) * (1.f / DM) + EPS);
#pragma unroll
            for (int j = 0; j < 4; ++j) { u32x2 o; o.x = pk2(v[q][j][0] * rstd * gv[j][0], v[q][j][1] * rstd * gv[j][1]); o.y = pk2(v[q][j][2] * rstd * gv[j][2], v[q][j][3] * rstd * gv[j][3]);
                *(u32x2*)(H + (size_t)rr * DM + 4 * (lane + 64 * j)) = o; } } }
    }
}
__device__ __forceinline__ int wmap(int mat, int j) {
    if (mat == 0) return j < C_GATE ? j : -1;
    if (mat == 1) { const int pn = j >> 8, rho = j & 255, bj = rho >> 7, wc = (rho >> 5) & 3, n = (rho >> 4) & 1, fq = (rho >> 2) & 3, jj = rho & 3;
        return C_GATE + (2 * bj + n) * 1024 + 64 * pn + 16 * wc + 4 * fq + jj; }
    return j;
}
struct WItem { const float* src; bf16_t* dst; int ld, K, mat, k0, n0; };
__device__ __forceinline__ WItem wdecode(const Params& p, int l, int r) {
    constexpr int I0 = 16 * 56, I1 = 16 * 64, I2 = 4 * 4 * 16, I3 = 16 * 16, I4 = 16 * 64;
    WItem w;
    if (r < I0) { w.src = p.w_in + (size_t)l * DM * N_IN; w.ld = N_IN; w.K = DM; w.dst = (bf16_t*)(p.ws + OFF_WIN); w.mat = 0; w.k0 = (r / 56) * 64; w.n0 = (r % 56) * 64; return w; } r -= I0;
    if (r < I1) { w.src = p.w_in + (size_t)l * DM * N_IN; w.ld = N_IN; w.K = DM; w.dst = (bf16_t*)(p.ws + OFF_WG); w.mat = 1; w.k0 = (r / 64) * 64; w.n0 = (r % 64) * 64; return w; } r -= I1;
    if (r < I2) { const int nb = r / 64, q = r % 64; w.src = p.w_branch + ((size_t)l * 4 + nb) * 256 * DM; w.ld = DM; w.K = 256; w.dst = (bf16_t*)(p.ws + OFF_WB) + (size_t)nb * 1024 * 256; w.mat = 2; w.k0 = (q / 16) * 64; w.n0 = (q % 16) * 64; return w; } r -= I2;
    if (r < I3) { w.src = p.w_out + (size_t)l * DM * DM; w.ld = DM; w.K = DM; w.dst = (bf16_t*)(p.ws + OFF_WO); w.mat = 2; w.k0 = (r / 16) * 64; w.n0 = (r % 16) * 64; return w; } r -= I3;
    if (r < I4) { w.src = p.w_mlp_in + (size_t)l * DM * DFF; w.ld = DFF; w.K = DM; w.dst = (bf16_t*)(p.ws + OFF_W1); w.mat = 2; w.k0 = (r / 64) * 64; w.n0 = (r % 64) * 64; return w; } r -= I4;
    w.src = p.w_mlp_out + (size_t)l * DFF * DM; w.ld = DM; w.K = DFF; w.dst = (bf16_t*)(p.ws + OFF_W2); w.mat = 2; w.k0 = (r / 16) * 64; w.n0 = (r % 16) * 64; return w;
}
__device__ __forceinline__ void wload(const WItem& w, int tid, float (&v)[8]) {
    const int nn = tid & 63; const int c = wmap(w.mat, w.n0 + nn);
#pragma unroll
    for (int i = 0; i < 8; ++i) { const int kk = i * 8 + (tid >> 6); v[i] = (c >= 0) ? w.src[(size_t)(w.k0 + kk) * w.ld + c] : 0.f; }
}
__device__ __forceinline__ void wconv_phase(const Params& p, int l, LAS unsigned char* lds) {
    LAS float* scr = (LAS float*)lds;
    constexpr int NI = 16 * 56 + 16 * 64 + 4 * 4 * 16 + 16 * 16 + 16 * 64 + 64 * 16;
    const int tid = TIDX, G = gridDim.x;
    int it = blockIdx.x;
    if (it >= NI) return;
    WItem w0 = wdecode(p, l, it), w1 = w0, w2 = w0; float v0[8], v1[8], v2[8];
    wload(w0, tid, v0);
    if (it + G < NI) { w1 = wdecode(p, l, it + G); wload(w1, tid, v1); }
    for (; it < NI; it += G) {
        if (it + 2 * G < NI) { w2 = wdecode(p, l, it + 2 * G); wload(w2, tid, v2); }
        { const int nn = tid & 63;
#pragma unroll
          for (int i = 0; i < 8; ++i) scr[(i * 8 + (tid >> 6)) * 65 + nn] = v0[i]; }
        __syncthreads();
        { const int kk2 = (tid & 31) * 2;
#pragma unroll
          for (int i = 0; i < 4; ++i) { const int nn = i * 16 + (tid >> 5); *(unsigned*)(w0.dst + (size_t)(w0.n0 + nn) * w0.K + w0.k0 + kk2) = pk2(scr[kk2 * 65 + nn], scr[(kk2 + 1) * 65 + nn]); } }
        __syncthreads();
        w0 = w1; w1 = w2;
#pragma unroll
        for (int i = 0; i < 8; ++i) { v0[i] = v1[i]; v1[i] = v2[i]; }
    }
}

__device__ __forceinline__ void sb_task(const Params& p, int l, LAS unsigned char* lds, int task) {
    constexpr int VTS = 140;
    const int tid = TIDX, wave = tid >> 6, lane = tid & 63, ll = lane & 15, qd = lane >> 4;
    const int bh = task >> 7, qi = 127 - (task & 127), b = bh >> 2, h = bh & 3, q0 = qi * 128;
    const bf16_t* base = (const bf16_t*)(p.ws + OFF_B) + (size_t)b * SEQ * NP;
    LAS bf16_t* vt = (LAS bf16_t*)lds;
    LAS int* flag = (LAS int*)(lds + 64 * VTS * 2);
    bf16x8 qf[2];
#pragma unroll
    for (int ks = 0; ks < 2; ++ks) qf[ks] = *(const bf16x8*)(base + (size_t)(q0 + wave * 16 + ll) * NP + C_SBQ + h * 64 + ks * 32 + qd * 8);
    float carry = 0.f;
    f32x4 oacc[4];
#pragma unroll
    for (int c = 0; c < 4; ++c) oacc[c] = (f32x4){0.f, 0.f, 0.f, 0.f};
    bf16x8 kc[8][2], va, vc;
#define SB_LOAD(jj, K_, A_, C_) do { _Pragma("unroll") for (int g = 0; g < 8; ++g) _Pragma("unroll") for (int ks = 0; ks < 2; ++ks) \
            K_[g][ks] = *(const bf16x8*)(base + (size_t)((jj) * 128 + g * 16 + ll) * NP + C_SBK + h * 64 + ks * 32 + qd * 8); \
        const bf16_t* vp_ = base + (size_t)((jj) * 128 + 2 * (tid >> 3)) * NP + C_SBV + h * 64 + (tid & 7) * 8; A_ = *(const bf16x8*)vp_; C_ = *(const bf16x8*)(vp_ + NP); } while (0)
    SB_LOAD(qi, kc, va, vc);
    for (int j = qi; j >= 0; --j) {
        bf16x8 kn[8][2], van, vcn;
        { const int jn = j > 0 ? j - 1 : 0; SB_LOAD(jn, kn, van, vcn); }
        {
#pragma unroll
            for (int e = 0; e < 8; ++e) *(LAS unsigned*)(vt + ((tid & 7) * 8 + e) * VTS + 2 * (tid >> 3)) = (unsigned)(unsigned short)va[e] | ((unsigned)(unsigned short)vc[e] << 16);
        }
        f32x4 s[8];
#pragma unroll
        for (int g = 0; g < 8; ++g) { s[g] = (f32x4){0.f, 0.f, 0.f, 0.f};
#pragma unroll
            for (int ks = 0; ks < 2; ++ks) s[g] = MFMA16(kc[g][ks], qf[ks], s[g]); }
        const bool diag = (j == qi);
        f32x4 sp[8], lb[8]; float Gt[8], abq[8];
#pragma unroll
        for (int g = 0; g < 8; ++g) {
#pragma unroll
            for (int r = 0; r < 4; ++r) { const float z = s[g][r] * 0.125f; float spv = softplusf_(z), lbv = z - spv;
                if (diag && !(16 * g + 4 * qd + r < wave * 16 + ll)) { spv = 0.f; lbv = -INFINITY; }
                sp[g][r] = spv; lb[g][r] = lbv; }
            const float L = (sp[g][0] + sp[g][1]) + (sp[g][2] + sp[g][3]);
            const float L0 = __shfl(L, ll), L1 = __shfl(L, ll + 16), L2 = __shfl(L, ll + 32), L3 = __shfl(L, ll + 48);
            Gt[g] = (L0 + L1) + (L2 + L3);
            abq[g] = (qd < 1 ? L1 : 0.f) + (qd < 2 ? L2 : 0.f) + (qd < 3 ? L3 : 0.f);
        }
        float run = 0.f; bf16x8 pf[4]; f32x4 w[8];
#pragma unroll
        for (int g = 7; g >= 0; --g) {
            const float bs = carry - run - abq[g];
            w[g][3] = __expf(lb[g][3] + bs);
            w[g][2] = __expf(lb[g][2] + bs - sp[g][3]);
            w[g][1] = __expf(lb[g][1] + bs - (sp[g][3] + sp[g][2]));
            w[g][0] = __expf(lb[g][0] + bs - (sp[g][3] + sp[g][2] + sp[g][1]));
            run += Gt[g];
        }
#pragma unroll
        for (int g2 = 0; g2 < 4; ++g2) pf[g2] = pk8(w[2 * g2], w[2 * g2 + 1]);
        carry -= run;
        __syncthreads();
        {
            bf16x8 af[4][4];
#pragma unroll
            for (int c = 0; c < 4; ++c)
#pragma unroll
                for (int g2 = 0; g2 < 4; ++g2) { const LAS bf16_t* vr = vt + (16 * c + ll) * VTS + 32 * g2 + 4 * qd; af[c][g2] = mk8(*(const LAS u32x2*)vr, *(const LAS u32x2*)(vr + 16)); }
            __builtin_amdgcn_sched_barrier(0);
#pragma unroll
            for (int c = 0; c < 4; ++c)
#pragma unroll
                for (int g2 = 0; g2 < 4; ++g2) oacc[c] = MFMA16(af[c][g2], pf[g2], oacc[c]);
        }
        const int done = __all(carry < -104.f) ? 1 : 0;
        if (lane == 0) flag[wave] = done;
        __syncthreads();
        int all = 1;
#pragma unroll
        for (int i = 0; i < 8; ++i) all &= flag[i];
        if (__builtin_amdgcn_readfirstlane(all)) break;
        __syncthreads();
#pragma unroll
        for (int g = 0; g < 8; ++g) { kc[g][0] = kn[g][0]; kc[g][1] = kn[g][1]; }
        va = van; vc = vcn;
    }
#undef SB_LOAD
    bf16_t* op = (bf16_t*)(p.ws + OFF_O) + (size_t)(b * SEQ + q0 + wave * 16 + ll) * DM + O_SB + h * 64 + 4 * qd;
#pragma unroll
    for (int c = 0; c < 4; ++c) { u32x2 o; o.x = pk2(oacc[c][0], oacc[c][1]); o.y = pk2(oacc[c][2], oacc[c][3]); *(u32x2*)(op + 16 * c) = o; }
    __syncthreads();
}

__device__ __forceinline__ void dil_task(const Params& p, int l, LAS unsigned char* lds, int pat, int task) {
    constexpr int RS = 72, VTS = 268;
    const int tid = TIDX, wave = tid >> 6, lane = tid & 63, ll = lane & 15, qd = lane >> 4;
    const int dil = pat == 0 ? 1 : (pat == 1 ? 4 : 16), nb = (SEQ / dil) / 128;
    const int n = task % nb, r = (task / nb) % dil, bh = task / (nb * dil), b = bh >> 2, h = bh & 3;
    const bf16_t* base = (const bf16_t*)(p.ws + OFF_B) + (size_t)b * SEQ * NP;
    LAS bf16_t* qs = (LAS bf16_t*)lds;
    LAS bf16_t* ks = qs + 128 * RS;
    LAS bf16_t* vt = ks + 256 * RS;
    LAS float* gq = (LAS float*)(vt + 64 * VTS);
    const bool isq = tid < 128; const int ridx = isq ? n * 128 + tid : n * 128 - 128 + (tid - 128), rpos = ridx * dil + r;
    u32x4 raw[8];
    if (tid < 384 && ridx >= 0) { const bf16_t* src = base + (size_t)rpos * NP + (isq ? C_LQ : C_LK) + h * 64;
#pragma unroll
        for (int c8 = 0; c8 < 8; ++c8) raw[c8] = *(const u32x4*)(src + c8 * 8); }
    if (tid < 128) gq[tid] = tid < 64 ? p.dil_q_g[l * 64 + tid] : p.dil_k_g[l * 64 + tid - 64];
    bf16x8 vreg[2][2];
#pragma unroll
    for (int ps = 0; ps < 2; ++ps) { const int kj = 2 * (ps * 64 + (tid >> 3)), idx = n * 128 - 128 + kj;
        vreg[ps][0] = (bf16x8){0, 0, 0, 0, 0, 0, 0, 0}; vreg[ps][1] = (bf16x8){0, 0, 0, 0, 0, 0, 0, 0};
        if (idx >= 0) { const bf16_t* vp = base + (size_t)(idx * dil + r) * NP + C_LV + h * 64 + (tid & 7) * 8; vreg[ps][0] = *(const bf16x8*)vp; vreg[ps][1] = *(const bf16x8*)(vp + (size_t)dil * NP); } }
    __syncthreads();
    if (tid < 384) {
        const int idx = ridx;
        LAS bf16_t* dst = isq ? qs + tid * RS : ks + (tid - 128) * RS;
        if (idx >= 0) {
            const int pos = rpos;
            float xv[64]; float ss = 0.f;
#pragma unroll
            for (int c8 = 0; c8 < 8; ++c8) { const u32x4 u = raw[c8];
                xv[c8 * 8 + 0] = bflo(u.x); xv[c8 * 8 + 1] = bfhi(u.x); xv[c8 * 8 + 2] = bflo(u.y); xv[c8 * 8 + 3] = bfhi(u.y);
                xv[c8 * 8 + 4] = bflo(u.z); xv[c8 * 8 + 5] = bfhi(u.z); xv[c8 * 8 + 6] = bflo(u.w); xv[c8 * 8 + 7] = bfhi(u.w); }
#pragma unroll
            for (int c = 0; c < 64; ++c) ss += xv[c] * xv[c];
            const float rstd = rsqrtf(ss * (1.f / 64.f) + EPS);
            const LAS float* gg = gq + (isq ? 0 : 64);
#pragma unroll
            for (int c = 0; c < 64; ++c) xv[c] = xv[c] * rstd * gg[c];
#pragma unroll
            for (int i = 0; i < 8; ++i) {
                const float invf = exp2f(-(float)i * (18.931568569324174f / 8.f));
                const float ang = (float)pos * invf;
                double rev = (double)ang * 0.15915494309189535; rev -= rint(rev);
                const float a2 = (float)(rev * 6.283185307179586);
                const float cs = __cosf(a2), sn = __sinf(a2);
                const float x1 = xv[i], x2 = xv[i + 8]; xv[i] = x1 * cs - x2 * sn; xv[i + 8] = x2 * cs + x1 * sn;
            }
#pragma unroll
            for (int c8 = 0; c8 < 8; ++c8) { u32x4 o; o.x = pk2(xv[c8 * 8], xv[c8 * 8 + 1]); o.y = pk2(xv[c8 * 8 + 2], xv[c8 * 8 + 3]); o.z = pk2(xv[c8 * 8 + 4], xv[c8 * 8 + 5]); o.w = pk2(xv[c8 * 8 + 6], xv[c8 * 8 + 7]);
                *(LAS u32x4*)(dst + c8 * 8) = o; }
        } else {
#pragma unroll
            for (int c8 = 0; c8 < 8; ++c8) *(LAS u32x4*)(dst + c8 * 8) = (u32x4){0u, 0u, 0u, 0u};
        }
    }
    {
#pragma unroll
        for (int ps = 0; ps < 2; ++ps) { const int kj = 2 * (ps * 64 + (tid >> 3));
#pragma unroll
            for (int e = 0; e < 8; ++e) *(LAS unsigned*)(vt + ((tid & 7) * 8 + e) * VTS + kj) = (unsigned)(unsigned short)vreg[ps][0][e] | ((unsigned)(unsigned short)vreg[ps][1][e] << 16); }
    }
    __syncthreads();
    const size_t tok = (size_t)b * SEQ + (size_t)(n * 128 + 16 * wave + ll) * dil + r;
    bf16_t* op = (bf16_t*)(p.ws + OFF_O) + tok * DM + O_DIL + h * 64 + 4 * qd;
    float* st = (float*)(p.ws + OFF_DSTAT) + (tok * 4 + h) * 2;
    u32x2 pv[4]; float mo = 0.f, dd = 0.f;
    if (pat > 0) { mo = st[0]; dd = st[1];
#pragma unroll
        for (int c = 0; c < 4; ++c) pv[c] = *(const u32x2*)(op + 16 * c); }
    bf16x8 qf[2];
#pragma unroll
    for (int k2 = 0; k2 < 2; ++k2) qf[k2] = *(const LAS bf16x8*)(qs + (16 * wave + ll) * RS + k2 * 32 + qd * 8);
    f32x4 s[10]; float mx = -INFINITY;
    {   bf16x8 kf[10][2];
#pragma unroll
        for (int gi = 0; gi < 10; ++gi) { const int g = wave + gi, gc = g < 16 ? g : 15;
#pragma unroll
            for (int k2 = 0; k2 < 2; ++k2) kf[gi][k2] = *(const LAS bf16x8*)(ks + (16 * gc + ll) * RS + k2 * 32 + qd * 8); }
        __builtin_amdgcn_sched_barrier(0);
#pragma unroll
        for (int gi = 0; gi < 10; ++gi) { s[gi] = (f32x4){0.f, 0.f, 0.f, 0.f};
#pragma unroll
            for (int k2 = 0; k2 < 2; ++k2) s[gi] = MFMA16(kf[gi][k2], qf[k2], s[gi]); }
    }
#pragma unroll
    for (int gi = 0; gi < 10; ++gi) {
        const int g = wave + gi;
#pragma unroll
        for (int rr = 0; rr < 4; ++rr) { const int kj = 16 * g + 4 * qd + rr, m = (16 * wave + ll) + 128 - kj;
            const bool valid = (g < 16) && (m >= 0) && (m <= 128) && (n * 128 - 128 + kj >= 0);
            const float v = valid ? s[gi][rr] * 0.125f : -INFINITY; s[gi][rr] = v; mx = fmaxf(mx, v); }
    }
    mx = fmaxf(mx, __shfl_xor(mx, 16)); mx = fmaxf(mx, __shfl_xor(mx, 32));
    float den = 0.f; bf16x8 pf[5];
#pragma unroll
    for (int gi = 0; gi < 10; ++gi)
#pragma unroll
        for (int rr = 0; rr < 4; ++rr) { const float e = __expf(s[gi][rr] - mx); s[gi][rr] = e; den += e; }
    den += __shfl_xor(den, 16); den += __shfl_xor(den, 32);
#pragma unroll
    for (int g2 = 0; g2 < 5; ++g2) pf[g2] = pk8(s[2 * g2], s[2 * g2 + 1]);
    f32x4 oacc[4];
    {   bf16x8 af[4][5];
#pragma unroll
        for (int c = 0; c < 4; ++c)
#pragma unroll
            for (int g2 = 0; g2 < 5; ++g2) {
                const int ga = wave + 2 * g2, gb = ga + 1, gac = ga < 16 ? ga : 15, gbc = gb < 16 ? gb : 15;
                const LAS bf16_t* vr = vt + (16 * c + ll) * VTS + 4 * qd;
                af[c][g2] = mk8(*(const LAS u32x2*)(vr + 16 * gac), *(const LAS u32x2*)(vr + 16 * gbc)); }
        __builtin_amdgcn_sched_barrier(0);
#pragma unroll
        for (int c = 0; c < 4; ++c) { oacc[c] = (f32x4){0.f, 0.f, 0.f, 0.f};
#pragma unroll
            for (int g2 = 0; g2 < 5; ++g2) oacc[c] = MFMA16(af[c][g2], pf[g2], oacc[c]); }
    }
    float wa = 0.f, wb = 1.f, D = den, M = mx;
    if (pat > 0) { M = fmaxf(mo, mx); wa = dd * __expf(mo - M); wb = __expf(mx - M); D = wa + den * wb; }
    const float inv = 1.f / D;
#pragma unroll
    for (int c = 0; c < 4; ++c) { f32x4 o = oacc[c] * wb;
        if (pat > 0) { const u32x2 u = pv[c]; o[0] += wa * bflo(u.x); o[1] += wa * bfhi(u.x); o[2] += wa * bflo(u.y); o[3] += wa * bfhi(u.y); }
        u32x2 q; q.x = pk2(o[0] * inv, o[1] * inv); q.y = pk2(o[2] * inv, o[3] * inv); *(u32x2*)(op + 16 * c) = q; }
    if (pat < 2 && qd == 0) { st[0] = M; st[1] = D; }
    __syncthreads();
}

__device__ __forceinline__ void gla_load(const Params& p, int l, const bf16_t* prow  , int h, LAS float* qL, LAS float* kL, LAS float* bL, LAS float* lrL, LAS float* w2L) {
    const int tid = TIDX;
    if (tid < 128) { const int t = tid >> 1, c8 = (tid & 1) * 8; const u32x4 u = *(const u32x4*)(prow + (size_t)t * NP + C_GLR + c8); LAS float* d = lrL + t * 16 + c8;
        d[0] = bflo(u.x); d[1] = bfhi(u.x); d[2] = bflo(u.y); d[3] = bfhi(u.y); d[4] = bflo(u.z); d[5] = bfhi(u.z); d[6] = bflo(u.w); d[7] = bfhi(u.w); }
    { const int j = tid >> 5, c = tid & 31; w2L[tid] = p.gla_w_lr2[(size_t)l * 16 * 128 + j * 128 + h * 32 + c]; }
    if (tid < 32) w2L[512 + tid] = p.gla_b_lr[l * 128 + h * 32 + tid];
    { const int isk = tid >> 8, t = (tid & 255) >> 2, c8 = (tid & 3) * 8; const u32x4 u = *(const u32x4*)(prow + (size_t)t * NP + (isk ? C_GK : C_GQ) + h * 32 + c8);
        const float sc = isk ? 1.f : 0.17677669529663687f; LAS float* d = (isk ? kL : qL) + t * 33 + c8;
        d[0] = bflo(u.x) * sc; d[1] = bfhi(u.x) * sc; d[2] = bflo(u.y) * sc; d[3] = bfhi(u.y) * sc; d[4] = bflo(u.z) * sc; d[5] = bfhi(u.z) * sc; d[6] = bflo(u.w) * sc; d[7] = bfhi(u.w) * sc; }
    __syncthreads();
    for (int i = tid; i < 64 * 32; i += 512) { const int t = i >> 5, c = i & 31; float a = w2L[512 + c];
#pragma unroll
        for (int j = 0; j < 16; ++j) a += lrL[t * 16 + j] * w2L[j * 32 + c];
        bL[t * 33 + c] = -softplusf_(-a) * (1.f / 16.f); }
    __syncthreads();
    {
        const int wv = tid >> 6, ln = tid & 63;
#pragma unroll
        for (int q = 0; q < 4; ++q) { const int c = wv * 4 + q; float v = bL[ln * 33 + c];
#pragma unroll
            for (int o = 1; o < 64; o <<= 1) { const float u = __shfl_up(v, o); if (ln >= o) v += u; }
            bL[ln * 33 + c] = v; }
    }
    __syncthreads();
}
__device__ __forceinline__ void gla_a_task(const Params& p, int l, LAS unsigned char* lds, int task) {
    const int tid = TIDX, wave = tid >> 6, lane = tid & 63, ll = lane & 15, qd = lane >> 4, bh = task >> 8, ch = task & 255, b = bh >> 2, h = bh & 3;
    const bf16_t* prow = (const bf16_t*)(p.ws + OFF_B) + ((size_t)b * SEQ + ch * 64) * NP;
    LAS float* qL = (LAS float*)lds; LAS float* kL = qL + 64 * 33; LAS float* bL = kL + 64 * 33; LAS float* lrL = bL + 64 * 33; LAS float* w2L = lrL + 1024;
    LAS bf16_t* vt = (LAS bf16_t*)(w2L + 576);
    LAS bf16_t* kT = vt + 64 * 72;
    { const int tp = tid >> 4, c4 = (tid & 15) * 4;
      const u32x2 u0 = *(const u32x2*)(prow + (size_t)(2 * tp) * NP + C_GV + h * 64 + c4), u1 = *(const u32x2*)(prow + (size_t)(2 * tp + 1) * NP + C_GV + h * 64 + c4);
      *(LAS unsigned*)(vt + (c4 + 0) * 72 + 2 * tp) = (u0.x & 0xffffu) | (u1.x << 16); *(LAS unsigned*)(vt + (c4 + 1) * 72 + 2 * tp) = (u0.x >> 16) | (u1.x & 0xffff0000u);
      *(LAS unsigned*)(vt + (c4 + 2) * 72 + 2 * tp) = (u0.y & 0xffffu) | (u1.y << 16); *(LAS unsigned*)(vt + (c4 + 3) * 72 + 2 * tp) = (u0.y >> 16) | (u1.y & 0xffff0000u); }
    gla_load(p, l, prow, h, qL, kL, bL, lrL, w2L);
    { const int c = tid >> 4, t4 = (tid & 15) * 4; const float bl = bL[63 * 33 + c]; float kv[4];
#pragma unroll
      for (int e = 0; e < 4; ++e) kv[e] = kL[(t4 + e) * 33 + c] * __expf(bl - bL[(t4 + e) * 33 + c]);
      *(LAS unsigned*)(kT + c * 72 + t4) = pk2(kv[0], kv[1]); *(LAS unsigned*)(kT + c * 72 + t4 + 2) = pk2(kv[2], kv[3]); }
    __syncthreads();
    const int ct = wave >> 2, dt = wave & 3; f32x4 acc = {0.f, 0.f, 0.f, 0.f};
#pragma unroll
    for (int k2 = 0; k2 < 2; ++k2) acc = MFMA16(*(const LAS bf16x8*)(kT + (16 * ct + ll) * 72 + k2 * 32 + qd * 8), *(const LAS bf16x8*)(vt + (16 * dt + ll) * 72 + k2 * 32 + qd * 8), acc);
    float* U = (float*)(p.ws + OFF_GLAU) + (size_t)task * 2048;
#pragma unroll
    for (int r = 0; r < 4; ++r) U[(16 * ct + 4 * qd + r) * 64 + 16 * dt + ll] = acc[r];
    if (tid < 32) ((float*)(p.ws + OFF_GLAA))[(size_t)task * 32 + tid] = __expf(bL[63 * 33 + tid]);
    __syncthreads();
}
__device__ __forceinline__ void gla_scan_task(const Params& p, LAS unsigned char* lds, int task, unsigned* ready) {
    const int tid = TIDX, bh = task >> 2, qt = task & 3, e = qt * 512 + tid, cl = tid >> 6;
    float* U = (float*)(p.ws + OFF_GLAU) + (size_t)bh * 256 * 2048 + e;
    const float* A = (const float*)(p.ws + OFF_GLAA) + (size_t)bh * 256 * 32 + qt * 8;
    LAS float* aL = (LAS float*)lds;
#pragma unroll
    for (int k = 0; k < 4; ++k) { const int idx = tid + 512 * k; aL[idx] = A[(idx >> 3) * 32 + (idx & 7)]; }
    __syncthreads();
    float st = 0.f;
    for (int n0 = 0; n0 < 256; n0 += 16) {
        float u[16];
#pragma unroll
        for (int k = 0; k < 16; ++k) u[k] = U[(size_t)(n0 + k) * 2048];
#pragma unroll
        for (int k = 0; k < 16; ++k) { U[(size_t)(n0 + k) * 2048] = st; st = aL[(n0 + k) * 8 + cl] * st + u[k]; }
    }
    asm volatile("s_waitcnt vmcnt(0)" ::: "memory");
    __syncthreads();
    if (tid == 0) { __builtin_amdgcn_fence(__ATOMIC_RELEASE, "agent"); asm volatile("s_waitcnt vmcnt(0)" ::: "memory");
        __hip_atomic_fetch_add(ready, 1u, __ATOMIC_RELAXED, __HIP_MEMORY_SCOPE_AGENT); }
    __syncthreads();
}
__device__ __forceinline__ void gla_c_task(const Params& p, int l, LAS unsigned char* lds, int task, unsigned* ready) {
    const int tid = TIDX, wave = tid >> 6, lane = tid & 63, ll = lane & 15, qd = lane >> 4, bh = task >> 8, ch = task & 255, b = bh >> 2, h = bh & 3;
    if (tid == 0) {
        unsigned sp = 0; while (__hip_atomic_load(ready + bh, __ATOMIC_RELAXED, __HIP_MEMORY_SCOPE_AGENT) < 4u && ++sp < (1u << 24)) __builtin_amdgcn_s_sleep(2);
        __builtin_amdgcn_fence(__ATOMIC_ACQUIRE, "agent"); asm volatile("s_waitcnt vmcnt(0)" ::: "memory"); }
    __syncthreads();
    const bf16_t* prow = (const bf16_t*)(p.ws + OFF_B) + ((size_t)b * SEQ + ch * 64) * NP;
    LAS float* qL = (LAS float*)lds; LAS float* kL = qL + 64 * 33; LAS float* bL = kL + 64 * 33; LAS float* lrL = bL + 64 * 33; LAS float* w2L = lrL + 1024;
    LAS float* ssL = w2L + 576;
    LAS bf16_t* vt = (LAS bf16_t*)(ssL + 512);
    LAS bf16_t* sT = vt + 64 * 72;
    { const int tp = tid >> 4, c4 = (tid & 15) * 4;
      const u32x2 u0 = *(const u32x2*)(prow + (size_t)(2 * tp) * NP + C_GV + h * 64 + c4), u1 = *(const u32x2*)(prow + (size_t)(2 * tp + 1) * NP + C_GV + h * 64 + c4);
      *(LAS unsigned*)(vt + (c4 + 0) * 72 + 2 * tp) = (u0.x & 0xffffu) | (u1.x << 16); *(LAS unsigned*)(vt + (c4 + 1) * 72 + 2 * tp) = (u0.x >> 16) | (u1.x & 0xffff0000u);
      *(LAS unsigned*)(vt + (c4 + 2) * 72 + 2 * tp) = (u0.y & 0xffffu) | (u1.y << 16); *(LAS unsigned*)(vt + (c4 + 3) * 72 + 2 * tp) = (u0.y >> 16) | (u1.y & 0xffff0000u); }
    { const float* U = (const float*)(p.ws + OFF_GLAU) + (size_t)task * 2048; const int c = tid >> 4, d4 = (tid & 15) * 4; const f32x4 u = *(const f32x4*)(U + c * 64 + d4);
#pragma unroll
      for (int e = 0; e < 4; ++e) sT[(d4 + e) * 40 + c] = f2bf(u[e]); }
    const int I = wave >> 1, dh = wave & 1, t = 16 * I + ll;
    u32x2 rgl[2];
#pragma unroll
    for (int cc = 0; cc < 2; ++cc) rgl[cc] = *(const u32x2*)(prow + (size_t)t * NP + C_GR + h * 64 + 16 * (2 * dh + cc) + 4 * qd);
    gla_load(p, l, prow, h, qL, kL, bL, lrL, w2L);
    float qv[8], bt[8], rI[8];
#pragma unroll
    for (int e = 0; e < 8; ++e) { qv[e] = qL[t * 33 + 8 * qd + e]; bt[e] = bL[t * 33 + 8 * qd + e]; rI[e] = I > 0 ? bL[(16 * I - 1) * 33 + 8 * qd + e] : 0.f; }
    f32x4 qa, qb2, qc, qd2;
#pragma unroll
    for (int e = 0; e < 4; ++e) { qa[e] = qv[e] * __expf(bt[e] - rI[e]); qb2[e] = qv[4 + e] * __expf(bt[4 + e] - rI[4 + e]); qc[e] = qv[e] * __expf(bt[e]); qd2[e] = qv[4 + e] * __expf(bt[4 + e]); }
    const bf16x8 qfI = pk8(qa, qb2), qfin = pk8(qc, qd2);
    f32x4 at[4];
#pragma unroll
    for (int J = 0; J < 4; ++J) { at[J] = (f32x4){0.f, 0.f, 0.f, 0.f};
        if (J < I) { const int j = 16 * J + ll; f32x4 ka, kb2;
#pragma unroll
            for (int e = 0; e < 4; ++e) { ka[e] = kL[j * 33 + 8 * qd + e] * __expf(rI[e] - bL[j * 33 + 8 * qd + e]); kb2[e] = kL[j * 33 + 8 * qd + 4 + e] * __expf(rI[4 + e] - bL[j * 33 + 8 * qd + 4 + e]); }
            at[J] = MFMA16(pk8(ka, kb2), qfI, at[J]); } }
    {
        f32x4 dsum = {0.f, 0.f, 0.f, 0.f};
#pragma unroll 8
        for (int c = 0; c < 32; ++c) { const float q_ = qL[t * 33 + c], b_ = bL[t * 33 + c];
#pragma unroll
            for (int r = 0; r < 4; ++r) { const int j = 16 * I + 4 * qd + r; dsum[r] += q_ * kL[j * 33 + c] * __expf(fminf(b_ - bL[j * 33 + c], 0.f)); } }
#pragma unroll
        for (int r = 0; r < 4; ++r) dsum[r] = (4 * qd + r <= ll) ? dsum[r] : 0.f;
#pragma unroll
        for (int J = 0; J < 4; ++J) if (J == I) at[J] = dsum;
    }
    bf16x8 pf[2]; pf[0] = pk8(at[0], at[1]); pf[1] = pk8(at[2], at[3]);
    f32x4 oacc[2]; float ss = 0.f;
#pragma unroll
    for (int cc = 0; cc < 2; ++cc) { const int cg = 2 * dh + cc; f32x4 acc = {0.f, 0.f, 0.f, 0.f};
#pragma unroll
        for (int g2 = 0; g2 < 2; ++g2) { const LAS bf16_t* vr = vt + (16 * cg + ll) * 72 + 32 * g2 + 4 * qd; acc = MFMA16(mk8(*(const LAS u32x2*)vr, *(const LAS u32x2*)(vr + 16)), pf[g2], acc); }
        acc = MFMA16(*(const LAS bf16x8*)(sT + (16 * cg + ll) * 40 + 8 * qd), qfin, acc);
        oacc[cc] = acc; ss += acc[0] * acc[0] + acc[1] * acc[1] + acc[2] * acc[2] + acc[3] * acc[3]; }
    ssL[t * 8 + dh * 4 + qd] = ss;
    __syncthreads();
    float tot = 0.f;
#pragma unroll
    for (int e = 0; e < 8; ++e) tot += ssL[t * 8 + e];
    const float rstd = rsqrtf(tot * (1.f / 64.f) + EPS);
#pragma unroll
    for (int cc = 0; cc < 2; ++cc) { const int d = 16 * (2 * dh + cc) + 4 * qd;
        const u32x2 rg = rgl[cc];
        const float rr[4] = {bflo(rg.x), bfhi(rg.x), bflo(rg.y), bfhi(rg.y)}; float ov[4];
#pragma unroll
        for (int e = 0; e < 4; ++e) ov[e] = oacc[cc][e] * rstd * p.gla_norm_g[l * 64 + d + e] * rr[e] * sigmoidf_(rr[e]);
        u32x2 o; o.x = pk2(ov[0], ov[1]); o.y = pk2(ov[2], ov[3]);
        *(u32x2*)((bf16_t*)(p.ws + OFF_O) + ((size_t)b * SEQ + ch * 64 + t) * DM + O_GLA + h * 64 + d) = o; }
    __syncthreads();
}

__device__ __forceinline__ void dn_prep_task(const Params& p, int l, LAS unsigned char* lds, int task) {
    const int tid = TIDX, bh = task >> 8, ch = task & 255, b = bh >> 2, h = bh & 3, t0 = ch * 64;
    const bf16_t* pb = (const bf16_t*)(p.ws + OFF_B) + (size_t)b * SEQ * NP;
    LAS float* qn = (LAS float*)lds; LAS float* kn = qn + 64 * 65; LAS float* vv = kn + 64 * 65; LAS float* Lw = vv + 64 * 65; LAS float* X = Lw + 64 * 65;
    LAS float* Gc = X + 64 * 129; LAS float* be = Gc + 64;
    LAS bf16_t* qb = (LAS bf16_t*)(be + 64); LAS bf16_t* kb = qb + 64 * 72;
    bf16_t graw_a = 0, graw_b = 0;
    if (tid < 64) { const bf16_t* pr0 = pb + (size_t)(t0 + tid) * NP; graw_a = pr0[C_DA + h]; graw_b = pr0[C_DB + h]; }
    {
        LAS float* cwL = (LAS float*)(kb + 64 * 72);
        if (tid < 192) *(LAS f32x4*)(cwL + tid * 4) = *(const f32x4*)(p.dn_conv_w + ((size_t)l * 768 + (tid >> 6) * 256 + h * 64 + (tid & 63)) * 4);
        u32x4 xd[3][4];
#pragma unroll
        for (int it = 0; it < 3; ++it) { const int q = tid + 512 * it, t = q / 24, cc8 = (q % 24) * 8, chg = (cc8 >> 6) * 256 + h * 64 + (cc8 & 63);
#pragma unroll
            for (int i = 0; i < 4; ++i) { const int tt = t0 + t - 3 + i; xd[it][i] = tt >= 0 ? *(const u32x4*)(pb + (size_t)tt * NP + C_DQKV + chg) : (u32x4){0u, 0u, 0u, 0u}; } }
        __syncthreads();
#pragma unroll
        for (int it = 0; it < 3; ++it) { const int q = tid + 512 * it, t = q / 24, cc8 = (q % 24) * 8, sec = cc8 >> 6, c = cc8 & 63;
            float acc[8];
#pragma unroll
            for (int e = 0; e < 8; ++e) acc[e] = 0.f;
#pragma unroll
            for (int i = 0; i < 4; ++i) { const u32x4 u = xd[it][i]; const float xs[8] = {bflo(u.x), bfhi(u.x), bflo(u.y), bfhi(u.y), bflo(u.z), bfhi(u.z), bflo(u.w), bfhi(u.w)};
#pragma unroll
                for (int e = 0; e < 8; ++e) acc[e] += cwL[(cc8 + e) * 4 + i] * xs[e]; }
            LAS float* dst = (sec == 0 ? qn : (sec == 1 ? kn : vv)) + t * 65 + c;
#pragma unroll
            for (int e = 0; e < 8; ++e) dst[e] = acc[e] * sigmoidf_(acc[e]); }
    }
    __syncthreads();
    { LAS float* row = ((tid >> 2) < 64 ? qn : kn) + ((tid >> 2) & 63) * 65 + (tid & 3) * 16; float ss = 0.f;
#pragma unroll
        for (int c = 0; c < 16; ++c) ss += row[c] * row[c];
        ss += __shfl_xor(ss, 1); ss += __shfl_xor(ss, 2);
        const float sc = rsqrtf(ss + EPS) * ((tid >> 2) < 64 ? 0.125f : 1.f);
        LAS bf16_t* rb = ((tid >> 2) < 64 ? qb : kb) + ((tid >> 2) & 63) * 72 + (tid & 3) * 16;
#pragma unroll
        for (int c = 0; c < 16; c += 2) { const float v0 = row[c] * sc, v1 = row[c + 1] * sc; row[c] = v0; row[c + 1] = v1; *(LAS unsigned*)(rb + c) = pk2(v0, v1); } }
    if (tid < 64) {
        be[tid] = sigmoidf_(bf2f(graw_b));
        float g = -__expf(p.dn_a_log[l * 4 + h]) * softplusf_(bf2f(graw_a) + p.dn_dt_bias[l * 4 + h]);
#pragma unroll
        for (int o = 1; o < 64; o <<= 1) { const float v = __shfl_up(g, o); if (tid >= o) g += v; }
        Gc[tid] = g; }
    __syncthreads();
    bf16_t* ob = (bf16_t*)(p.ws + OFF_DN) + (size_t)task * 5 * 4096;
    {
        const int wave = tid >> 6, lane = tid & 63, ll = lane & 15, qd = lane >> 4, ti = wave >> 1;
#pragma unroll
        for (int tt = 0; tt < 2; ++tt) { const int tj = (wave & 1) * 2 + tt;
            f32x4 ck = {0.f, 0.f, 0.f, 0.f}, cs = {0.f, 0.f, 0.f, 0.f};
            if (tj <= ti) {
#pragma unroll
                for (int k2 = 0; k2 < 2; ++k2) {
                    const bf16x8 ki = *(const LAS bf16x8*)(kb + (16 * ti + ll) * 72 + k2 * 32 + qd * 8), kj = *(const LAS bf16x8*)(kb + (16 * tj + ll) * 72 + k2 * 32 + qd * 8);
                    const bf16x8 qi = *(const LAS bf16x8*)(qb + (16 * ti + ll) * 72 + k2 * 32 + qd * 8);
                    ck = MFMA16(ki, kj, ck);
                    cs = MFMA16(kj, qi, cs);
                } }
#pragma unroll
            for (int r = 0; r < 4; ++r) { const int i = 16 * ti + 4 * qd + r, j = 16 * tj + ll;
                Lw[i * 65 + j] = j < i ? be[i] * ck[r] * __expf(Gc[i] - Gc[j]) : 0.f; }
            { const int i = 16 * ti + ll; float sv[4];
#pragma unroll
              for (int r = 0; r < 4; ++r) { const int j = 16 * tj + 4 * qd + r; sv[r] = j <= i ? cs[r] * __expf(Gc[i] - Gc[j]) : 0.f; }
              u32x2 o; o.x = pk2(sv[0], sv[1]); o.y = pk2(sv[2], sv[3]); *(u32x2*)(ob + 4 * 4096 + i * 64 + 16 * tj + 4 * qd) = o; }
        }
    }
    for (int idx = tid; idx < 4096; idx += 512) { const int i = idx >> 6, j = idx & 63;
        X[i * 129 + j] = vv[i * 65 + j] * be[i]; X[i * 129 + 64 + j] = kn[i * 65 + j] * be[i] * __expf(Gc[i]); }
    __syncthreads();
    {
        const int col = tid >> 2, part = tid & 3;
        float xr[16];
#pragma unroll
        for (int k = 0; k < 16; ++k) xr[k] = 0.f;
#pragma unroll
        for (int i = 0; i < 64; ++i) { float s0 = 0.f, s1 = 0.f;
#pragma unroll
            for (int k = 0; k < (i + 3) / 4; ++k) { const float t_ = Lw[i * 65 + 4 * k + part] * xr[k]; if (k & 1) s1 += t_; else s0 += t_; }
            s0 += s1; s0 += __shfl_xor(s0, 1); s0 += __shfl_xor(s0, 2);
            const float xi = X[i * 129 + col] - s0;
            if (part == (i & 3)) xr[i >> 2] = xi; }
#pragma unroll
        for (int k = 0; k < 16; ++k) X[(4 * k + part) * 129 + col] = xr[k];
    }
    __syncthreads();
    const float Gl = Gc[63];
    for (int i2 = tid; i2 < 2048; i2 += 512) { const int a = i2 >> 5, c = (i2 & 31) * 2;
        *(unsigned*)(ob + 0 * 4096 + a * 64 + c) = pk2(X[a * 129 + 64 + c], X[a * 129 + 65 + c]);
        *(unsigned*)(ob + 1 * 4096 + a * 64 + c) = pk2(kn[c * 65 + a] * __expf(Gl - Gc[c]), kn[(c + 1) * 65 + a] * __expf(Gl - Gc[c + 1]));
        *(unsigned*)(ob + 2 * 4096 + a * 64 + c) = pk2(X[c * 129 + a], X[(c + 1) * 129 + a]);
        const float eg = __expf(Gc[a]);
        *(unsigned*)(ob + 3 * 4096 + a * 64 + c) = pk2(qn[a * 65 + c] * eg, qn[a * 65 + c + 1] * eg); }
    if (tid == 0) ((float*)(p.ws + OFF_DNA))[task] = __expf(Gl);
    __syncthreads();
}
__device__ __forceinline__ void dn_scan_task(const Params& p, int l, LAS unsigned char* lds, int task) {
    constexpr int RS = 72, MATB = 64 * RS * 2  , STG = 4 * MATB + 16 * RS * 2;
    const int tid = TIDX, wave = tid >> 6, lane = tid & 63, ll = lane & 15, qd = lane >> 4, bh = task >> 2, b = bh >> 2, h = bh & 3;
    const bf16_t* cb = (const bf16_t*)(p.ws + OFF_DN) + (size_t)bh * 256 * 5 * 4096;
    const float* al = (const float*)(p.ws + OFF_DNA) + bh * 256;
    const int lrow = tid >> 3, lc8 = tid & 7;
    LAS float* alL = (LAS float*)(lds + 3 * STG);
    if (tid < 256) alL[tid] = al[tid];
    u32x4 pre[3][5];
    const int d0 = (task & 3) * 16;
#define DN_ISSUE(n, st) do { const int n_ = (n) < 255 ? (n) : 255; _Pragma("unroll") for (int m_ = 0; m_ < 4; ++m_) pre[st][m_] = *(const u32x4*)(cb + ((size_t)n_ * 5 + (m_ < 2 ? m_ : m_ + 1)) * 4096 + tid * 8); \
        pre[st][4] = *(const u32x4*)(cb + ((size_t)n_ * 5 + 2) * 4096 + d0 * 64 + (tid & 127) * 8); } while (0)
#define DN_COMMIT(st) do { LAS unsigned char* sb_ = lds + (st) * STG; _Pragma("unroll") for (int m_ = 0; m_ < 4; ++m_) *(LAS u32x4*)(sb_ + m_ * MATB + lrow * (RS * 2) + lc8 * 16) = pre[st][m_]; \
        if (tid < 128) *(LAS u32x4*)(sb_ + 4 * MATB + lrow * (RS * 2) + lc8 * 16) = pre[st][4]; } while (0)
    DN_ISSUE(0, 0); DN_ISSUE(1, 1); DN_COMMIT(0); DN_COMMIT(1); DN_ISSUE(2, 2); DN_ISSUE(3, 0); DN_ISSUE(4, 1);
    f32x4 S[4];
#pragma unroll
    for (int m = 0; m < 4; ++m) S[m] = (f32x4){0.f, 0.f, 0.f, 0.f};
    __syncthreads();
#define DN_FRAG(mat, mt, k2) ({ const LAS bf16_t* _r = (const LAS bf16_t*)(sb + (mat) * MATB) + (16 * (mt) + ll) * RS + 32 * (k2) + 4 * qd; mk8(*(const LAS u32x2*)_r, *(const LAS u32x2*)(_r + 16)); })
#define DN_STEP(n, st) do { \
        DN_COMMIT(((st) + 2) % 3); \
        DN_ISSUE((n) + 5, ((st) + 2) % 3); \
        if (wave < 1) { \
            const LAS unsigned char* sb = lds + (st) * STG; \
              \
            u32x2 uc[4]; bf16x8 fw[4][2], fk[4][2], fq[4][2], fs[4][2]; \
            _Pragma("unroll") for (int m = 0; m < 4; ++m) _Pragma("unroll") for (int k2 = 0; k2 < 2; ++k2) fw[m][k2] = DN_FRAG(0, m, k2); \
            _Pragma("unroll") for (int m = 0; m < 4; ++m) uc[m] = *(const LAS u32x2*)((const LAS bf16_t*)(sb + 4 * MATB) + ll * RS + 16 * m + 4 * qd); \
            _Pragma("unroll") for (int m = 0; m < 4; ++m) _Pragma("unroll") for (int k2 = 0; k2 < 2; ++k2) fk[m][k2] = DN_FRAG(1, m, k2); \
            const float a = alL[n]; \
            __builtin_amdgcn_sched_barrier(0); \
            bf16x8 Sb[2], Vb[2]; \
            Sb[0] = pk8(S[0], S[1]); Sb[1] = pk8(S[2], S[3]); \
            f32x4 vn[4], oo[4]; \
            _Pragma("unroll") for (int m = 0; m < 4; ++m) { f32x4 acc = {0.f, 0.f, 0.f, 0.f}; \
                _Pragma("unroll") for (int k2 = 0; k2 < 2; ++k2) acc = MFMA16(fw[m][k2], Sb[k2], acc); \
                vn[m][0] = bflo(uc[m].x) - acc[0]; vn[m][1] = bfhi(uc[m].x) - acc[1]; vn[m][2] = bflo(uc[m].y) - acc[2]; vn[m][3] = bfhi(uc[m].y) - acc[3]; } \
            Vb[0] = pk8(vn[0], vn[1]); Vb[1] = pk8(vn[2], vn[3]); \
            _Pragma("unroll") for (int m = 0; m < 4; ++m) _Pragma("unroll") for (int k2 = 0; k2 < 2; ++k2) { fq[m][k2] = DN_FRAG(2, m, k2); fs[m][k2] = DN_FRAG(3, m, k2); } \
            __builtin_amdgcn_sched_barrier(0); \
            _Pragma("unroll") for (int m = 0; m < 4; ++m) { f32x4 acc = S[m] * a; \
                _Pragma("unroll") for (int k2 = 0; k2 < 2; ++k2) acc = MFMA16(fk[m][k2], Vb[k2], acc); \
                S[m] = acc; } \
            _Pragma("unroll") for (int m = 0; m < 4; ++m) { f32x4 acc = {0.f, 0.f, 0.f, 0.f};   \
                _Pragma("unroll") for (int k2 = 0; k2 < 2; ++k2) { acc = MFMA16(Sb[k2], fq[m][k2], acc); acc = MFMA16(Vb[k2], fs[m][k2], acc); } \
                oo[m] = acc; } \
            bf16_t* op = (bf16_t*)(p.ws + OFF_O) + ((size_t)b * SEQ + (n) * 64 + ll) * DM + O_DN + h * 64 + d0 + 4 * qd; \
            _Pragma("unroll") for (int m = 0; m < 4; ++m) { u32x2 o; o.x = pk2(oo[m][0], oo[m][1]); o.y = pk2(oo[m][2], oo[m][3]); *(u32x2*)(op + (size_t)(16 * m) * DM) = o; } \
        } \
        __syncthreads(); \
    } while (0)
    for (int n = 0; n < 255; n += 3) { DN_STEP(n, 0); DN_STEP(n + 1, 1); DN_STEP(n + 2, 2); }
    DN_STEP(255, 0);
#undef DN_STEP
#undef DN_FRAG
#undef DN_ISSUE
#undef DN_COMMIT
}
__device__ __forceinline__ void dn_norm_task(const Params& p, int l, int task8) {
    const int tid = TIDX, d8 = (tid & 7) * 8;
    u32x4 uu[8], gg[8];
#pragma unroll
    for (int sub = 0; sub < 8; ++sub) { const int pair = (task8 * 8 + sub) * 64 + (tid >> 3), tok = pair >> 2, h = pair & 3;
        uu[sub] = *(const u32x4*)((const bf16_t*)(p.ws + OFF_O) + (size_t)tok * DM + O_DN + h * 64 + d8);
        gg[sub] = *(const u32x4*)((const bf16_t*)(p.ws + OFF_B) + (size_t)tok * NP + C_DG + h * 64 + d8); }
    float gn[8];
#pragma unroll
    for (int e = 0; e < 8; ++e) gn[e] = p.dn_norm_g[l * 64 + d8 + e];
#pragma unroll
    for (int sub = 0; sub < 8; ++sub) { const int pair = (task8 * 8 + sub) * 64 + (tid >> 3), tok = pair >> 2, h = pair & 3;
        const u32x4 u = uu[sub], gt = gg[sub];
        const float ov[8] = {bflo(u.x), bfhi(u.x), bflo(u.y), bfhi(u.y), bflo(u.z), bfhi(u.z), bflo(u.w), bfhi(u.w)};
        const float gv[8] = {bflo(gt.x), bfhi(gt.x), bflo(gt.y), bfhi(gt.y), bflo(gt.z), bfhi(gt.z), bflo(gt.w), bfhi(gt.w)};
        float ss = 0.f;
#pragma unroll
        for (int e = 0; e < 8; ++e) ss += ov[e] * ov[e];
        ss += __shfl_xor(ss, 1); ss += __shfl_xor(ss, 2); ss += __shfl_xor(ss, 4);
        const float rstd = rsqrtf(ss * (1.f / 64.f) + EPS);
        float r[8];
#pragma unroll
        for (int e = 0; e < 8; ++e) r[e] = ov[e] * rstd * gn[e] * gv[e] * sigmoidf_(gv[e]);
        u32x4 o; o.x = pk2(r[0], r[1]); o.y = pk2(r[2], r[3]); o.z = pk2(r[4], r[5]); o.w = pk2(r[6], r[7]);
        *(u32x4*)((bf16_t*)(p.ws + OFF_O) + (size_t)tok * DM + O_DN + h * 64 + d8) = o; }
}

__device__ __forceinline__ int next_task(int* cnt, LAS int* slot, int& pre) {
    __syncthreads();
    if (TIDX == 0) *slot = pre;
    __syncthreads();
    const int t = __builtin_amdgcn_readfirstlane(*slot);
    if (TIDX == 0) pre = atomicAdd(cnt, 1);
    return t;
}
__device__ __forceinline__ void mix_phase(const Params& p, int l, int k, LAS unsigned char* lds) {
    const int xcc = (int)((unsigned)__builtin_amdgcn_s_getreg((3 << 11) | 20) & 7u);
    int* cnt = (int*)((unsigned*)(p.ws + OFF_BAR) + 3456  ) + ((l * 3 + k) * 8 + xcc) * 4;
#define XQ_MAP(i_) ((((i_) >> 2) * 8 + xcc) * 4 + ((i_) & 3))
    LAS int* slot = (LAS int*)(lds + LDS_BYTES + 16);
    int pre = 0; if (TIDX == 0) pre = atomicAdd(cnt, 1);
    unsigned* gready = (unsigned*)(p.ws + OFF_CNT) + 32 + l * 8;
    if (k == 0) {
        for (;;) { int t = next_task(cnt, slot, pre); t = XQ_MAP(t);
            if (t < 2048) { dn_prep_task(p, l, lds, t); continue; } t -= 2048;
            if (t < 1024) { dil_task(p, l, lds, 0, t); continue; } t -= 1024;
            if (t < 2048) { gla_a_task(p, l, lds, t); continue; }
            break; }
    } else if (k == 1) {
        for (;;) { int t = next_task(cnt, slot, pre); t = XQ_MAP(t);
            if (t < 32) { dn_scan_task(p, l, lds, t); continue; } t -= 32;
            if (t < 32) { gla_scan_task(p, lds, t, gready + (t >> 2)); continue; } t -= 32;
            if (t < 1024) { sb_task(p, l, lds, t); continue; } t -= 1024;
            if (t < 1024) { dil_task(p, l, lds, 1, t); continue; } t -= 1024;
            if (t < 2048) { gla_c_task(p, l, lds, t, gready); continue; }
            break; }
    } else {
        for (;;) { int t = next_task(cnt, slot, pre); t = XQ_MAP(t);
            if (t < 1024) { dil_task(p, l, lds, 2, t); continue; } t -= 1024;
            if (t < 256) { dn_norm_task(p, l, t); continue; }
            break; }
    }
}
#undef XQ_MAP

#define XB_TMO      128
#define XB_XCNT(j)  (256  + 64 * (j))
#define XB_XSUB(j)  (1280 + 64 * (j))
#define XB_XGEN(j)  (2304 + 64 * (j))
#define XB_TOP      3328
#define XB_TOPGEN   3392
#define XCD_BAR_WORDS 3456
#define XB_SPIN_CAP (1u << 22)
__device__ __forceinline__ unsigned xb_ld(unsigned* p)              { return __hip_atomic_load(p, __ATOMIC_RELAXED, __HIP_MEMORY_SCOPE_AGENT); }
__device__ __forceinline__ unsigned xb_add(unsigned* p, unsigned v) { return __hip_atomic_fetch_add(p, v, __ATOMIC_RELAXED, __HIP_MEMORY_SCOPE_AGENT); }
__device__ __forceinline__ unsigned xb_xcc_id() { return (unsigned)__builtin_amdgcn_s_getreg((3 << 11) | 20) & 0xFu; }
#define XB_SPIN(cond, bar) do { unsigned _sp = 0; while (cond) { __builtin_amdgcn_s_sleep(1); \
    if ((++_sp & 255u) == 0u) { if (xb_ld(&(bar)[XB_TMO])) break; if (_sp > XB_SPIN_CAP) { atomicAdd(&(bar)[XB_TMO], 1u); break; } } } } while (0)
struct XcdBarrier { unsigned* bar; unsigned x; volatile LAS unsigned* st; };
__device__ __forceinline__ XcdBarrier xcd_barrier_post(unsigned* bar, volatile LAS unsigned* st) {
    XcdBarrier b; b.bar = bar; b.x = xb_xcc_id(); b.st = st;
    if (TIDX == 0) (void)xb_add(&bar[XB_XCNT(b.x)], 1u);
    return b;
}
__device__ __forceinline__ void xcd_barrier_complete(unsigned* bar, unsigned x, unsigned& nloc, unsigned& nx) {
    const unsigned G = gridDim.x * gridDim.y * gridDim.z;
    unsigned sum, cnt, mine, sp = 0u;
    for (;;) {
        sum = 0u; cnt = 0u; mine = 0u;
#pragma unroll
        for (unsigned j = 0; j < 16; ++j) { const unsigned c = xb_ld(&bar[XB_XCNT(j)]); sum += c; cnt += (c > 0u) ? 1u : 0u; mine = (j == x) ? c : mine; }
        if (sum == G) break;
        __builtin_amdgcn_s_sleep(1);
        if ((++sp & 255u) == 0u) { if (xb_ld(&bar[XB_TMO])) break; if (sp > XB_SPIN_CAP) { atomicAdd(&bar[XB_TMO], 1u); break; } }
    }
    nloc = mine > 0u ? mine : 1u; nx = cnt > 0u ? cnt : 1u;
}
__device__ __forceinline__ void xcd_barrier(const XcdBarrier& b) {
    asm volatile("s_waitcnt vmcnt(0)" ::: "memory");
    __syncthreads();
    if (TIDX == 0) {
        unsigned* bar = b.bar;
        __builtin_amdgcn_s_waitcnt(0);
        unsigned nloc = b.st[0], nx = b.st[1];
        if (nloc == 0u) { xcd_barrier_complete(bar, b.x, nloc, nx); b.st[0] = nloc; b.st[1] = nx; }
        const unsigned old = xb_add(&bar[XB_XSUB(b.x)], 1u);
        const unsigned gen = old / nloc;
        if (old + 1u == (gen + 1u) * nloc) {
            __builtin_amdgcn_fence(__ATOMIC_RELEASE, "agent");
            asm volatile("s_waitcnt vmcnt(0)" ::: "memory");
            const unsigned og = xb_add(&bar[XB_TOP], 1u);
            const unsigned tg = og / nx;
            if (og + 1u == (tg + 1u) * nx) xb_add(&bar[XB_TOPGEN], 1u);
            else XB_SPIN(xb_ld(&bar[XB_TOPGEN]) == tg, bar);
            __builtin_amdgcn_fence(__ATOMIC_ACQUIRE, "agent");
            xb_add(&bar[XB_XGEN(b.x)], 1u);
            asm volatile("s_waitcnt vmcnt(0)" ::: "memory");
        } else {
            XB_SPIN(xb_ld(&bar[XB_XGEN(b.x)]) == gen, bar);
            __builtin_amdgcn_fence(__ATOMIC_ACQUIRE, "agent");
            asm volatile("s_waitcnt vmcnt(0)" ::: "memory");
        }
    }
    __syncthreads();
}

__global__ void __launch_bounds__(512) fwd_kernel(Params p) {
    extern __shared__ __attribute__((aligned(16))) unsigned char shm[];
    LAS unsigned char* lds = (LAS unsigned char*)shm;
    cg::grid_group grid = cg::this_grid();
    unsigned char* ws = p.ws;
    volatile LAS unsigned* bst = (volatile LAS unsigned*)(lds + LDS_BYTES);
    if (TIDX < 2) bst[TIDX] = 0u;
    __syncthreads();
    XcdBarrier gbar; gbar.bar = (unsigned*)(ws + OFF_BAR); gbar.x = 0; gbar.st = bst;
    if (p.ph_hi - p.ph_lo > 1) gbar = xcd_barrier_post((unsigned*)(ws + OFF_BAR), bst);
    if (p.ph_hi > 1000000) grid.sync();
    for (int ph = p.ph_lo; ph < p.ph_hi; ++ph) {
        const int l = ph / NPH, k = ph % NPH;
        const float* xin = (l == 0) ? p.x : p.out;
        if (k == 0) {
            wconv_phase(p, l, lds);
            rmsnorm_phase(xin, p.g_mix + l * DM, (bf16_t*)(ws + OFF_H));
        } else if (k == 8) {
            rmsnorm_phase(p.out, p.g_mlp + l * DM, (bf16_t*)(ws + OFF_H));
        } else if (k >= 2 && k <= 4) {
            mix_phase(p, l, k - 2, lds);
        } else {
            pg8::Epi E; E.mode = 0; E.O = (bf16_t*)(ws + OFF_B); E.ldc = NP; E.Xin = xin; E.Xout = p.out; E.Y = (const bf16_t*)(ws + OFF_B);
            const bf16_t* A = (const bf16_t*)(ws + OFF_H); const bf16_t* Bt = (const bf16_t*)(ws + OFF_WIN); int lda = DM, a_sh = 0, a_mul = 0, N = NP, K = DM;
            if (k == 5) { E.ldc = 4096; A = (const bf16_t*)(ws + OFF_O); a_sh = 2; a_mul = 256; Bt = (const bf16_t*)(ws + OFF_WB); N = 4096; K = 256; }
            else if (k == 6) { E.mode = 3; E.O = (bf16_t*)(ws + OFF_O); Bt = (const bf16_t*)(ws + OFF_WG); N = 4096; }
            else if (k == 7) { E.mode = 2; A = (const bf16_t*)(ws + OFF_O); Bt = (const bf16_t*)(ws + OFF_WO); N = DM; }
            else if (k == 9) { E.mode = 1; E.ldc = DFF; Bt = (const bf16_t*)(ws + OFF_W1); N = DFF; }
            else if (k == 10) { E.mode = 2; E.Xin = p.out; A = (const bf16_t*)(ws + OFF_B); lda = DFF; Bt = (const bf16_t*)(ws + OFF_W2); N = DM; K = DFF; }
            run_gemm(lds, A, lda, a_sh, a_mul, Bt, N, K, E);
        }
        if (ph + 1 < p.ph_hi) xcd_barrier(gbar);
    }
}

#ifndef ONE_LAUNCH
#define ONE_LAUNCH 1
#endif
extern "C" void kernel_launch(void* const* d_in, const int* in_sizes, int n_in, void* d_out, int out_size, void* d_ws, size_t ws_size, hipStream_t stream) {
    static int grid = 0;
    if (grid == 0) {
        if (n_in != 17 || out_size != T_TOK * DM || ws_size < WS_END) { fprintf(stderr, "kernel_launch: unexpected shapes / workspace (%zu < %zu)\n", ws_size, (size_t)WS_END); grid = -1; return; }
        int dev = 0, cus = 0, per_cu = 0;
        hipGetDevice(&dev); hipDeviceGetAttribute(&cus, hipDeviceAttributeMultiprocessorCount, dev);
        if (hipFuncSetAttribute((const void*)fwd_kernel, hipFuncAttributeMaxDynamicSharedMemorySize, LDS_TOTAL) != hipSuccess) { fprintf(stderr, "hipFuncSetAttribute failed\n"); grid = -1; return; }
        if (hipOccupancyMaxActiveBlocksPerMultiprocessor(&per_cu, (const void*)fwd_kernel, 512, LDS_TOTAL) != hipSuccess || per_cu < 1) per_cu = 1;
        grid = cus * per_cu;
    }
    if (grid < 0) return;
    Params p{};
    p.x = (const float*)d_in[0]; p.g_mix = (const float*)d_in[1]; p.g_mlp = (const float*)d_in[2]; p.w_in = (const float*)d_in[3]; p.gla_w_lr2 = (const float*)d_in[4];
    p.gla_b_lr = (const float*)d_in[5]; p.gla_norm_g = (const float*)d_in[6]; p.dn_conv_w = (const float*)d_in[7]; p.dn_a_log = (const float*)d_in[8]; p.dn_dt_bias = (const float*)d_in[9];
    p.dn_norm_g = (const float*)d_in[10]; p.dil_q_g = (const float*)d_in[11]; p.dil_k_g = (const float*)d_in[12]; p.w_branch = (const float*)d_in[13]; p.w_out = (const float*)d_in[14];
    p.w_mlp_in = (const float*)d_in[15]; p.w_mlp_out = (const float*)d_in[16]; p.out = (float*)d_out; p.ws = (unsigned char*)d_ws;
    if (hipMemsetAsync((char*)d_ws + OFF_CNT, 0, 256 + 16384, stream) != hipSuccess) { fprintf(stderr, "memset failed\n"); return; }
#if ONE_LAUNCH
    p.ph_lo = 0; p.ph_hi = NLAYER * NPH;
    void* args[] = {&p};
    hipError_t e = hipLaunchCooperativeKernel((const void*)fwd_kernel, dim3(grid), dim3(512), args, LDS_TOTAL, stream);
    if (e != hipSuccess) fprintf(stderr, "cooperative launch failed: %s (grid %d)\n", hipGetErrorString(e), grid);
#else
    for (int ph = 0; ph < NLAYER * NPH; ++ph) { p.ph_lo = ph; p.ph_hi = ph + 1; hipLaunchKernelGGL(fwd_kernel, dim3(grid), dim3(512), LDS_TOTAL, stream, p); }
#endif
}
```

```cpp
#include <hip/hip_runtime.h>
#include <hip/hip_cooperative_groups.h>
#include <cstdio>
namespace cg = cooperative_groups;

#define LAS __attribute__((address_space(3)))
typedef unsigned short bf16_t;
typedef short bf16x8 __attribute__((ext_vector_type(8)));
typedef short bf16x4 __attribute__((ext_vector_type(4)));
typedef float f32x4 __attribute__((ext_vector_type(4)));
typedef unsigned u32x4 __attribute__((ext_vector_type(4)));
typedef unsigned u32x2 __attribute__((ext_vector_type(2)));

constexpr int T_TOK = 32768, SEQ = 16384, DM = 1024, NP = 3584, DFF = 4096;
constexpr int C_SBQ = 0, C_SBK = 256, C_SBV = 512, C_GQ = 768, C_GK = 896, C_GV = 1024, C_GLR = 1280, C_GR = 1296, C_DQKV = 1552, C_DA = 2320, C_DB = 2324,
              C_DG = 2328, C_LQ = 2584, C_LK = 2840, C_LV = 3096, C_GATE = 3352, N_IN = 7448;
constexpr int O_SB = 0, O_GLA = 256, O_DN = 512, O_DIL = 768;
constexpr float EPS = 1e-6f;
constexpr int NLAYER = 4, NPH = 11;
constexpr size_t SZ_WIN = (size_t)NP * DM * 2, SZ_WG = (size_t)4096 * DM * 2, SZ_WB = (size_t)4096 * 256 * 2, SZ_WO = (size_t)DM * DM * 2, SZ_W1 = (size_t)DFF * DM * 2, SZ_W2 = (size_t)DM * DFF * 2;
constexpr size_t OFF_WIN = 0, OFF_WG = OFF_WIN + SZ_WIN, OFF_WB = OFF_WG + SZ_WG, OFF_WO = OFF_WB + SZ_WB, OFF_W1 = OFF_WO + SZ_WO, OFF_W2 = OFF_W1 + SZ_W1;
constexpr size_t OFF_B = OFF_W2 + SZ_W2;
constexpr size_t SZ_B = (size_t)T_TOK * 4096 * 2;
constexpr size_t OFF_GLAU = OFF_B + (size_t)T_TOK * NP * 2;
constexpr size_t OFF_GLAA = OFF_GLAU + (size_t)2048 * 2048 * 4;
constexpr size_t OFF_DSTAT = OFF_GLAA + (size_t)2048 * 32 * 4;
constexpr size_t OFF_DNA = OFF_DSTAT + (size_t)T_TOK * 4 * 2 * 4;
constexpr size_t OFF_H = OFF_B + SZ_B;
constexpr size_t OFF_O = OFF_H + (size_t)T_TOK * DM * 2;
constexpr size_t OFF_DN = OFF_O + (size_t)T_TOK * DM * 2;
constexpr size_t OFF_CNT = OFF_DN + (size_t)2048 * 5 * 8192;
constexpr size_t OFF_BAR = OFF_CNT + 256;
constexpr size_t WS_END = OFF_BAR + 16384;
static_assert(OFF_DNA + 2048 * 4 <= OFF_H, "region B overflow");
constexpr int LDS_BYTES = 131072, LDS_TOTAL = LDS_BYTES + 64;

struct Params {
    const float* x; const float* g_mix; const float* g_mlp; const float* w_in; const float* gla_w_lr2; const float* gla_b_lr; const float* gla_norm_g;
    const float* dn_conv_w; const float* dn_a_log; const float* dn_dt_bias; const float* dn_norm_g; const float* dil_q_g; const float* dil_k_g;
    const float* w_branch; const float* w_out; const float* w_mlp_in; const float* w_mlp_out;
    float* out; unsigned char* ws; int ph_lo, ph_hi;
};

typedef __bf16 bf16v2_t __attribute__((ext_vector_type(2)));
typedef float f32v2_t __attribute__((ext_vector_type(2)));
__device__ __forceinline__ unsigned pk2(float lo, float hi) { f32v2_t v = {lo, hi}; bf16v2_t b = __builtin_convertvector(v, bf16v2_t); return __builtin_bit_cast(unsigned, b); }
__device__ __forceinline__ float bf2f(bf16_t b) { return __uint_as_float(((unsigned)b) << 16); }
__device__ __forceinline__ float bflo(unsigned u) { return __uint_as_float(u << 16); }
__device__ __forceinline__ float bfhi(unsigned u) { return __uint_as_float(u & 0xffff0000u); }
__device__ __forceinline__ bf16_t f2bf(float f) { return (bf16_t)(pk2(f, 0.f) & 0xffffu); }
__device__ __forceinline__ float wave_sum(float v) {
#pragma unroll
    for (int o = 1; o < 64; o <<= 1) v += __shfl_xor(v, o);
    return v;
}
__device__ __forceinline__ float sigmoidf_(float x) { return 1.f / (1.f + __expf(-x)); }
__device__ __forceinline__ float sigmoid_fast(float x) { return __builtin_amdgcn_rcpf(1.f + __expf(-x)); }
__device__ __forceinline__ float softplusf_(float z) { return fmaxf(z, 0.f) + __logf(1.f + __expf(-fabsf(z))); }
__device__ __forceinline__ bf16x8 mk8(u32x2 a, u32x2 b) { u32x4 t; t.x = a.x; t.y = a.y; t.z = b.x; t.w = b.y; return __builtin_bit_cast(bf16x8, t); }
__device__ __forceinline__ bf16x8 pk8(f32x4 a, f32x4 b) { u32x4 t; t.x = pk2(a[0], a[1]); t.y = pk2(a[2], a[3]); t.z = pk2(b[0], b[1]); t.w = pk2(b[2], b[3]); return __builtin_bit_cast(bf16x8, t); }
__device__ __forceinline__ int tid_opaque() { int t = (int)threadIdx.x; asm volatile("" : "+v"(t)); return t; }
#define TIDX tid_opaque()
#define MFMA16(a, b, c) __builtin_amdgcn_mfma_f32_16x16x32_bf16((a), (b), (c), 0, 0, 0)

namespace pg8 {
constexpr int BM = 256, BK = 64, HALF = 128, HTB = HALF * BK * 2, NXCD = 8, WGM = 8;
__device__ __forceinline__ int lds_byte(int r, int c) { const int st = (r >> 4) * 2 + (c >> 5), rr = r & 15, cc = c & 31, ob = rr * 64 + cc * 2; return st * 1024 + (ob ^ (((ob >> 9) & 1) << 5)); }
__device__ __forceinline__ void stage_rc(int b, int& R, int& C) { const int st = b / 1024, sb = b % 1024, swz = sb ^ (((sb >> 9) & 1) << 5); R = (st >> 1) * 16 + swz / 64; C = (st & 1) * 32 + (swz % 64) / 2; }
__device__ __forceinline__ int perm32(int rho) { const int n = rho >> 4, i = rho & 15; return 8 * (i >> 2) + 4 * n + (i & 3); }
struct Unit { int pm, pn; };
struct Gemm { const bf16_t* A; const bf16_t* Bt; int M, N, K, lda, a_sh, a_mul; };
struct StaticOrder {
    int nM, nN, nwg, G, c;
    __device__ void init(int M, int N, int G_, int c_) { nM = M / BM; nN = N / BM; nwg = nM * nN; G = G_; c = c_; }
    __device__ bool next(int i, Unit& u) const {
        const long L = (long)i * G + c; if (L >= nwg) return false;
        int wgid = (int)L; { const int q = nwg / NXCD, r = nwg % NXCD, xcd = wgid % NXCD, off = wgid / NXCD; wgid = (xcd < r ? xcd * (q + 1) : r * (q + 1) + (xcd - r) * q) + off; }
        const int nig = WGM * nN, gid = wgid / nig, fm = gid * WGM, gsz = (nM - fm) < WGM ? (nM - fm) : WGM;
        u.pm = fm + ((wgid % nig) % gsz); u.pn = (wgid % nig) / gsz; return true;
    }
};
struct Epi {
    int mode; bf16_t* O; int ldc; const float* Xin; float* Xout; const bf16_t* Y;
    __device__ __forceinline__ void operator()(const f32x4 (&acc)[2][2][4][2], const Unit& u, int wr, int wc, int fr, int fq) const {
        const int row0 = u.pm * BM + wr * 64 + fr;
        if (mode < 2) {
            const int col0 = u.pn * BM + wc * 32 + 8 * fq;
#pragma unroll
            for (int ai = 0; ai < 2; ++ai)
#pragma unroll
                for (int m = 0; m < 4; ++m) { bf16_t* rowp = O + (size_t)(row0 + ai * HALF + m * 16) * ldc + col0;
#pragma unroll
                    for (int bj = 0; bj < 2; ++bj) { f32x4 v0 = acc[ai][bj][m][0], v1 = acc[ai][bj][m][1];
                        if (mode == 1) {
#pragma unroll
                            for (int j = 0; j < 4; ++j) { float a = fmaxf(v0[j], 0.f), b = fmaxf(v1[j], 0.f); v0[j] = a * a; v1[j] = b * b; } }
                        u32x4 o; o.x = pk2(v0[0], v0[1]); o.y = pk2(v0[2], v0[3]); o.z = pk2(v1[0], v1[1]); o.w = pk2(v1[2], v1[3]);
                        *(u32x4*)(rowp + bj * HALF) = o; } }
        } else if (mode == 2) {
            const int col0 = u.pn * BM + wc * 32 + 4 * fq;
#pragma unroll
            for (int ai = 0; ai < 2; ++ai) { f32x4 xi[4][2][2];
#pragma unroll
                for (int m = 0; m < 4; ++m) { const size_t ro = (size_t)(row0 + ai * HALF + m * 16) * DM + col0;
#pragma unroll
                    for (int bj = 0; bj < 2; ++bj)
#pragma unroll
                        for (int n = 0; n < 2; ++n) xi[m][bj][n] = *(const f32x4*)(Xin + ro + bj * HALF + n * 16); }
                __builtin_amdgcn_sched_barrier(0);
#pragma unroll
                for (int m = 0; m < 4; ++m) { const size_t ro = (size_t)(row0 + ai * HALF + m * 16) * DM + col0;
#pragma unroll
                    for (int bj = 0; bj < 2; ++bj)
#pragma unroll
                        for (int n = 0; n < 2; ++n) *(f32x4*)(Xout + ro + bj * HALF + n * 16) = xi[m][bj][n] + acc[ai][bj][m][n]; }
                __builtin_amdgcn_sched_barrier(0); }
        } else {
            const int ch0 = u.pn * 64 + wc * 16 + 4 * fq;
#pragma unroll
            for (int ai = 0; ai < 2; ++ai) { u32x2 y[4][2][2];
#pragma unroll
                for (int m = 0; m < 4; ++m) { const size_t row = (size_t)(row0 + ai * HALF + m * 16);
#pragma unroll
                    for (int bj = 0; bj < 2; ++bj)
#pragma unroll
                        for (int n = 0; n < 2; ++n) y[m][bj][n] = *(const u32x2*)(Y + row * 4096 + (2 * bj + n) * 1024 + ch0); }
                __builtin_amdgcn_sched_barrier(0);
#pragma unroll
                for (int m = 0; m < 4; ++m) { const size_t row = (size_t)(row0 + ai * HALF + m * 16); f32x4 s = {0.f, 0.f, 0.f, 0.f};
#pragma unroll
                    for (int bj = 0; bj < 2; ++bj)
#pragma unroll
                        for (int n = 0; n < 2; ++n) { const u32x2 yy = y[m][bj][n]; const f32x4 a = acc[ai][bj][m][n];
                            s[0] += sigmoid_fast(a[0]) * bflo(yy.x); s[1] += sigmoid_fast(a[1]) * bfhi(yy.x); s[2] += sigmoid_fast(a[2]) * bflo(yy.y); s[3] += sigmoid_fast(a[3]) * bfhi(yy.y); }
                    u32x2 o; o.x = pk2(s[0], s[1]); o.y = pk2(s[2], s[3]); *(u32x2*)(O + row * DM + ch0) = o; }
                __builtin_amdgcn_sched_barrier(0); }
        }
    }
};

__device__ __forceinline__ void gemm_phase(LAS unsigned char* lds, const Gemm g, const StaticOrder& S, const Epi& E) {
    const int tid = TIDX, wid = __builtin_amdgcn_readfirstlane(tid >> 6), lane = tid & 63, wr = wid >> 2, wc = wid & 3, fr = lane & 15, fq = lane >> 4;
    const int K = g.K, nt = K / BK, lda = g.lda;
    unsigned voffA[2], voffB[2];
#pragma unroll
    for (int i = 0; i < 2; ++i) { int R, C; stage_rc(tid * 16 + i * 8192, R, C); const int Rb = (E.mode < 2) ? ((R & ~31) + perm32(R & 31)) : R;
        voffA[i] = (unsigned)(R * lda + C) * 2u; voffB[i] = (unsigned)(Rb * K + C) * 2u; }
    const size_t kstep = (size_t)(BK * 2);
    const size_t hstepA = (size_t)HALF * lda * 2, hstepB = (size_t)HALF * K * 2;
    const size_t tstepA = 2 * hstepA, tstepB = 2 * hstepB;
    const unsigned ldsw = (unsigned)wid * 1024u;
    const int aoff = lds_byte(wr * 64 + fr, fq * 8), boff = lds_byte(wc * 32 + fr, fq * 8);
#define PG8_SA(b, h) (((b) * 2 + (h)) * HTB)
#define PG8_SB(b, h) ((4 + (b) * 2 + (h)) * HTB)
#define PG8_STAGE(bufoff, gbase, voff) do { _Pragma("unroll") for (int _i = 0; _i < 2; ++_i) \
        __builtin_amdgcn_global_load_lds((const unsigned*)((const char*)(gbase) + (voff)[_i]), (LAS unsigned*)(lds + (bufoff) + ldsw + _i * 8192), 16, 0, 0); } while (0)
#define PG8_LDA(dst, b, h) do { _Pragma("unroll") for (int m = 0; m < 4; ++m) _Pragma("unroll") for (int k = 0; k < 2; ++k) dst[m][k] = *(const LAS bf16x8*)(lds + PG8_SA(b, h) + aoff + m * 2048 + k * 1024); } while (0)
#define PG8_LDB(dst, b, h) do { _Pragma("unroll") for (int n = 0; n < 2; ++n) _Pragma("unroll") for (int k = 0; k < 2; ++k) dst[n][k] = *(const LAS bf16x8*)(lds + PG8_SB(b, h) + boff + n * 2048 + k * 1024); } while (0)
#define PG8_MMA(ai, bj, At, Bt) do { __builtin_amdgcn_s_setprio(1); _Pragma("unroll") for (int m = 0; m < 4; ++m) _Pragma("unroll") for (int n = 0; n < 2; ++n) _Pragma("unroll") for (int k = 0; k < 2; ++k) \
        acc[ai][bj][m][n] = __builtin_amdgcn_mfma_f32_16x16x32_bf16(Bt[n][k], At[m][k], acc[ai][bj][m][n], 0, 0, 0); __builtin_amdgcn_s_setprio(0); } while (0)
#define PG8_WAIT_V(n) asm volatile("s_waitcnt vmcnt(" #n ")" ::: "memory")
#define PG8_WAIT_L(n) asm volatile("s_waitcnt lgkmcnt(" #n ")" ::: "memory")
#define PG8_BAR __builtin_amdgcn_s_barrier()
#define PG8_SCHED __builtin_amdgcn_sched_barrier(0)
#define PG8_APTR(u) ((const char*)g.A + (size_t)(u).pm * tstepA + (size_t)(((u).pn >> g.a_sh) * g.a_mul) * 2)
    Unit cur, nxt; int ui = 0;
    if (!S.next(0, cur)) return;
    f32x4 acc[2][2][4][2];
#pragma unroll
    for (int a = 0; a < 2; ++a)
#pragma unroll
        for (int b = 0; b < 2; ++b)
#pragma unroll
            for (int m = 0; m < 4; ++m)
#pragma unroll
                for (int n = 0; n < 2; ++n) acc[a][b][m][n] = (f32x4){0.f, 0.f, 0.f, 0.f};
    bf16x8 At[4][2], B0[2][2], B1[2][2];
    const char* cA = PG8_APTR(cur); const char* cB = (const char*)g.Bt + (size_t)cur.pn * tstepB;
    PG8_STAGE(PG8_SB(0, 0), cB, voffB); PG8_STAGE(PG8_SB(0, 1), cB + hstepB, voffB); PG8_STAGE(PG8_SA(0, 0), cA, voffA); PG8_STAGE(PG8_SA(0, 1), cA + hstepA, voffA);
    if (wr == 1) PG8_BAR;
    PG8_WAIT_V(2); PG8_BAR;
    PG8_STAGE(PG8_SB(1, 0), cB + kstep, voffB); PG8_STAGE(PG8_SA(1, 0), cA + kstep, voffA); PG8_STAGE(PG8_SB(1, 1), cB + hstepB + kstep, voffB);
    PG8_WAIT_V(6); PG8_BAR;
    for (;;) {
        const bool has_next = S.next(ui + 1, nxt);
        const char* nA = has_next ? PG8_APTR(nxt) : cA; const char* nB = has_next ? (const char*)g.Bt + (size_t)nxt.pn * tstepB : cB;
        for (int t = 0; t < nt; t += 2) {
            const bool last = (t == nt - 2);
            const char* a1 = cA + (size_t)(t + 1) * kstep;
            const char* a2 = last ? nA : cA + (size_t)(t + 2) * kstep; const char* b2 = last ? nB : cB + (size_t)(t + 2) * kstep;
            const char* a3 = a2 + kstep; const char* b3 = b2 + kstep;
            PG8_LDB(B0, 0, 0); PG8_LDB(B1, 0, 1); PG8_SCHED; PG8_LDA(At, 0, 0); PG8_STAGE(PG8_SA(1, 1), a1 + hstepA, voffA);
            PG8_WAIT_V(8); PG8_WAIT_L(0); PG8_BAR; PG8_MMA(0, 0, At, B0); PG8_MMA(0, 1, At, B1); PG8_BAR; PG8_SCHED;
            PG8_LDA(At, 0, 1); PG8_STAGE(PG8_SB(0, 0), b2, voffB); PG8_STAGE(PG8_SB(0, 1), b2 + hstepB, voffB); PG8_STAGE(PG8_SA(0, 0), a2, voffA);
            PG8_WAIT_V(8); PG8_WAIT_L(0); PG8_BAR; PG8_MMA(1, 0, At, B0); PG8_MMA(1, 1, At, B1); PG8_BAR; PG8_SCHED;
            PG8_LDB(B0, 1, 0); PG8_LDB(B1, 1, 1); PG8_SCHED; PG8_LDA(At, 1, 0); PG8_STAGE(PG8_SA(0, 1), a2 + hstepA, voffA);
            PG8_WAIT_V(8); PG8_WAIT_L(0); PG8_BAR; PG8_MMA(0, 0, At, B0); PG8_MMA(0, 1, At, B1); PG8_BAR; PG8_SCHED;
            PG8_LDA(At, 1, 1); PG8_STAGE(PG8_SB(1, 0), b3, voffB); PG8_STAGE(PG8_SB(1, 1), b3 + hstepB, voffB); PG8_STAGE(PG8_SA(1, 0), a3, voffA);
            PG8_WAIT_V(8); PG8_WAIT_L(0); PG8_BAR; PG8_MMA(1, 0, At, B0); PG8_MMA(1, 1, At, B1); PG8_BAR; PG8_SCHED;
        }
        if (wr == 0) PG8_BAR;
        E(acc, cur, wr, wc, fr, fq);
        if (!has_next) break;
#pragma unroll
        for (int a = 0; a < 2; ++a)
#pragma unroll
            for (int b = 0; b < 2; ++b)
#pragma unroll
                for (int m = 0; m < 4; ++m)
#pragma unroll
                    for (int n = 0; n < 2; ++n) acc[a][b][m][n] = (f32x4){0.f, 0.f, 0.f, 0.f};
        cur = nxt; cA = nA; cB = nB; ++ui;
        if (wr == 1) PG8_BAR;
    }
    PG8_WAIT_V(0);
    PG8_BAR;
#undef PG8_SA
#undef PG8_SB
#undef PG8_STAGE
#undef PG8_LDA
#undef PG8_LDB
#undef PG8_MMA
#undef PG8_WAIT_V
#undef PG8_WAIT_L
#undef PG8_BAR
#undef PG8_SCHED
#undef PG8_APTR
}
}

__device__ __forceinline__ void run_gemm(LAS unsigned char* lds, const bf16_t* A, int lda, int a_sh, int a_mul, const bf16_t* Bt, int N, int K, const pg8::Epi& E) {
    pg8::Gemm g; g.A = A; g.Bt = Bt; g.M = T_TOK; g.N = N; g.K = K; g.lda = lda; g.a_sh = a_sh; g.a_mul = a_mul;
    pg8::StaticOrder S; S.init(T_TOK, N, (int)gridDim.x, (int)blockIdx.x);
    pg8::gemm_phase(lds, g, S, E);
}

__device__ __forceinline__ void rmsnorm_phase(const float* X, const float* g, bf16_t* H) {
    const int lane = TIDX & 63, gw = blockIdx.x * 8 + (TIDX >> 6), NW = gridDim.x * 8;
    f32x4 gv[4];
#pragma unroll
    for (int j = 0; j < 4; ++j) gv[j] = *(const f32x4*)(g + 4 * (lane + 64 * j));
    for (int row = gw; row < T_TOK; row += 4 * NW) {
        f32x4 v[4][4];
#pragma unroll
        for (int q = 0; q < 4; ++q) { const int rr = row + q * NW; if (rr < T_TOK) {
#pragma unroll
            for (int j = 0; j < 4; ++j) v[q][j] = *(const f32x4*)(X + (size_t)rr * DM + 4 * (lane + 64 * j)); } }
#pragma unroll
        for (int q = 0; q < 4; ++q) { const int rr = row + q * NW; if (rr < T_TOK) { float s = 0.f;
#pragma unroll
            for (int j = 0; j < 4; ++j) s += v[q][j][0] * v[q][j][0] + v[q][j][1] * v[q][j][1] + v[q][j][2] * v[q][j][2] + v[q][j][3] * v[q][j][3];
            const float rstd = rsqrtf(wave_sum(s) * (1.f / DM) + EPS);
#pragma unroll
            for (int j = 0; j < 4; ++j) { u32x2 o; o.x = pk2(v[q][j][0] * rstd * gv[j][0], v[q][j][1] * rstd * gv[j][1]); o.y = pk2(v[q][j][2] * rstd * gv[j][2], v[q][j][3] * rstd * gv[j][3]);
                *(u32x2*)(H + (size_t)rr * DM + 4 * (lane + 64 * j)) = o; } } }
    }
}
__device__ __forceinline__ int wmap(int mat, int j) {
    if (mat == 0) return j < C_GATE ? j : -1;
    if (mat == 1) { const int pn = j >> 8, rho = j & 255, bj = rho >> 7, wc = (rho >> 5) & 3, n = (rho >> 4) & 1, fq = (rho >> 2) & 3, jj = rho & 3;
        return C_GATE + (2 * bj + n) * 1024 + 64 * pn + 16 * wc + 4 * fq + jj; }
    return j;
}
struct WItem { const float* src; bf16_t* dst; int ld, K, mat, k0, n0; };
__device__ __forceinline__ WItem wdecode(const Params& p, int l, int r) {
    constexpr int I0 = 16 * 56, I1 = 16 * 64, I2 = 4 * 4 * 16, I3 = 16 * 16, I4 = 16 * 64;
    WItem w;
    if (r < I0) { w.src = p.w_in + (size_t)l * DM * N_IN; w.ld = N_IN; w.K = DM; w.dst = (bf16_t*)(p.ws + OFF_WIN); w.mat = 0; w.k0 = (r / 56) * 64; w.n0 = (r % 56) * 64; return w; } r -= I0;
    if (r < I1) { w.src = p.w_in + (size_t)l * DM * N_IN; w.ld = N_IN; w.K = DM; w.dst = (bf16_t*)(p.ws + OFF_WG); w.mat = 1; w.k0 = (r / 64) * 64; w.n0 = (r % 64) * 64; return w; } r -= I1;
    if (r < I2) { const int nb = r / 64, q = r % 64; w.src = p.w_branch + ((size_t)l * 4 + nb) * 256 * DM; w.ld = DM; w.K = 256; w.dst = (bf16_t*)(p.ws + OFF_WB) + (size_t)nb * 1024 * 256; w.mat = 2; w.k0 = (q / 16) * 64; w.n0 = (q % 16) * 64; return w; } r -= I2;
    if (r < I3) { w.src = p.w_out + (size_t)l * DM * DM; w.ld = DM; w.K = DM; w.dst = (bf16_t*)(p.ws + OFF_WO); w.mat = 2; w.k0 = (r / 16) * 64; w.n0 = (r % 16) * 64; return w; } r -= I3;
    if (r < I4) { w.src = p.w_mlp_in + (size_t)l * DM * DFF; w.ld = DFF; w.K = DM; w.dst = (bf16_t*)(p.ws + OFF_W1); w.mat = 2; w.k0 = (r / 64) * 64; w.n0 = (r % 64) * 64; return w; } r -= I4;
    w.src = p.w_mlp_out + (size_t)l * DFF * DM; w.ld = DM; w.K = DFF; w.dst = (bf16_t*)(p.ws + OFF_W2); w.mat = 2; w.k0 = (r / 16) * 64; w.n0 = (r % 16) * 64; return w;
}
__device__ __forceinline__ void wload(const WItem& w, int tid, float (&v)[8]) {
    const int nn = tid & 63; const int c = wmap(w.mat, w.n0 + nn);
#pragma unroll
    for (int i = 0; i < 8; ++i) { const int kk = i * 8 + (tid >> 6); v[i] = (c >= 0) ? w.src[(size_t)(w.k0 + kk) * w.ld + c] : 0.f; }
}
__device__ __forceinline__ void wconv_phase(const Params& p, int l, LAS unsigned char* lds) {
    LAS float* scr = (LAS float*)lds;
    constexpr int NI = 16 * 56 + 16 * 64 + 4 * 4 * 16 + 16 * 16 + 16 * 64 + 64 * 16;
    const int tid = TIDX, G = gridDim.x;
    int it = blockIdx.x;
    if (it >= NI) return;
    WItem w0 = wdecode(p, l, it), w1 = w0, w2 = w0; float v0[8], v1[8], v2[8];
    wload(w0, tid, v0);
    if (it + G < NI) { w1 = wdecode(p, l, it + G); wload(w1, tid, v1); }
    for (; it < NI; it += G) {
        if (it + 2 * G < NI) { w2 = wdecode(p, l, it + 2 * G); wload(w2, tid, v2); }
        { const int nn = tid & 63;
#pragma unroll
          for (int i = 0; i < 8; ++i) scr[(i * 8 + (tid >> 6)) * 65 + nn] = v0[i]; }
        __syncthreads();
        { const int kk2 = (tid & 31) * 2;
#pragma unroll
          for (int i = 0; i < 4; ++i) { const int nn = i * 16 + (tid >> 5); *(unsigned*)(w0.dst + (size_t)(w0.n0 + nn) * w0.K + w0.k0 + kk2) = pk2(scr[kk2 * 65 + nn], scr[(kk2 + 1) * 65 + nn]); } }
        __syncthreads();
        w0 = w1; w1 = w2;
#pragma unroll
        for (int i = 0; i < 8; ++i) { v0[i] = v1[i]; v1[i] = v2[i]; }
    }
}

__device__ __forceinline__ void sb_task(const Params& p, int l, LAS unsigned char* lds, int task) {
    constexpr int VTS = 140;
    const int tid = TIDX, wave = tid >> 6, lane = tid & 63, ll = lane & 15, qd = lane >> 4;
    const int bh = task >> 7, qi = 127 - (task & 127), b = bh >> 2, h = bh & 3, q0 = qi * 128;
    const bf16_t* base = (const bf16_t*)(p.ws + OFF_B) + (size_t)b * SEQ * NP;
    LAS bf16_t* vt = (LAS bf16_t*)lds;
    LAS int* flag = (LAS int*)(lds + 64 * VTS * 2);
    bf16x8 qf[2];
#pragma unroll
    for (int ks = 0; ks < 2; ++ks) qf[ks] = *(const bf16x8*)(base + (size_t)(q0 + wave * 16 + ll) * NP + C_SBQ + h * 64 + ks * 32 + qd * 8);
    float carry = 0.f;
    f32x4 oacc[4];
#pragma unroll
    for (int c = 0; c < 4; ++c) oacc[c] = (f32x4){0.f, 0.f, 0.f, 0.f};
    bf16x8 kc[8][2], va, vc;
#define SB_LOAD(jj, K_, A_, C_) do { _Pragma("unroll") for (int g = 0; g < 8; ++g) _Pragma("unroll") for (int ks = 0; ks < 2; ++ks) \
            K_[g][ks] = *(const bf16x8*)(base + (size_t)((jj) * 128 + g * 16 + ll) * NP + C_SBK + h * 64 + ks * 32 + qd * 8); \
        const bf16_t* vp_ = base + (size_t)((jj) * 128 + 2 * (tid >> 3)) * NP + C_SBV + h * 64 + (tid & 7) * 8; A_ = *(const bf16x8*)vp_; C_ = *(const bf16x8*)(vp_ + NP); } while (0)
    SB_LOAD(qi, kc, va, vc);
    for (int j = qi; j >= 0; --j) {
        bf16x8 kn[8][2], van, vcn;
        { const int jn = j > 0 ? j - 1 : 0; SB_LOAD(jn, kn, van, vcn); }
        {
#pragma unroll
            for (int e = 0; e < 8; ++e) *(LAS unsigned*)(vt + ((tid & 7) * 8 + e) * VTS + 2 * (tid >> 3)) = (unsigned)(unsigned short)va[e] | ((unsigned)(unsigned short)vc[e] << 16);
        }
        f32x4 s[8];
#pragma unroll
        for (int g = 0; g < 8; ++g) { s[g] = (f32x4){0.f, 0.f, 0.f, 0.f};
#pragma unroll
            for (int ks = 0; ks < 2; ++ks) s[g] = MFMA16(kc[g][ks], qf[ks], s[g]); }
        const bool diag = (j == qi);
        f32x4 sp[8], lb[8]; float Gt[8], abq[8];
#pragma unroll
        for (int g = 0; g < 8; ++g) {
#pragma unroll
            for (int r = 0; r < 4; ++r) { const float z = s[g][r] * 0.125f; float spv = softplusf_(z), lbv = z - spv;
                if (diag && !(16 * g + 4 * qd + r < wave * 16 + ll)) { spv = 0.f; lbv = -INFINITY; }
                sp[g][r] = spv; lb[g][r] = lbv; }
            const float L = (sp[g][0] + sp[g][1]) + (sp[g][2] + sp[g][3]);
            const float L0 = __shfl(L, ll), L1 = __shfl(L, ll + 16), L2 = __shfl(L, ll + 32), L3 = __shfl(L, ll + 48);
            Gt[g] = (L0 + L1) + (L2 + L3);
            abq[g] = (qd < 1 ? L1 : 0.f) + (qd < 2 ? L2 : 0.f) + (qd < 3 ? L3 : 0.f);
        }
        float run = 0.f; bf16x8 pf[4]; f32x4 w[8];
#pragma unroll
        for (int g = 7; g >= 0; --g) {
            const float bs = carry - run - abq[g];
            w[g][3] = __expf(lb[g][3] + bs);
            w[g][2] = __expf(lb[g][2] + bs - sp[g][3]);
            w[g][1] = __expf(lb[g][1] + bs - (sp[g][3] + sp[g][2]));
            w[g][0] = __expf(lb[g][0] + bs - (sp[g][3] + sp[g][2] + sp[g][1]));
            run += Gt[g];
        }
#pragma unroll
        for (int g2 = 0; g2 < 4; ++g2) pf[g2] = pk8(w[2 * g2], w[2 * g2 + 1]);
        carry -= run;
        __syncthreads();
        {
            bf16x8 af[4][4];
#pragma unroll
            for (int c = 0; c < 4; ++c)
#pragma unroll
                for (int g2 = 0; g2 < 4; ++g2) { const LAS bf16_t* vr = vt + (16 * c + ll) * VTS + 32 * g2 + 4 * qd; af[c][g2] = mk8(*(const LAS u32x2*)vr, *(const LAS u32x2*)(vr + 16)); }
            __builtin_amdgcn_sched_barrier(0);
#pragma unroll
            for (int c = 0; c < 4; ++c)
#pragma unroll
                for (int g2 = 0; g2 < 4; ++g2) oacc[c] = MFMA16(af[c][g2], pf[g2], oacc[c]);
        }
        const int done = __all(carry < -104.f) ? 1 : 0;
        if (lane == 0) flag[wave] = done;
        __syncthreads();
        int all = 1;
#pragma unroll
        for (int i = 0; i < 8; ++i) all &= flag[i];
        if (__builtin_amdgcn_readfirstlane(all)) break;
        __syncthreads();
#pragma unroll
        for (int g = 0; g < 8; ++g) { kc[g][0] = kn[g][0]; kc[g][1] = kn[g][1]; }
        va = van; vc = vcn;
    }
#undef SB_LOAD
    bf16_t* op = (bf16_t*)(p.ws + OFF_O) + (size_t)(b * SEQ + q0 + wave * 16 + ll) * DM + O_SB + h * 64 + 4 * qd;
#pragma unroll
    for (int c = 0; c < 4; ++c) { u32x2 o; o.x = pk2(oacc[c][0], oacc[c][1]); o.y = pk2(oacc[c][2], oacc[c][3]); *(u32x2*)(op + 16 * c) = o; }
    __syncthreads();
}

__device__ __forceinline__ void dil_task(const Params& p, int l, LAS unsigned char* lds, int pat, int task) {
    constexpr int RS = 72, VTS = 268;
    const int tid = TIDX, wave = tid >> 6, lane = tid & 63, ll = lane & 15, qd = lane >> 4;
    const int dil = pat == 0 ? 1 : (pat == 1 ? 4 : 16), nb = (SEQ / dil) / 128;
    const int n = task % nb, r = (task / nb) % dil, bh = task / (nb * dil), b = bh >> 2, h = bh & 3;
    const bf16_t* base = (const bf16_t*)(p.ws + OFF_B) + (size_t)b * SEQ * NP;
    LAS bf16_t* qs = (LAS bf16_t*)lds;
    LAS bf16_t* ks = qs + 128 * RS;
    LAS bf16_t* vt = ks + 256 * RS;
    LAS float* gq = (LAS float*)(vt + 64 * VTS);
    if (tid < 128) gq[tid] = tid < 64 ? p.dil_q_g[l * 64 + tid] : p.dil_k_g[l * 64 + tid - 64];
    bf16x8 vreg[2][2];
#pragma unroll
    for (int ps = 0; ps < 2; ++ps) { const int kj = 2 * (ps * 64 + (tid >> 3)), idx = n * 128 - 128 + kj;
        vreg[ps][0] = (bf16x8){0, 0, 0, 0, 0, 0, 0, 0}; vreg[ps][1] = (bf16x8){0, 0, 0, 0, 0, 0, 0, 0};
        if (idx >= 0) { const bf16_t* vp = base + (size_t)(idx * dil + r) * NP + C_LV + h * 64 + (tid & 7) * 8; vreg[ps][0] = *(const bf16x8*)vp; vreg[ps][1] = *(const bf16x8*)(vp + (size_t)dil * NP); } }
    __syncthreads();
    if (tid < 384) {
        const bool isq = tid < 128; const int idx = isq ? n * 128 + tid : n * 128 - 128 + (tid - 128);
        LAS bf16_t* dst = isq ? qs + tid * RS : ks + (tid - 128) * RS;
        if (idx >= 0) {
            const int pos = idx * dil + r;
            const bf16_t* src = base + (size_t)pos * NP + (isq ? C_LQ : C_LK) + h * 64;
            float xv[64]; float ss = 0.f;
#pragma unroll
            for (int c8 = 0; c8 < 8; ++c8) { const u32x4 u = *(const u32x4*)(src + c8 * 8);
                xv[c8 * 8 + 0] = bflo(u.x); xv[c8 * 8 + 1] = bfhi(u.x); xv[c8 * 8 + 2] = bflo(u.y); xv[c8 * 8 + 3] = bfhi(u.y);
                xv[c8 * 8 + 4] = bflo(u.z); xv[c8 * 8 + 5] = bfhi(u.z); xv[c8 * 8 + 6] = bflo(u.w); xv[c8 * 8 + 7] = bfhi(u.w); }
#pragma unroll
            for (int c = 0; c < 64; ++c) ss += xv[c] * xv[c];
            const float rstd = rsqrtf(ss * (1.f / 64.f) + EPS);
            const LAS float* gg = gq + (isq ? 0 : 64);
#pragma unroll
            for (int c = 0; c < 64; ++c) xv[c] = xv[c] * rstd * gg[c];
#pragma unroll
            for (int i = 0; i < 8; ++i) {
                const float invf = exp2f(-(float)i * (18.931568569324174f / 8.f));
                const float ang = (float)pos * invf;
                double rev = (double)ang * 0.15915494309189535; rev -= rint(rev);
                const float a2 = (float)(rev * 6.283185307179586);
                const float cs = __cosf(a2), sn = __sinf(a2);
                const float x1 = xv[i], x2 = xv[i + 8]; xv[i] = x1 * cs - x2 * sn; xv[i + 8] = x2 * cs + x1 * sn;
            }
#pragma unroll
            for (int c8 = 0; c8 < 8; ++c8) { u32x4 o; o.x = pk2(xv[c8 * 8], xv[c8 * 8 + 1]); o.y = pk2(xv[c8 * 8 + 2], xv[c8 * 8 + 3]); o.z = pk2(xv[c8 * 8 + 4], xv[c8 * 8 + 5]); o.w = pk2(xv[c8 * 8 + 6], xv[c8 * 8 + 7]);
                *(LAS u32x4*)(dst + c8 * 8) = o; }
        } else {
#pragma unroll
            for (int c8 = 0; c8 < 8; ++c8) *(LAS u32x4*)(dst + c8 * 8) = (u32x4){0u, 0u, 0u, 0u};
        }
    }
    {
#pragma unroll
        for (int ps = 0; ps < 2; ++ps) { const int kj = 2 * (ps * 64 + (tid >> 3));
#pragma unroll
            for (int e = 0; e < 8; ++e) *(LAS unsigned*)(vt + ((tid & 7) * 8 + e) * VTS + kj) = (unsigned)(unsigned short)vreg[ps][0][e] | ((unsigned)(unsigned short)vreg[ps][1][e] << 16); }
    }
    __syncthreads();
    const size_t tok = (size_t)b * SEQ + (size_t)(n * 128 + 16 * wave + ll) * dil + r;
    bf16_t* op = (bf16_t*)(p.ws + OFF_O) + tok * DM + O_DIL + h * 64 + 4 * qd;
    float* st = (float*)(p.ws + OFF_DSTAT) + (tok * 4 + h) * 2;
    u32x2 pv[4]; float mo = 0.f, dd = 0.f;
    if (pat > 0) { mo = st[0]; dd = st[1];
#pragma unroll
        for (int c = 0; c < 4; ++c) pv[c] = *(const u32x2*)(op + 16 * c); }
    bf16x8 qf[2];
#pragma unroll
    for (int k2 = 0; k2 < 2; ++k2) qf[k2] = *(const LAS bf16x8*)(qs + (16 * wave + ll) * RS + k2 * 32 + qd * 8);
    f32x4 s[10]; float mx = -INFINITY;
    {   bf16x8 kf[10][2];
#pragma unroll
        for (int gi = 0; gi < 10; ++gi) { const int g = wave + gi, gc = g < 16 ? g : 15;
#pragma unroll
            for (int k2 = 0; k2 < 2; ++k2) kf[gi][k2] = *(const LAS bf16x8*)(ks + (16 * gc + ll) * RS + k2 * 32 + qd * 8); }
        __builtin_amdgcn_sched_barrier(0);
#pragma unroll
        for (int gi = 0; gi < 10; ++gi) { s[gi] = (f32x4){0.f, 0.f, 0.f, 0.f};
#pragma unroll
            for (int k2 = 0; k2 < 2; ++k2) s[gi] = MFMA16(kf[gi][k2], qf[k2], s[gi]); }
    }
#pragma unroll
    for (int gi = 0; gi < 10; ++gi) {
        const int g = wave + gi;
#pragma unroll
        for (int rr = 0; rr < 4; ++rr) { const int kj = 16 * g + 4 * qd + rr, m = (16 * wave + ll) + 128 - kj;
            const bool valid = (g < 16) && (m >= 0) && (m <= 128) && (n * 128 - 128 + kj >= 0);
            const float v = valid ? s[gi][rr] * 0.125f : -INFINITY; s[gi][rr] = v; mx = fmaxf(mx, v); }
    }
    mx = fmaxf(mx, __shfl_xor(mx, 16)); mx = fmaxf(mx, __shfl_xor(mx, 32));
    float den = 0.f; bf16x8 pf[5];
#pragma unroll
    for (int gi = 0; gi < 10; ++gi)
#pragma unroll
        for (int rr = 0; rr < 4; ++rr) { const float e = __expf(s[gi][rr] - mx); s[gi][rr] = e; den += e; }
    den += __shfl_xor(den, 16); den += __shfl_xor(den, 32);
#pragma unroll
    for (int g2 = 0; g2 < 5; ++g2) pf[g2] = pk8(s[2 * g2], s[2 * g2 + 1]);
    f32x4 oacc[4];
    {   bf16x8 af[4][5];
#pragma unroll
        for (int c = 0; c < 4; ++c)
#pragma unroll
            for (int g2 = 0; g2 < 5; ++g2) {
                const int ga = wave + 2 * g2, gb = ga + 1, gac = ga < 16 ? ga : 15, gbc = gb < 16 ? gb : 15;
                const LAS bf16_t* vr = vt + (16 * c + ll) * VTS + 4 * qd;
                af[c][g2] = mk8(*(const LAS u32x2*)(vr + 16 * gac), *(const LAS u32x2*)(vr + 16 * gbc)); }
        __builtin_amdgcn_sched_barrier(0);
#pragma unroll
        for (int c = 0; c < 4; ++c) { oacc[c] = (f32x4){0.f, 0.f, 0.f, 0.f};
#pragma unroll
            for (int g2 = 0; g2 < 5; ++g2) oacc[c] = MFMA16(af[c][g2], pf[g2], oacc[c]); }
    }
    float wa = 0.f, wb = 1.f, D = den, M = mx;
    if (pat > 0) { M = fmaxf(mo, mx); wa = dd * __expf(mo - M); wb = __expf(mx - M); D = wa + den * wb; }
    const float inv = 1.f / D;
#pragma unroll
    for (int c = 0; c < 4; ++c) { f32x4 o = oacc[c] * wb;
        if (pat > 0) { const u32x2 u = pv[c]; o[0] += wa * bflo(u.x); o[1] += wa * bfhi(u.x); o[2] += wa * bflo(u.y); o[3] += wa * bfhi(u.y); }
        u32x2 q; q.x = pk2(o[0] * inv, o[1] * inv); q.y = pk2(o[2] * inv, o[3] * inv); *(u32x2*)(op + 16 * c) = q; }
    if (pat < 2 && qd == 0) { st[0] = M; st[1] = D; }
    __syncthreads();
}

__device__ __forceinline__ void gla_load(const Params& p, int l, const bf16_t* prow  , int h, LAS float* qL, LAS float* kL, LAS float* bL, LAS float* lrL, LAS float* w2L) {
    const int tid = TIDX;
    if (tid < 128) { const int t = tid >> 1, c8 = (tid & 1) * 8; const u32x4 u = *(const u32x4*)(prow + (size_t)t * NP + C_GLR + c8); LAS float* d = lrL + t * 16 + c8;
        d[0] = bflo(u.x); d[1] = bfhi(u.x); d[2] = bflo(u.y); d[3] = bfhi(u.y); d[4] = bflo(u.z); d[5] = bfhi(u.z); d[6] = bflo(u.w); d[7] = bfhi(u.w); }
    { const int j = tid >> 5, c = tid & 31; w2L[tid] = p.gla_w_lr2[(size_t)l * 16 * 128 + j * 128 + h * 32 + c]; }
    if (tid < 32) w2L[512 + tid] = p.gla_b_lr[l * 128 + h * 32 + tid];
    { const int isk = tid >> 8, t = (tid & 255) >> 2, c8 = (tid & 3) * 8; const u32x4 u = *(const u32x4*)(prow + (size_t)t * NP + (isk ? C_GK : C_GQ) + h * 32 + c8);
        const float sc = isk ? 1.f : 0.17677669529663687f; LAS float* d = (isk ? kL : qL) + t * 33 + c8;
        d[0] = bflo(u.x) * sc; d[1] = bfhi(u.x) * sc; d[2] = bflo(u.y) * sc; d[3] = bfhi(u.y) * sc; d[4] = bflo(u.z) * sc; d[5] = bfhi(u.z) * sc; d[6] = bflo(u.w) * sc; d[7] = bfhi(u.w) * sc; }
    __syncthreads();
    for (int i = tid; i < 64 * 32; i += 512) { const int t = i >> 5, c = i & 31; float a = w2L[512 + c];
#pragma unroll
        for (int j = 0; j < 16; ++j) a += lrL[t * 16 + j] * w2L[j * 32 + c];
        bL[t * 33 + c] = -softplusf_(-a) * (1.f / 16.f); }
    __syncthreads();
    {
        const int wv = tid >> 6, ln = tid & 63;
#pragma unroll
        for (int q = 0; q < 4; ++q) { const int c = wv * 4 + q; float v = bL[ln * 33 + c];
#pragma unroll
            for (int o = 1; o < 64; o <<= 1) { const float u = __shfl_up(v, o); if (ln >= o) v += u; }
            bL[ln * 33 + c] = v; }
    }
    __syncthreads();
}
__device__ __forceinline__ void gla_a_task(const Params& p, int l, LAS unsigned char* lds, int task) {
    const int tid = TIDX, wave = tid >> 6, lane = tid & 63, ll = lane & 15, qd = lane >> 4, bh = task >> 8, ch = task & 255, b = bh >> 2, h = bh & 3;
    const bf16_t* prow = (const bf16_t*)(p.ws + OFF_B) + ((size_t)b * SEQ + ch * 64) * NP;
    LAS float* qL = (LAS float*)lds; LAS float* kL = qL + 64 * 33; LAS float* bL = kL + 64 * 33; LAS float* lrL = bL + 64 * 33; LAS float* w2L = lrL + 1024;
    LAS bf16_t* vt = (LAS bf16_t*)(w2L + 576);
    LAS bf16_t* kT = vt + 64 * 72;
    { const int tp = tid >> 4, c4 = (tid & 15) * 4;
      const u32x2 u0 = *(const u32x2*)(prow + (size_t)(2 * tp) * NP + C_GV + h * 64 + c4), u1 = *(const u32x2*)(prow + (size_t)(2 * tp + 1) * NP + C_GV + h * 64 + c4);
      *(LAS unsigned*)(vt + (c4 + 0) * 72 + 2 * tp) = (u0.x & 0xffffu) | (u1.x << 16); *(LAS unsigned*)(vt + (c4 + 1) * 72 + 2 * tp) = (u0.x >> 16) | (u1.x & 0xffff0000u);
      *(LAS unsigned*)(vt + (c4 + 2) * 72 + 2 * tp) = (u0.y & 0xffffu) | (u1.y << 16); *(LAS unsigned*)(vt + (c4 + 3) * 72 + 2 * tp) = (u0.y >> 16) | (u1.y & 0xffff0000u); }
    gla_load(p, l, prow, h, qL, kL, bL, lrL, w2L);
    { const int c = tid >> 4, t4 = (tid & 15) * 4; const float bl = bL[63 * 33 + c]; float kv[4];
#pragma unroll
      for (int e = 0; e < 4; ++e) kv[e] = kL[(t4 + e) * 33 + c] * __expf(bl - bL[(t4 + e) * 33 + c]);
      *(LAS unsigned*)(kT + c * 72 + t4) = pk2(kv[0], kv[1]); *(LAS unsigned*)(kT + c * 72 + t4 + 2) = pk2(kv[2], kv[3]); }
    __syncthreads();
    const int ct = wave >> 2, dt = wave & 3; f32x4 acc = {0.f, 0.f, 0.f, 0.f};
#pragma unroll
    for (int k2 = 0; k2 < 2; ++k2) acc = MFMA16(*(const LAS bf16x8*)(kT + (16 * ct + ll) * 72 + k2 * 32 + qd * 8), *(const LAS bf16x8*)(vt + (16 * dt + ll) * 72 + k2 * 32 + qd * 8), acc);
    float* U = (float*)(p.ws + OFF_GLAU) + (size_t)task * 2048;
#pragma unroll
    for (int r = 0; r < 4; ++r) U[(16 * ct + 4 * qd + r) * 64 + 16 * dt + ll] = acc[r];
    if (tid < 32) ((float*)(p.ws + OFF_GLAA))[(size_t)task * 32 + tid] = __expf(bL[63 * 33 + tid]);
    __syncthreads();
}
__device__ __forceinline__ void gla_scan_task(const Params& p, LAS unsigned char* lds, int task, unsigned* ready) {
    const int tid = TIDX, bh = task >> 2, qt = task & 3, e = qt * 512 + tid, cl = tid >> 6;
    float* U = (float*)(p.ws + OFF_GLAU) + (size_t)bh * 256 * 2048 + e;
    const float* A = (const float*)(p.ws + OFF_GLAA) + (size_t)bh * 256 * 32 + qt * 8;
    LAS float* aL = (LAS float*)lds;
#pragma unroll
    for (int k = 0; k < 4; ++k) { const int idx = tid + 512 * k; aL[idx] = A[(idx >> 3) * 32 + (idx & 7)]; }
    __syncthreads();
    float st = 0.f;
    for (int n0 = 0; n0 < 256; n0 += 16) {
        float u[16];
#pragma unroll
        for (int k = 0; k < 16; ++k) u[k] = U[(size_t)(n0 + k) * 2048];
#pragma unroll
        for (int k = 0; k < 16; ++k) { U[(size_t)(n0 + k) * 2048] = st; st = aL[(n0 + k) * 8 + cl] * st + u[k]; }
    }
    asm volatile("s_waitcnt vmcnt(0)" ::: "memory");
    __syncthreads();
    if (tid == 0) { __builtin_amdgcn_fence(__ATOMIC_RELEASE, "agent"); asm volatile("s_waitcnt vmcnt(0)" ::: "memory");
        __hip_atomic_fetch_add(ready, 1u, __ATOMIC_RELAXED, __HIP_MEMORY_SCOPE_AGENT); }
    __syncthreads();
}
__device__ __forceinline__ void gla_c_task(const Params& p, int l, LAS unsigned char* lds, int task, unsigned* ready) {
    const int tid = TIDX, wave = tid >> 6, lane = tid & 63, ll = lane & 15, qd = lane >> 4, bh = task >> 8, ch = task & 255, b = bh >> 2, h = bh & 3;
    if (tid == 0) {
        unsigned sp = 0; while (__hip_atomic_load(ready + bh, __ATOMIC_RELAXED, __HIP_MEMORY_SCOPE_AGENT) < 4u && ++sp < (1u << 24)) __builtin_amdgcn_s_sleep(2);
        __builtin_amdgcn_fence(__ATOMIC_ACQUIRE, "agent"); asm volatile("s_waitcnt vmcnt(0)" ::: "memory"); }
    __syncthreads();
    const bf16_t* prow = (const bf16_t*)(p.ws + OFF_B) + ((size_t)b * SEQ + ch * 64) * NP;
    LAS float* qL = (LAS float*)lds; LAS float* kL = qL + 64 * 33; LAS float* bL = kL + 64 * 33; LAS float* lrL = bL + 64 * 33; LAS float* w2L = lrL + 1024;
    LAS float* ssL = w2L + 576;
    LAS bf16_t* vt = (LAS bf16_t*)(ssL + 512);
    LAS bf16_t* sT = vt + 64 * 72;
    { const int tp = tid >> 4, c4 = (tid & 15) * 4;
      const u32x2 u0 = *(const u32x2*)(prow + (size_t)(2 * tp) * NP + C_GV + h * 64 + c4), u1 = *(const u32x2*)(prow + (size_t)(2 * tp + 1) * NP + C_GV + h * 64 + c4);
      *(LAS unsigned*)(vt + (c4 + 0) * 72 + 2 * tp) = (u0.x & 0xffffu) | (u1.x << 16); *(LAS unsigned*)(vt + (c4 + 1) * 72 + 2 * tp) = (u0.x >> 16) | (u1.x & 0xffff0000u);
      *(LAS unsigned*)(vt + (c4 + 2) * 72 + 2 * tp) = (u0.y & 0xffffu) | (u1.y << 16); *(LAS unsigned*)(vt + (c4 + 3) * 72 + 2 * tp) = (u0.y >> 16) | (u1.y & 0xffff0000u); }
    { const float* U = (const float*)(p.ws + OFF_GLAU) + (size_t)task * 2048; const int c = tid >> 4, d4 = (tid & 15) * 4; const f32x4 u = *(const f32x4*)(U + c * 64 + d4);
#pragma unroll
      for (int e = 0; e < 4; ++e) sT[(d4 + e) * 40 + c] = f2bf(u[e]); }
    const int I = wave >> 1, dh = wave & 1, t = 16 * I + ll;
    u32x2 rgl[2];
#pragma unroll
    for (int cc = 0; cc < 2; ++cc) rgl[cc] = *(const u32x2*)(prow + (size_t)t * NP + C_GR + h * 64 + 16 * (2 * dh + cc) + 4 * qd);
    gla_load(p, l, prow, h, qL, kL, bL, lrL, w2L);
    float qv[8], bt[8], rI[8];
#pragma unroll
    for (int e = 0; e < 8; ++e) { qv[e] = qL[t * 33 + 8 * qd + e]; bt[e] = bL[t * 33 + 8 * qd + e]; rI[e] = I > 0 ? bL[(16 * I - 1) * 33 + 8 * qd + e] : 0.f; }
    f32x4 qa, qb2, qc, qd2;
#pragma unroll
    for (int e = 0; e < 4; ++e) { qa[e] = qv[e] * __expf(bt[e] - rI[e]); qb2[e] = qv[4 + e] * __expf(bt[4 + e] - rI[4 + e]); qc[e] = qv[e] * __expf(bt[e]); qd2[e] = qv[4 + e] * __expf(bt[4 + e]); }
    const bf16x8 qfI = pk8(qa, qb2), qfin = pk8(qc, qd2);
    f32x4 at[4];
#pragma unroll
    for (int J = 0; J < 4; ++J) { at[J] = (f32x4){0.f, 0.f, 0.f, 0.f};
        if (J < I) { const int j = 16 * J + ll; f32x4 ka, kb2;
#pragma unroll
            for (int e = 0; e < 4; ++e) { ka[e] = kL[j * 33 + 8 * qd + e] * __expf(rI[e] - bL[j * 33 + 8 * qd + e]); kb2[e] = kL[j * 33 + 8 * qd + 4 + e] * __expf(rI[4 + e] - bL[j * 33 + 8 * qd + 4 + e]); }
            at[J] = MFMA16(pk8(ka, kb2), qfI, at[J]); } }
    {
        f32x4 dsum = {0.f, 0.f, 0.f, 0.f};
#pragma unroll 8
        for (int c = 0; c < 32; ++c) { const float q_ = qL[t * 33 + c], b_ = bL[t * 33 + c];
#pragma unroll
            for (int r = 0; r < 4; ++r) { const int j = 16 * I + 4 * qd + r; dsum[r] += q_ * kL[j * 33 + c] * __expf(fminf(b_ - bL[j * 33 + c], 0.f)); } }
#pragma unroll
        for (int r = 0; r < 4; ++r) dsum[r] = (4 * qd + r <= ll) ? dsum[r] : 0.f;
#pragma unroll
        for (int J = 0; J < 4; ++J) if (J == I) at[J] = dsum;
    }
    bf16x8 pf[2]; pf[0] = pk8(at[0], at[1]); pf[1] = pk8(at[2], at[3]);
    f32x4 oacc[2]; float ss = 0.f;
#pragma unroll
    for (int cc = 0; cc < 2; ++cc) { const int cg = 2 * dh + cc; f32x4 acc = {0.f, 0.f, 0.f, 0.f};
#pragma unroll
        for (int g2 = 0; g2 < 2; ++g2) { const LAS bf16_t* vr = vt + (16 * cg + ll) * 72 + 32 * g2 + 4 * qd; acc = MFMA16(mk8(*(const LAS u32x2*)vr, *(const LAS u32x2*)(vr + 16)), pf[g2], acc); }
        acc = MFMA16(*(const LAS bf16x8*)(sT + (16 * cg + ll) * 40 + 8 * qd), qfin, acc);
        oacc[cc] = acc; ss += acc[0] * acc[0] + acc[1] * acc[1] + acc[2] * acc[2] + acc[3] * acc[3]; }
    ssL[t * 8 + dh * 4 + qd] = ss;
    __syncthreads();
    float tot = 0.f;
#pragma unroll
    for (int e = 0; e < 8; ++e) tot += ssL[t * 8 + e];
    const float rstd = rsqrtf(tot * (1.f / 64.f) + EPS);
#pragma unroll
    for (int cc = 0; cc < 2; ++cc) { const int d = 16 * (2 * dh + cc) + 4 * qd;
        const u32x2 rg = rgl[cc];
        const float rr[4] = {bflo(rg.x), bfhi(rg.x), bflo(rg.y), bfhi(rg.y)}; float ov[4];
#pragma unroll
        for (int e = 0; e < 4; ++e) ov[e] = oacc[cc][e] * rstd * p.gla_norm_g[l * 64 + d + e] * rr[e] * sigmoidf_(rr[e]);
        u32x2 o; o.x = pk2(ov[0], ov[1]); o.y = pk2(ov[2], ov[3]);
        *(u32x2*)((bf16_t*)(p.ws + OFF_O) + ((size_t)b * SEQ + ch * 64 + t) * DM + O_GLA + h * 64 + d) = o; }
    __syncthreads();
}

__device__ __forceinline__ void dn_prep_task(const Params& p, int l, LAS unsigned char* lds, int task) {
    const int tid = TIDX, bh = task >> 8, ch = task & 255, b = bh >> 2, h = bh & 3, t0 = ch * 64;
    const bf16_t* pb = (const bf16_t*)(p.ws + OFF_B) + (size_t)b * SEQ * NP;
    LAS float* qn = (LAS float*)lds; LAS float* kn = qn + 64 * 65; LAS float* vv = kn + 64 * 65; LAS float* Lw = vv + 64 * 65; LAS float* X = Lw + 64 * 65;
    LAS float* Gc = X + 64 * 129; LAS float* be = Gc + 64;
    LAS bf16_t* qb = (LAS bf16_t*)(be + 64); LAS bf16_t* kb = qb + 64 * 72;
    bf16_t graw_a = 0, graw_b = 0;
    if (tid < 64) { const bf16_t* pr0 = pb + (size_t)(t0 + tid) * NP; graw_a = pr0[C_DA + h]; graw_b = pr0[C_DB + h]; }
    {
        LAS float* cwL = (LAS float*)(kb + 64 * 72);
        if (tid < 192) *(LAS f32x4*)(cwL + tid * 4) = *(const f32x4*)(p.dn_conv_w + ((size_t)l * 768 + (tid >> 6) * 256 + h * 64 + (tid & 63)) * 4);
        u32x4 xd[3][4];
#pragma unroll
        for (int it = 0; it < 3; ++it) { const int q = tid + 512 * it, t = q / 24, cc8 = (q % 24) * 8, chg = (cc8 >> 6) * 256 + h * 64 + (cc8 & 63);
#pragma unroll
            for (int i = 0; i < 4; ++i) { const int tt = t0 + t - 3 + i; xd[it][i] = tt >= 0 ? *(const u32x4*)(pb + (size_t)tt * NP + C_DQKV + chg) : (u32x4){0u, 0u, 0u, 0u}; } }
        __syncthreads();
#pragma unroll
        for (int it = 0; it < 3; ++it) { const int q = tid + 512 * it, t = q / 24, cc8 = (q % 24) * 8, sec = cc8 >> 6, c = cc8 & 63;
            float acc[8];
#pragma unroll
            for (int e = 0; e < 8; ++e) acc[e] = 0.f;
#pragma unroll
            for (int i = 0; i < 4; ++i) { const u32x4 u = xd[it][i]; const float xs[8] = {bflo(u.x), bfhi(u.x), bflo(u.y), bfhi(u.y), bflo(u.z), bfhi(u.z), bflo(u.w), bfhi(u.w)};
#pragma unroll
                for (int e = 0; e < 8; ++e) acc[e] += cwL[(cc8 + e) * 4 + i] * xs[e]; }
            LAS float* dst = (sec == 0 ? qn : (sec == 1 ? kn : vv)) + t * 65 + c;
#pragma unroll
            for (int e = 0; e < 8; ++e) dst[e] = acc[e] * sigmoidf_(acc[e]); }
    }
    __syncthreads();
    { LAS float* row = ((tid >> 2) < 64 ? qn : kn) + ((tid >> 2) & 63) * 65 + (tid & 3) * 16; float ss = 0.f;
#pragma unroll
        for (int c = 0; c < 16; ++c) ss += row[c] * row[c];
        ss += __shfl_xor(ss, 1); ss += __shfl_xor(ss, 2);
        const float sc = rsqrtf(ss + EPS) * ((tid >> 2) < 64 ? 0.125f : 1.f);
        LAS bf16_t* rb = ((tid >> 2) < 64 ? qb : kb) + ((tid >> 2) & 63) * 72 + (tid & 3) * 16;
#pragma unroll
        for (int c = 0; c < 16; c += 2) { const float v0 = row[c] * sc, v1 = row[c + 1] * sc; row[c] = v0; row[c + 1] = v1; *(LAS unsigned*)(rb + c) = pk2(v0, v1); } }
    if (tid < 64) {
        be[tid] = sigmoidf_(bf2f(graw_b));
        float g = -__expf(p.dn_a_log[l * 4 + h]) * softplusf_(bf2f(graw_a) + p.dn_dt_bias[l * 4 + h]);
#pragma unroll
        for (int o = 1; o < 64; o <<= 1) { const float v = __shfl_up(g, o); if (tid >= o) g += v; }
        Gc[tid] = g; }
    __syncthreads();
    bf16_t* ob = (bf16_t*)(p.ws + OFF_DN) + (size_t)task * 5 * 4096;
    {
        const int wave = tid >> 6, lane = tid & 63, ll = lane & 15, qd = lane >> 4, ti = wave >> 1;
#pragma unroll
        for (int tt = 0; tt < 2; ++tt) { const int tj = (wave & 1) * 2 + tt;
            f32x4 ck = {0.f, 0.f, 0.f, 0.f}, cs = {0.f, 0.f, 0.f, 0.f};
            if (tj <= ti) {
#pragma unroll
                for (int k2 = 0; k2 < 2; ++k2) {
                    const bf16x8 ki = *(const LAS bf16x8*)(kb + (16 * ti + ll) * 72 + k2 * 32 + qd * 8), kj = *(const LAS bf16x8*)(kb + (16 * tj + ll) * 72 + k2 * 32 + qd * 8);
                    const bf16x8 qi = *(const LAS bf16x8*)(qb + (16 * ti + ll) * 72 + k2 * 32 + qd * 8);
                    ck = MFMA16(ki, kj, ck);
                    cs = MFMA16(kj, qi, cs);
                } }
#pragma unroll
            for (int r = 0; r < 4; ++r) { const int i = 16 * ti + 4 * qd + r, j = 16 * tj + ll;
                Lw[i * 65 + j] = j < i ? be[i] * ck[r] * __expf(Gc[i] - Gc[j]) : 0.f; }
            { const int i = 16 * ti + ll; float sv[4];
#pragma unroll
              for (int r = 0; r < 4; ++r) { const int j = 16 * tj + 4 * qd + r; sv[r] = j <= i ? cs[r] * __expf(Gc[i] - Gc[j]) : 0.f; }
              u32x2 o; o.x = pk2(sv[0], sv[1]); o.y = pk2(sv[2], sv[3]); *(u32x2*)(ob + 4 * 4096 + i * 64 + 16 * tj + 4 * qd) = o; }
        }
    }
    for (int idx = tid; idx < 4096; idx += 512) { const int i = idx >> 6, j = idx & 63;
        X[i * 129 + j] = vv[i * 65 + j] * be[i]; X[i * 129 + 64 + j] = kn[i * 65 + j] * be[i] * __expf(Gc[i]); }
    __syncthreads();
    {
        const int col = tid >> 2, part = tid & 3;
        float xr[16];
#pragma unroll
        for (int k = 0; k < 16; ++k) xr[k] = 0.f;
#pragma unroll
        for (int i = 0; i < 64; ++i) { float s0 = 0.f, s1 = 0.f;
#pragma unroll
            for (int k = 0; k < (i + 3) / 4; ++k) { const float t_ = Lw[i * 65 + 4 * k + part] * xr[k]; if (k & 1) s1 += t_; else s0 += t_; }
            s0 += s1; s0 += __shfl_xor(s0, 1); s0 += __shfl_xor(s0, 2);
            const float xi = X[i * 129 + col] - s0;
            if (part == (i & 3)) xr[i >> 2] = xi; }
#pragma unroll
        for (int k = 0; k < 16; ++k) X[(4 * k + part) * 129 + col] = xr[k];
    }
    __syncthreads();
    const float Gl = Gc[63];
    for (int i2 = tid; i2 < 2048; i2 += 512) { const int a = i2 >> 5, c = (i2 & 31) * 2;
        *(unsigned*)(ob + 0 * 4096 + a * 64 + c) = pk2(X[a * 129 + 64 + c], X[a * 129 + 65 + c]);
        *(unsigned*)(ob + 1 * 4096 + a * 64 + c) = pk2(kn[c * 65 + a] * __expf(Gl - Gc[c]), kn[(c + 1) * 65 + a] * __expf(Gl - Gc[c + 1]));
        *(unsigned*)(ob + 2 * 4096 + a * 64 + c) = pk2(X[c * 129 + a], X[(c + 1) * 129 + a]);
        const float eg = __expf(Gc[a]);
        *(unsigned*)(ob + 3 * 4096 + a * 64 + c) = pk2(qn[a * 65 + c] * eg, qn[a * 65 + c + 1] * eg); }
    if (tid == 0) ((float*)(p.ws + OFF_DNA))[task] = __expf(Gl);
    __syncthreads();
}
__device__ __forceinline__ void dn_scan_task(const Params& p, int l, LAS unsigned char* lds, int task) {
    constexpr int RS = 72, MATB = 64 * RS * 2  , STG = 4 * MATB + 16 * RS * 2;
    const int tid = TIDX, wave = tid >> 6, lane = tid & 63, ll = lane & 15, qd = lane >> 4, bh = task >> 2, b = bh >> 2, h = bh & 3;
    const bf16_t* cb = (const bf16_t*)(p.ws + OFF_DN) + (size_t)bh * 256 * 5 * 4096;
    const float* al = (const float*)(p.ws + OFF_DNA) + bh * 256;
    const int lrow = tid >> 3, lc8 = tid & 7;
    LAS float* alL = (LAS float*)(lds + 3 * STG);
    if (tid < 256) alL[tid] = al[tid];
    u32x4 pre[3][5];
    const int d0 = (task & 3) * 16;
#define DN_ISSUE(n, st) do { const int n_ = (n) < 255 ? (n) : 255; _Pragma("unroll") for (int m_ = 0; m_ < 4; ++m_) pre[st][m_] = *(const u32x4*)(cb + ((size_t)n_ * 5 + (m_ < 2 ? m_ : m_ + 1)) * 4096 + tid * 8); \
        pre[st][4] = *(const u32x4*)(cb + ((size_t)n_ * 5 + 2) * 4096 + d0 * 64 + (tid & 127) * 8); } while (0)
#define DN_COMMIT(st) do { LAS unsigned char* sb_ = lds + (st) * STG; _Pragma("unroll") for (int m_ = 0; m_ < 4; ++m_) *(LAS u32x4*)(sb_ + m_ * MATB + lrow * (RS * 2) + lc8 * 16) = pre[st][m_]; \
        if (tid < 128) *(LAS u32x4*)(sb_ + 4 * MATB + lrow * (RS * 2) + lc8 * 16) = pre[st][4]; } while (0)
    DN_ISSUE(0, 0); DN_ISSUE(1, 1); DN_COMMIT(0); DN_COMMIT(1); DN_ISSUE(2, 2); DN_ISSUE(3, 0); DN_ISSUE(4, 1);
    f32x4 S[4];
#pragma unroll
    for (int m = 0; m < 4; ++m) S[m] = (f32x4){0.f, 0.f, 0.f, 0.f};
    __syncthreads();
#define DN_FRAG(mat, mt, k2) ({ const LAS bf16_t* _r = (const LAS bf16_t*)(sb + (mat) * MATB) + (16 * (mt) + ll) * RS + 32 * (k2) + 4 * qd; mk8(*(const LAS u32x2*)_r, *(const LAS u32x2*)(_r + 16)); })
#define DN_STEP(n, st) do { \
        DN_COMMIT(((st) + 2) % 3); \
        DN_ISSUE((n) + 5, ((st) + 2) % 3); \
        if (wave < 1) { \
            const LAS unsigned char* sb = lds + (st) * STG; \
              \
            u32x2 uc[4]; bf16x8 fw[4][2], fk[4][2], fq[4][2], fs[4][2]; \
            _Pragma("unroll") for (int m = 0; m < 4; ++m) _Pragma("unroll") for (int k2 = 0; k2 < 2; ++k2) fw[m][k2] = DN_FRAG(0, m, k2); \
            _Pragma("unroll") for (int m = 0; m < 4; ++m) uc[m] = *(const LAS u32x2*)((const LAS bf16_t*)(sb + 4 * MATB) + ll * RS + 16 * m + 4 * qd); \
            _Pragma("unroll") for (int m = 0; m < 4; ++m) _Pragma("unroll") for (int k2 = 0; k2 < 2; ++k2) fk[m][k2] = DN_FRAG(1, m, k2); \
            const float a = alL[n]; \
            __builtin_amdgcn_sched_barrier(0); \
            bf16x8 Sb[2], Vb[2]; \
            Sb[0] = pk8(S[0], S[1]); Sb[1] = pk8(S[2], S[3]); \
            f32x4 vn[4], oo[4]; \
            _Pragma("unroll") for (int m = 0; m < 4; ++m) { f32x4 acc = {0.f, 0.f, 0.f, 0.f}; \
                _Pragma("unroll") for (int k2 = 0; k2 < 2; ++k2) acc = MFMA16(fw[m][k2], Sb[k2], acc); \
                vn[m][0] = bflo(uc[m].x) - acc[0]; vn[m][1] = bfhi(uc[m].x) - acc[1]; vn[m][2] = bflo(uc[m].y) - acc[2]; vn[m][3] = bfhi(uc[m].y) - acc[3]; } \
            Vb[0] = pk8(vn[0], vn[1]); Vb[1] = pk8(vn[2], vn[3]); \
            _Pragma("unroll") for (int m = 0; m < 4; ++m) _Pragma("unroll") for (int k2 = 0; k2 < 2; ++k2) { fq[m][k2] = DN_FRAG(2, m, k2); fs[m][k2] = DN_FRAG(3, m, k2); } \
            __builtin_amdgcn_sched_barrier(0); \
            _Pragma("unroll") for (int m = 0; m < 4; ++m) { f32x4 acc = S[m] * a; \
                _Pragma("unroll") for (int k2 = 0; k2 < 2; ++k2) acc = MFMA16(fk[m][k2], Vb[k2], acc); \
                S[m] = acc; } \
            _Pragma("unroll") for (int m = 0; m < 4; ++m) { f32x4 acc = {0.f, 0.f, 0.f, 0.f};   \
                _Pragma("unroll") for (int k2 = 0; k2 < 2; ++k2) { acc = MFMA16(Sb[k2], fq[m][k2], acc); acc = MFMA16(Vb[k2], fs[m][k2], acc); } \
                oo[m] = acc; } \
            bf16_t* op = (bf16_t*)(p.ws + OFF_O) + ((size_t)b * SEQ + (n) * 64 + ll) * DM + O_DN + h * 64 + d0 + 4 * qd; \
            _Pragma("unroll") for (int m = 0; m < 4; ++m) { u32x2 o; o.x = pk2(oo[m][0], oo[m][1]); o.y = pk2(oo[m][2], oo[m][3]); *(u32x2*)(op + (size_t)(16 * m) * DM) = o; } \
        } \
        __syncthreads(); \
    } while (0)
    for (int n = 0; n < 255; n += 3) { DN_STEP(n, 0); DN_STEP(n + 1, 1); DN_STEP(n + 2, 2); }
    DN_STEP(255, 0);
#undef DN_STEP
#undef DN_FRAG
#undef DN_ISSUE
#undef DN_COMMIT
}
__device__ __forceinline__ void dn_norm_task(const Params& p, int l, int task8) {
    const int tid = TIDX, d8 = (tid & 7) * 8;
    u32x4 uu[8], gg[8];
#pragma unroll
    for (int sub = 0; sub < 8; ++sub) { const int pair = (task8 * 8 + sub) * 64 + (tid >> 3), tok = pair >> 2, h = pair & 3;
        uu[sub] = *(const u32x4*)((const bf16_t*)(p.ws + OFF_O) + (size_t)tok * DM + O_DN + h * 64 + d8);
        gg[sub] = *(const u32x4*)((const bf16_t*)(p.ws + OFF_B) + (size_t)tok * NP + C_DG + h * 64 + d8); }
    float gn[8];
#pragma unroll
    for (int e = 0; e < 8; ++e) gn[e] = p.dn_norm_g[l * 64 + d8 + e];
#pragma unroll
    for (int sub = 0; sub < 8; ++sub) { const int pair = (task8 * 8 + sub) * 64 + (tid >> 3), tok = pair >> 2, h = pair & 3;
        const u32x4 u = uu[sub], gt = gg[sub];
        const float ov[8] = {bflo(u.x), bfhi(u.x), bflo(u.y), bfhi(u.y), bflo(u.z), bfhi(u.z), bflo(u.w), bfhi(u.w)};
        const float gv[8] = {bflo(gt.x), bfhi(gt.x), bflo(gt.y), bfhi(gt.y), bflo(gt.z), bfhi(gt.z), bflo(gt.w), bfhi(gt.w)};
        float ss = 0.f;
#pragma unroll
        for (int e = 0; e < 8; ++e) ss += ov[e] * ov[e];
        ss += __shfl_xor(ss, 1); ss += __shfl_xor(ss, 2); ss += __shfl_xor(ss, 4);
        const float rstd = rsqrtf(ss * (1.f / 64.f) + EPS);
        float r[8];
#pragma unroll
        for (int e = 0; e < 8; ++e) r[e] = ov[e] * rstd * gn[e] * gv[e] * sigmoidf_(gv[e]);
        u32x4 o; o.x = pk2(r[0], r[1]); o.y = pk2(r[2], r[3]); o.z = pk2(r[4], r[5]); o.w = pk2(r[6], r[7]);
        *(u32x4*)((bf16_t*)(p.ws + OFF_O) + (size_t)tok * DM + O_DN + h * 64 + d8) = o; }
}

__device__ __forceinline__ int next_task(int* cnt, LAS int* slot, int& pre) {
    __syncthreads();
    if (TIDX == 0) *slot = pre;
    __syncthreads();
    const int t = __builtin_amdgcn_readfirstlane(*slot);
    if (TIDX == 0) pre = atomicAdd(cnt, 1);
    return t;
}
__device__ __forceinline__ void mix_phase(const Params& p, int l, int k, LAS unsigned char* lds) {
    int* cnt = (int*)(p.ws + OFF_CNT) + l * 3 + k;
    LAS int* slot = (LAS int*)(lds + LDS_BYTES + 16);
    int pre = 0; if (TIDX == 0) pre = atomicAdd(cnt, 1);
    unsigned* gready = (unsigned*)(p.ws + OFF_CNT) + 32 + l * 8;
    if (k == 0) {
        for (;;) { int t = next_task(cnt, slot, pre);
            if (t < 2048) { dn_prep_task(p, l, lds, t); continue; } t -= 2048;
            if (t < 1024) { dil_task(p, l, lds, 0, t); continue; } t -= 1024;
            if (t < 2048) { gla_a_task(p, l, lds, t); continue; }
            break; }
    } else if (k == 1) {
        for (;;) { int t = next_task(cnt, slot, pre);
            if (t < 32) { dn_scan_task(p, l, lds, t); continue; } t -= 32;
            if (t < 32) { gla_scan_task(p, lds, t, gready + (t >> 2)); continue; } t -= 32;
            if (t < 1024) { sb_task(p, l, lds, t); continue; } t -= 1024;
            if (t < 1024) { dil_task(p, l, lds, 1, t); continue; } t -= 1024;
            if (t < 2048) { gla_c_task(p, l, lds, t, gready); continue; }
            break; }
    } else {
        for (;;) { int t = next_task(cnt, slot, pre);
            if (t < 1024) { dil_task(p, l, lds, 2, t); continue; } t -= 1024;
            if (t < 256) { dn_norm_task(p, l, t); continue; }
            break; }
    }
}

#define XB_TMO      128
#define XB_XCNT(j)  (256  + 64 * (j))
#define XB_XSUB(j)  (1280 + 64 * (j))
#define XB_XGEN(j)  (2304 + 64 * (j))
#define XB_TOP      3328
#define XB_TOPGEN   3392
#define XCD_BAR_WORDS 3456
#define XB_SPIN_CAP (1u << 22)
__device__ __forceinline__ unsigned xb_ld(unsigned* p)              { return __hip_atomic_load(p, __ATOMIC_RELAXED, __HIP_MEMORY_SCOPE_AGENT); }
__device__ __forceinline__ unsigned xb_add(unsigned* p, unsigned v) { return __hip_atomic_fetch_add(p, v, __ATOMIC_RELAXED, __HIP_MEMORY_SCOPE_AGENT); }
__device__ __forceinline__ unsigned xb_xcc_id() { return (unsigned)__builtin_amdgcn_s_getreg((3 << 11) | 20) & 0xFu; }
#define XB_SPIN(cond, bar) do { unsigned _sp = 0; while (cond) { __builtin_amdgcn_s_sleep(1); \
    if ((++_sp & 255u) == 0u) { if (xb_ld(&(bar)[XB_TMO])) break; if (_sp > XB_SPIN_CAP) { atomicAdd(&(bar)[XB_TMO], 1u); break; } } } } while (0)
struct XcdBarrier { unsigned* bar; unsigned x; volatile LAS unsigned* st; };
__device__ __forceinline__ XcdBarrier xcd_barrier_post(unsigned* bar, volatile LAS unsigned* st) {
    XcdBarrier b; b.bar = bar; b.x = xb_xcc_id(); b.st = st;
    if (TIDX == 0) (void)xb_add(&bar[XB_XCNT(b.x)], 1u);
    return b;
}
__device__ __forceinline__ void xcd_barrier_complete(unsigned* bar, unsigned x, unsigned& nloc, unsigned& nx) {
    const unsigned G = gridDim.x * gridDim.y * gridDim.z;
    unsigned sum, cnt, mine, sp = 0u;
    for (;;) {
        sum = 0u; cnt = 0u; mine = 0u;
#pragma unroll
        for (unsigned j = 0; j < 16; ++j) { const unsigned c = xb_ld(&bar[XB_XCNT(j)]); sum += c; cnt += (c > 0u) ? 1u : 0u; mine = (j == x) ? c : mine; }
        if (sum == G) break;
        __builtin_amdgcn_s_sleep(1);
        if ((++sp & 255u) == 0u) { if (xb_ld(&bar[XB_TMO])) break; if (sp > XB_SPIN_CAP) { atomicAdd(&bar[XB_TMO], 1u); break; } }
    }
    nloc = mine > 0u ? mine : 1u; nx = cnt > 0u ? cnt : 1u;
}
__device__ __forceinline__ void xcd_barrier(const XcdBarrier& b) {
    asm volatile("s_waitcnt vmcnt(0)" ::: "memory");
    __syncthreads();
    if (TIDX == 0) {
        unsigned* bar = b.bar;
        __builtin_amdgcn_s_waitcnt(0);
        unsigned nloc = b.st[0], nx = b.st[1];
        if (nloc == 0u) { xcd_barrier_complete(bar, b.x, nloc, nx); b.st[0] = nloc; b.st[1] = nx; }
        const unsigned old = xb_add(&bar[XB_XSUB(b.x)], 1u);
        const unsigned gen = old / nloc;
        if (old + 1u == (gen + 1u) * nloc) {
            __builtin_amdgcn_fence(__ATOMIC_RELEASE, "agent");
            asm volatile("s_waitcnt vmcnt(0)" ::: "memory");
            const unsigned og = xb_add(&bar[XB_TOP], 1u);
            const unsigned tg = og / nx;
            if (og + 1u == (tg + 1u) * nx) xb_add(&bar[XB_TOPGEN], 1u);
            else XB_SPIN(xb_ld(&bar[XB_TOPGEN]) == tg, bar);
            __builtin_amdgcn_fence(__ATOMIC_ACQUIRE, "agent");
            xb_add(&bar[XB_XGEN(b.x)], 1u);
            asm volatile("s_waitcnt vmcnt(0)" ::: "memory");
        } else {
            XB_SPIN(xb_ld(&bar[XB_XGEN(b.x)]) == gen, bar);
            __builtin_amdgcn_fence(__ATOMIC_ACQUIRE, "agent");
            asm volatile("s_waitcnt vmcnt(0)" ::: "memory");
        }
    }
    __syncthreads();
}

__global__ void __launch_bounds__(512) fwd_kernel(Params p) {
    extern __shared__ __attribute__((aligned(16))) unsigned char shm[];
    LAS unsigned char* lds = (LAS unsigned char*)shm;
    cg::grid_group grid = cg::this_grid();
    unsigned char* ws = p.ws;
    volatile LAS unsigned* bst = (volatile LAS unsigned*)(lds + LDS_BYTES);
    if (TIDX < 2) bst[TIDX] = 0u;
    __syncthreads();
    XcdBarrier gbar; gbar.bar = (unsigned*)(ws + OFF_BAR); gbar.x = 0; gbar.st = bst;
    if (p.ph_hi - p.ph_lo > 1) gbar = xcd_barrier_post((unsigned*)(ws + OFF_BAR), bst);
    if (p.ph_hi > 1000000) grid.sync();
    for (int ph = p.ph_lo; ph < p.ph_hi; ++ph) {
        const int l = ph / NPH, k = ph % NPH;
        const float* xin = (l == 0) ? p.x : p.out;
        if (k == 0) {
            wconv_phase(p, l, lds);
            rmsnorm_phase(xin, p.g_mix + l * DM, (bf16_t*)(ws + OFF_H));
        } else if (k == 8) {
            rmsnorm_phase(p.out, p.g_mlp + l * DM, (bf16_t*)(ws + OFF_H));
        } else if (k >= 2 && k <= 4) {
            mix_phase(p, l, k - 2, lds);
        } else {
            pg8::Epi E; E.mode = 0; E.O = (bf16_t*)(ws + OFF_B); E.ldc = NP; E.Xin = xin; E.Xout = p.out; E.Y = (const bf16_t*)(ws + OFF_B);
            const bf16_t* A = (const bf16_t*)(ws + OFF_H); const bf16_t* Bt = (const bf16_t*)(ws + OFF_WIN); int lda = DM, a_sh = 0, a_mul = 0, N = NP, K = DM;
            if (k == 5) { E.ldc = 4096; A = (const bf16_t*)(ws + OFF_O); a_sh = 2; a_mul = 256; Bt = (const bf16_t*)(ws + OFF_WB); N = 4096; K = 256; }
            else if (k == 6) { E.mode = 3; E.O = (bf16_t*)(ws + OFF_O); Bt = (const bf16_t*)(ws + OFF_WG); N = 4096; }
            else if (k == 7) { E.mode = 2; A = (const bf16_t*)(ws + OFF_O); Bt = (const bf16_t*)(ws + OFF_WO); N = DM; }
            else if (k == 9) { E.mode = 1; E.ldc = DFF; Bt = (const bf16_t*)(ws + OFF_W1); N = DFF; }
            else if (k == 10) { E.mode = 2; E.Xin = p.out; A = (const bf16_t*)(ws + OFF_B); lda = DFF; Bt = (const bf16_t*)(ws + OFF_W2); N = DM; K = DFF; }
            run_gemm(lds, A, lda, a_sh, a_mul, Bt, N, K, E);
        }
        if (ph + 1 < p.ph_hi) xcd_barrier(gbar);
    }
}

#ifndef ONE_LAUNCH
#define ONE_LAUNCH 1
#endif
extern "C" void kernel_launch(void* const* d_in, const int* in_sizes, int n_in, void* d_out, int out_size, void* d_ws, size_t ws_size, hipStream_t stream) {
    static int grid = 0;
    if (grid == 0) {
        if (n_in != 17 || out_size != T_TOK * DM || ws_size < WS_END) { fprintf(stderr, "kernel_launch: unexpected shapes / workspace (%zu < %zu)\n", ws_size, (size_t)WS_END); grid = -1; return; }
        int dev = 0, cus = 0, per_cu = 0;
        hipGetDevice(&dev); hipDeviceGetAttribute(&cus, hipDeviceAttributeMultiprocessorCount, dev);
        if (hipFuncSetAttribute((const void*)fwd_kernel, hipFuncAttributeMaxDynamicSharedMemorySize, LDS_TOTAL) != hipSuccess) { fprintf(stderr, "hipFuncSetAttribute failed\n"); grid = -1; return; }
        if (hipOccupancyMaxActiveBlocksPerMultiprocessor(&per_cu, (const void*)fwd_kernel, 512, LDS_TOTAL) != hipSuccess || per_cu < 1) per_cu = 1;
        grid = cus * per_cu;
    }
    if (grid < 0) return;
    Params p{};
    p.x = (const float*)d_in[0]; p.g_mix = (const float*)d_in[1]; p.g_mlp = (const float*)d_in[2]; p.w_in = (const float*)d_in[3]; p.gla_w_lr2 = (const float*)d_in[4];
    p.gla_b_lr = (const float*)d_in[5]; p.gla_norm_g = (const float*)d_in[6]; p.dn_conv_w = (const float*)d_in[7]; p.dn_a_log = (const float*)d_in[8]; p.dn_dt_bias = (const float*)d_in[9];
    p.dn_norm_g = (const float*)d_in[10]; p.dil_q_g = (const float*)d_in[11]; p.dil_k_g = (const float*)d_in[12]; p.w_branch = (const float*)d_in[13]; p.w_out = (const float*)d_in[14];
    p.w_mlp_in = (const float*)d_in[15]; p.w_mlp_out = (const float*)d_in[16]; p.out = (float*)d_out; p.ws = (unsigned char*)d_ws;
    if (hipMemsetAsync((char*)d_ws + OFF_CNT, 0, 256 + 16384, stream) != hipSuccess) { fprintf(stderr, "memset failed\n"); return; }
#if ONE_LAUNCH
    p.ph_lo = 0; p.ph_hi = NLAYER * NPH;
    void* args[] = {&p};
    hipError_t e = hipLaunchCooperativeKernel((const void*)fwd_kernel, dim3(grid), dim3(512), args, LDS_TOTAL, stream);
    if (e != hipSuccess) fprintf(stderr, "cooperative launch failed: %s (grid %d)\n", hipGetErrorString(e), grid);
#else
    for (int ph = 0; ph < NLAYER * NPH; ++ph) { p.ph_lo = ph; p.ph_hi = ph + 1; hipLaunchKernelGGL(fwd_kernel, dim3(grid), dim3(512), LDS_TOTAL, stream, p); }
#endif
}
```

```cpp
#include <hip/hip_runtime.h>
#include <hip/hip_cooperative_groups.h>
#include <cstdio>
namespace cg = cooperative_groups;

#define LAS __attribute__((address_space(3)))
typedef unsigned short bf16_t;
typedef short bf16x8 __attribute__((ext_vector_type(8)));
typedef short bf16x4 __attribute__((ext_vector_type(4)));
typedef float f32x4 __attribute__((ext_vector_type(4)));
typedef unsigned u32x4 __attribute__((ext_vector_type(4)));
typedef unsigned u32x2 __attribute__((ext_vector_type(2)));

constexpr int T_TOK = 32768, SEQ = 16384, DM = 1024, NP = 3584, DFF = 4096;
constexpr int C_SBQ = 0, C_SBK = 256, C_SBV = 512, C_GQ = 768, C_GK = 896, C_GV = 1024, C_GLR = 1280, C_GR = 1296, C_DQKV = 1552, C_DA = 2320, C_DB = 2324,
              C_DG = 2328, C_LQ = 2584, C_LK = 2840, C_LV = 3096, C_GATE = 3352, N_IN = 7448;
constexpr int O_SB = 0, O_GLA = 256, O_DN = 512, O_DIL = 768;
constexpr float EPS = 1e-6f;
constexpr int NLAYER = 4, NPH = 11;
constexpr size_t SZ_WIN = (size_t)NP * DM * 2, SZ_WG = (size_t)4096 * DM * 2, SZ_WB = (size_t)4096 * 256 * 2, SZ_WO = (size_t)DM * DM * 2, SZ_W1 = (size_t)DFF * DM * 2, SZ_W2 = (size_t)DM * DFF * 2;
constexpr size_t OFF_WIN = 0, OFF_WG = OFF_WIN + SZ_WIN, OFF_WB = OFF_WG + SZ_WG, OFF_WO = OFF_WB + SZ_WB, OFF_W1 = OFF_WO + SZ_WO, OFF_W2 = OFF_W1 + SZ_W1;
constexpr size_t OFF_B = OFF_W2 + SZ_W2;
constexpr size_t SZ_B = (size_t)T_TOK * 4096 * 2;
constexpr size_t OFF_GLAU = OFF_B + (size_t)T_TOK * NP * 2;
constexpr size_t OFF_GLAA = OFF_GLAU + (size_t)2048 * 2048 * 4;
constexpr size_t OFF_DSTAT = OFF_GLAA + (size_t)2048 * 32 * 4;
constexpr size_t OFF_DNA = OFF_DSTAT + (size_t)T_TOK * 4 * 2 * 4;
constexpr size_t OFF_H = OFF_B + SZ_B;
constexpr size_t OFF_O = OFF_H + (size_t)T_TOK * DM * 2;
constexpr size_t OFF_DN = OFF_O + (size_t)T_TOK * DM * 2;
constexpr size_t OFF_CNT = OFF_DN + (size_t)2048 * 5 * 8192;
constexpr size_t OFF_BAR = OFF_CNT + 256;
constexpr size_t WS_END = OFF_BAR + 16384;
static_assert(OFF_DNA + 2048 * 4 <= OFF_H, "region B overflow");
constexpr int LDS_BYTES = 131072, LDS_TOTAL = LDS_BYTES + 64;

struct Params {
    const float* x; const float* g_mix; const float* g_mlp; const float* w_in; const float* gla_w_lr2; const float* gla_b_lr; const float* gla_norm_g;
    const float* dn_conv_w; const float* dn_a_log; const float* dn_dt_bias; const float* dn_norm_g; const float* dil_q_g; const float* dil_k_g;
    const float* w_branch; const float* w_out; const float* w_mlp_in; const float* w_mlp_out;
    float* out; unsigned char* ws; int ph_lo, ph_hi;
};

typedef __bf16 bf16v2_t __attribute__((ext_vector_type(2)));
typedef float f32v2_t __attribute__((ext_vector_type(2)));
__device__ __forceinline__ unsigned pk2(float lo, float hi) { f32v2_t v = {lo, hi}; bf16v2_t b = __builtin_convertvector(v, bf16v2_t); return __builtin_bit_cast(unsigned, b); }
__device__ __forceinline__ float bf2f(bf16_t b) { return __uint_as_float(((unsigned)b) << 16); }
__device__ __forceinline__ float bflo(unsigned u) { return __uint_as_float(u << 16); }
__device__ __forceinline__ float bfhi(unsigned u) { return __uint_as_float(u & 0xffff0000u); }
__device__ __forceinline__ bf16_t f2bf(float f) { return (bf16_t)(pk2(f, 0.f) & 0xffffu); }
__device__ __forceinline__ float wave_sum(float v) {
#pragma unroll
    for (int o = 1; o < 64; o <<= 1) v += __shfl_xor(v, o);
    return v;
}
__device__ __forceinline__ float sigmoidf_(float x) { return __builtin_amdgcn_rcpf(1.f + __expf(-x)); }
__device__ __forceinline__ float sigmoid_fast(float x) { return __builtin_amdgcn_rcpf(1.f + __expf(-x)); }
__device__ __forceinline__ float softplusf_(float z) { return fmaxf(z, 0.f) + __logf(1.f + __expf(-fabsf(z))); }
__device__ __forceinline__ bf16x8 mk8(u32x2 a, u32x2 b) { u32x4 t; t.x = a.x; t.y = a.y; t.z = b.x; t.w = b.y; return __builtin_bit_cast(bf16x8, t); }
__device__ __forceinline__ bf16x8 pk8(f32x4 a, f32x4 b) { u32x4 t; t.x = pk2(a[0], a[1]); t.y = pk2(a[2], a[3]); t.z = pk2(b[0], b[1]); t.w = pk2(b[2], b[3]); return __builtin_bit_cast(bf16x8, t); }
__device__ __forceinline__ int tid_opaque() { int t = (int)threadIdx.x; asm volatile("" : "+v"(t)); return t; }
#define TIDX tid_opaque()
#define MFMA16(a, b, c) __builtin_amdgcn_mfma_f32_16x16x32_bf16((a), (b), (c), 0, 0, 0)

namespace pg8 {
constexpr int BM = 256, BK = 64, HALF = 128, HTB = HALF * BK * 2, NXCD = 8, WGM = 8;
__device__ __forceinline__ int lds_byte(int r, int c) { const int st = (r >> 4) * 2 + (c >> 5), rr = r & 15, cc = c & 31, ob = rr * 64 + cc * 2; return st * 1024 + (ob ^ (((ob >> 9) & 1) << 5)); }
__device__ __forceinline__ void stage_rc(int b, int& R, int& C) { const int st = b / 1024, sb = b % 1024, swz = sb ^ (((sb >> 9) & 1) << 5); R = (st >> 1) * 16 + swz / 64; C = (st & 1) * 32 + (swz % 64) / 2; }
__device__ __forceinline__ int perm32(int rho) { const int n = rho >> 4, i = rho & 15; return 8 * (i >> 2) + 4 * n + (i & 3); }
struct Unit { int pm, pn; };
struct Gemm { const bf16_t* A; const bf16_t* Bt; int M, N, K, lda, a_sh, a_mul; };
struct StaticOrder {
    int nM, nN, nwg, G, c;
    __device__ void init(int M, int N, int G_, int c_) { nM = M / BM; nN = N / BM; nwg = nM * nN; G = G_; c = c_; }
    __device__ bool next(int i, Unit& u) const {
        const long L = (long)i * G + c; if (L >= nwg) return false;
        int wgid = (int)L; { const int q = nwg / NXCD, r = nwg % NXCD, xcd = wgid % NXCD, off = wgid / NXCD; wgid = (xcd < r ? xcd * (q + 1) : r * (q + 1) + (xcd - r) * q) + off; }
        const int nig = WGM * nN, gid = wgid / nig, fm = gid * WGM, gsz = (nM - fm) < WGM ? (nM - fm) : WGM;
        u.pm = fm + ((wgid % nig) % gsz); u.pn = (wgid % nig) / gsz; return true;
    }
};
struct Epi {
    int mode; bf16_t* O; int ldc; const float* Xin; float* Xout; const bf16_t* Y;
    __device__ __forceinline__ void operator()(const f32x4 (&acc)[2][2][4][2], const Unit& u, int wr, int wc, int fr, int fq) const {
        const int row0 = u.pm * BM + wr * 64 + fr;
        if (mode < 2) {
            const int col0 = u.pn * BM + wc * 32 + 8 * fq;
#pragma unroll
            for (int ai = 0; ai < 2; ++ai)
#pragma unroll
                for (int m = 0; m < 4; ++m) { bf16_t* rowp = O + (size_t)(row0 + ai * HALF + m * 16) * ldc + col0;
#pragma unroll
                    for (int bj = 0; bj < 2; ++bj) { f32x4 v0 = acc[ai][bj][m][0], v1 = acc[ai][bj][m][1];
                        if (mode == 1) {
#pragma unroll
                            for (int j = 0; j < 4; ++j) { float a = fmaxf(v0[j], 0.f), b = fmaxf(v1[j], 0.f); v0[j] = a * a; v1[j] = b * b; } }
                        u32x4 o; o.x = pk2(v0[0], v0[1]); o.y = pk2(v0[2], v0[3]); o.z = pk2(v1[0], v1[1]); o.w = pk2(v1[2], v1[3]);
                        *(u32x4*)(rowp + bj * HALF) = o; } }
        } else if (mode == 2) {
            const int col0 = u.pn * BM + wc * 32 + 4 * fq;
#pragma unroll
            for (int ai = 0; ai < 2; ++ai) { f32x4 xi[4][2][2];
#pragma unroll
                for (int m = 0; m < 4; ++m) { const size_t ro = (size_t)(row0 + ai * HALF + m * 16) * DM + col0;
#pragma unroll
                    for (int bj = 0; bj < 2; ++bj)
#pragma unroll
                        for (int n = 0; n < 2; ++n) xi[m][bj][n] = *(const f32x4*)(Xin + ro + bj * HALF + n * 16); }
                __builtin_amdgcn_sched_barrier(0);
#pragma unroll
                for (int m = 0; m < 4; ++m) { const size_t ro = (size_t)(row0 + ai * HALF + m * 16) * DM + col0;
#pragma unroll
                    for (int bj = 0; bj < 2; ++bj)
#pragma unroll
                        for (int n = 0; n < 2; ++n) *(f32x4*)(Xout + ro + bj * HALF + n * 16) = xi[m][bj][n] + acc[ai][bj][m][n]; }
                __builtin_amdgcn_sched_barrier(0); }
        } else {
            const int ch0 = u.pn * 64 + wc * 16 + 4 * fq;
#pragma unroll
            for (int ai = 0; ai < 2; ++ai) { u32x2 y[4][2][2];
#pragma unroll
                for (int m = 0; m < 4; ++m) { const size_t row = (size_t)(row0 + ai * HALF + m * 16);
#pragma unroll
                    for (int bj = 0; bj < 2; ++bj)
#pragma unroll
                        for (int n = 0; n < 2; ++n) y[m][bj][n] = *(const u32x2*)(Y + row * 4096 + (2 * bj + n) * 1024 + ch0); }
                __builtin_amdgcn_sched_barrier(0);
#pragma unroll
                for (int m = 0; m < 4; ++m) { const size_t row = (size_t)(row0 + ai * HALF + m * 16); f32x4 s = {0.f, 0.f, 0.f, 0.f};
#pragma unroll
                    for (int bj = 0; bj < 2; ++bj)
#pragma unroll
                        for (int n = 0; n < 2; ++n) { const u32x2 yy = y[m][bj][n]; const f32x4 a = acc[ai][bj][m][n];
                            s[0] += sigmoid_fast(a[0]) * bflo(yy.x); s[1] += sigmoid_fast(a[1]) * bfhi(yy.x); s[2] += sigmoid_fast(a[2]) * bflo(yy.y); s[3] += sigmoid_fast(a[3]) * bfhi(yy.y); }
                    u32x2 o; o.x = pk2(s[0], s[1]); o.y = pk2(s[2], s[3]); *(u32x2*)(O + row * DM + ch0) = o; }
                __builtin_amdgcn_sched_barrier(0); }
        }
    }
};

__device__ __forceinline__ void gemm_phase(LAS unsigned char* lds, const Gemm g, const StaticOrder& S, const Epi& E) {
    const int tid = TIDX, wid = __builtin_amdgcn_readfirstlane(tid >> 6), lane = tid & 63, wr = wid >> 2, wc = wid & 3, fr = lane & 15, fq = lane >> 4;
    const int K = g.K, nt = K / BK, lda = g.lda;
    unsigned voffA[2], voffB[2];
#pragma unroll
    for (int i = 0; i < 2; ++i) { int R, C; stage_rc(tid * 16 + i * 8192, R, C); const int Rb = (E.mode < 2) ? ((R & ~31) + perm32(R & 31)) : R;
        voffA[i] = (unsigned)(R * lda + C) * 2u; voffB[i] = (unsigned)(Rb * K + C) * 2u; }
    const size_t kstep = (size_t)(BK * 2);
    const size_t hstepA = (size_t)HALF * lda * 2, hstepB = (size_t)HALF * K * 2;
    const size_t tstepA = 2 * hstepA, tstepB = 2 * hstepB;
    const unsigned ldsw = (unsigned)wid * 1024u;
    const int aoff = lds_byte(wr * 64 + fr, fq * 8), boff = lds_byte(wc * 32 + fr, fq * 8);
#define PG8_SA(b, h) (((b) * 2 + (h)) * HTB)
#define PG8_SB(b, h) ((4 + (b) * 2 + (h)) * HTB)
#define PG8_STAGE(bufoff, gbase, voff) do { _Pragma("unroll") for (int _i = 0; _i < 2; ++_i) \
        __builtin_amdgcn_global_load_lds((const unsigned*)((const char*)(gbase) + (voff)[_i]), (LAS unsigned*)(lds + (bufoff) + ldsw + _i * 8192), 16, 0, 0); } while (0)
#define PG8_LDA(dst, b, h) do { _Pragma("unroll") for (int m = 0; m < 4; ++m) _Pragma("unroll") for (int k = 0; k < 2; ++k) dst[m][k] = *(const LAS bf16x8*)(lds + PG8_SA(b, h) + aoff + m * 2048 + k * 1024); } while (0)
#define PG8_LDB(dst, b, h) do { _Pragma("unroll") for (int n = 0; n < 2; ++n) _Pragma("unroll") for (int k = 0; k < 2; ++k) dst[n][k] = *(const LAS bf16x8*)(lds + PG8_SB(b, h) + boff + n * 2048 + k * 1024); } while (0)
#define PG8_MMA(ai, bj, At, Bt) do { __builtin_amdgcn_s_setprio(1); _Pragma("unroll") for (int m = 0; m < 4; ++m) _Pragma("unroll") for (int n = 0; n < 2; ++n) _Pragma("unroll") for (int k = 0; k < 2; ++k) \
        acc[ai][bj][m][n] = __builtin_amdgcn_mfma_f32_16x16x32_bf16(Bt[n][k], At[m][k], acc[ai][bj][m][n], 0, 0, 0); __builtin_amdgcn_s_setprio(0); } while (0)
#define PG8_WAIT_V(n) asm volatile("s_waitcnt vmcnt(" #n ")" ::: "memory")
#define PG8_WAIT_L(n) asm volatile("s_waitcnt lgkmcnt(" #n ")" ::: "memory")
#define PG8_BAR __builtin_amdgcn_s_barrier()
#define PG8_SCHED __builtin_amdgcn_sched_barrier(0)
#define PG8_APTR(u) ((const char*)g.A + (size_t)(u).pm * tstepA + (size_t)(((u).pn >> g.a_sh) * g.a_mul) * 2)
    Unit cur, nxt; int ui = 0;
    if (!S.next(0, cur)) return;
    f32x4 acc[2][2][4][2];
#pragma unroll
    for (int a = 0; a < 2; ++a)
#pragma unroll
        for (int b = 0; b < 2; ++b)
#pragma unroll
            for (int m = 0; m < 4; ++m)
#pragma unroll
                for (int n = 0; n < 2; ++n) acc[a][b][m][n] = (f32x4){0.f, 0.f, 0.f, 0.f};
    bf16x8 At[4][2], B0[2][2], B1[2][2];
    const char* cA = PG8_APTR(cur); const char* cB = (const char*)g.Bt + (size_t)cur.pn * tstepB;
    PG8_STAGE(PG8_SB(0, 0), cB, voffB); PG8_STAGE(PG8_SB(0, 1), cB + hstepB, voffB); PG8_STAGE(PG8_SA(0, 0), cA, voffA); PG8_STAGE(PG8_SA(0, 1), cA + hstepA, voffA);
    if (wr == 1) PG8_BAR;
    PG8_WAIT_V(2); PG8_BAR;
    PG8_STAGE(PG8_SB(1, 0), cB + kstep, voffB); PG8_STAGE(PG8_SA(1, 0), cA + kstep, voffA); PG8_STAGE(PG8_SB(1, 1), cB + hstepB + kstep, voffB);
    PG8_WAIT_V(6); PG8_BAR;
    for (;;) {
        const bool has_next = S.next(ui + 1, nxt);
        const char* nA = has_next ? PG8_APTR(nxt) : cA; const char* nB = has_next ? (const char*)g.Bt + (size_t)nxt.pn * tstepB : cB;
        for (int t = 0; t < nt; t += 2) {
            const bool last = (t == nt - 2);
            const char* a1 = cA + (size_t)(t + 1) * kstep;
            const char* a2 = last ? nA : cA + (size_t)(t + 2) * kstep; const char* b2 = last ? nB : cB + (size_t)(t + 2) * kstep;
            const char* a3 = a2 + kstep; const char* b3 = b2 + kstep;
            PG8_LDB(B0, 0, 0); PG8_LDB(B1, 0, 1); PG8_SCHED; PG8_LDA(At, 0, 0); PG8_STAGE(PG8_SA(1, 1), a1 + hstepA, voffA);
            PG8_WAIT_V(8); PG8_WAIT_L(0); PG8_BAR; PG8_MMA(0, 0, At, B0); PG8_MMA(0, 1, At, B1); PG8_BAR; PG8_SCHED;
            PG8_LDA(At, 0, 1); PG8_STAGE(PG8_SB(0, 0), b2, voffB); PG8_STAGE(PG8_SB(0, 1), b2 + hstepB, voffB); PG8_STAGE(PG8_SA(0, 0), a2, voffA);
            PG8_WAIT_V(8); PG8_WAIT_L(0); PG8_BAR; PG8_MMA(1, 0, At, B0); PG8_MMA(1, 1, At, B1); PG8_BAR; PG8_SCHED;
            PG8_LDB(B0, 1, 0); PG8_LDB(B1, 1, 1); PG8_SCHED; PG8_LDA(At, 1, 0); PG8_STAGE(PG8_SA(0, 1), a2 + hstepA, voffA);
            PG8_WAIT_V(8); PG8_WAIT_L(0); PG8_BAR; PG8_MMA(0, 0, At, B0); PG8_MMA(0, 1, At, B1); PG8_BAR; PG8_SCHED;
            PG8_LDA(At, 1, 1); PG8_STAGE(PG8_SB(1, 0), b3, voffB); PG8_STAGE(PG8_SB(1, 1), b3 + hstepB, voffB); PG8_STAGE(PG8_SA(1, 0), a3, voffA);
            PG8_WAIT_V(8); PG8_WAIT_L(0); PG8_BAR; PG8_MMA(1, 0, At, B0); PG8_MMA(1, 1, At, B1); PG8_BAR; PG8_SCHED;
        }
        if (wr == 0) PG8_BAR;
        E(acc, cur, wr, wc, fr, fq);
        if (!has_next) break;
#pragma unroll
        for (int a = 0; a < 2; ++a)
#pragma unroll
            for (int b = 0; b < 2; ++b)
#pragma unroll
                for (int m = 0; m < 4; ++m)
#pragma unroll
                    for (int n = 0; n < 2; ++n) acc[a][b][m][n] = (f32x4){0.f, 0.f, 0.f, 0.f};
        cur = nxt; cA = nA; cB = nB; ++ui;
        if (wr == 1) PG8_BAR;
    }
    PG8_WAIT_V(0);
    PG8_BAR;
#undef PG8_SA
#undef PG8_SB
#undef PG8_STAGE
#undef PG8_LDA
#undef PG8_LDB
#undef PG8_MMA
#undef PG8_WAIT_V
#undef PG8_WAIT_L
#undef PG8_BAR
#undef PG8_SCHED
#undef PG8_APTR
}
}

__device__ __forceinline__ void run_gemm(LAS unsigned char* lds, const bf16_t* A, int lda, int a_sh, int a_mul, const bf16_t* Bt, int N, int K, const pg8::Epi& E) {
    pg8::Gemm g; g.A = A; g.Bt = Bt; g.M = T_TOK; g.N = N; g.K = K; g.lda = lda; g.a_sh = a_sh; g.a_mul = a_mul;
    pg8::StaticOrder S; S.init(T_TOK, N, (int)gridDim.x, (int)blockIdx.x);
    pg8::gemm_phase(lds, g, S, E);
}

__device__ __forceinline__ void rmsnorm_phase(const float* X, const float* g, bf16_t* H) {
    const int lane = TIDX & 63, gw = blockIdx.x * 8 + (TIDX >> 6), NW = gridDim.x * 8;
    f32x4 gv[4];
#pragma unroll
    for (int j = 0; j < 4; ++j) gv[j] = *(const f32x4*)(g + 4 * (lane + 64 * j));
    for (int row = gw; row < T_TOK; row += 4 * NW) {
        f32x4 v[4][4];
#pragma unroll
        for (int q = 0; q < 4; ++q) { const int rr = row + q * NW; if (rr < T_TOK) {
#pragma unroll
            for (int j = 0; j < 4; ++j) v[q][j] = *(const f32x4*)(X + (size_t)rr * DM + 4 * (lane + 64 * j)); } }
#pragma unroll
        for (int q = 0; q < 4; ++q) { const int rr = row + q * NW; if (rr < T_TOK) { float s = 0.f;
#pragma unroll
            for (int j = 0; j < 4; ++j) s += v[q][j][0] * v[q][j][0] + v[q][j][1] * v[q][j][1] + v[q][j][2] * v[q][j][2] + v[q][j][3] * v[q][j][3];
            const float rstd = rsqrtf(wave_sum(s) * (1.f / DM) + EPS);
#pragma unroll
            for (int j = 0; j < 4; ++j) { u32x2 o; o.x = pk2(v[q][j][0] * rstd * gv[j][0], v[q][j][1] * rstd * gv[j][1]); o.y = pk2(v[q][j][2] * rstd * gv[j][2], v[q][j][3] * rstd * gv[j][3]);
                *(u32x2*)(H + (size_t)rr * DM + 4 * (lane + 64 * j)) = o; } } }
    }
}
__device__ __forceinline__ int wmap(int mat, int j) {
    if (mat == 0) return j < C_GATE ? j : -1;
    if (mat == 1) { const int pn = j >> 8, rho = j & 255, bj = rho >> 7, wc = (rho >> 5) & 3, n = (rho >> 4) & 1, fq = (rho >> 2) & 3, jj = rho & 3;
        return C_GATE + (2 * bj + n) * 1024 + 64 * pn + 16 * wc + 4 * fq + jj; }
    return j;
}
struct WItem { const float* src; bf16_t* dst; int ld, K, mat, k0, n0; };
__device__ __forceinline__ WItem wdecode(const Params& p, int l, int r) {
    constexpr int I0 = 16 * 56, I1 = 16 * 64, I2 = 4 * 4 * 16, I3 = 16 * 16, I4 = 16 * 64;
    WItem w;
    if (r < I0) { w.src = p.w_in + (size_t)l * DM * N_IN; w.ld = N_IN; w.K = DM; w.dst = (bf16_t*)(p.ws + OFF_WIN); w.mat = 0; w.k0 = (r / 56) * 64; w.n0 = (r % 56) * 64; return w; } r -= I0;
    if (r < I1) { w.src = p.w_in + (size_t)l * DM * N_IN; w.ld = N_IN; w.K = DM; w.dst = (bf16_t*)(p.ws + OFF_WG); w.mat = 1; w.k0 = (r / 64) * 64; w.n0 = (r % 64) * 64; return w; } r -= I1;
    if (r < I2) { const int nb = r / 64, q = r % 64; w.src = p.w_branch + ((size_t)l * 4 + nb) * 256 * DM; w.ld = DM; w.K = 256; w.dst = (bf16_t*)(p.ws + OFF_WB) + (size_t)nb * 1024 * 256; w.mat = 2; w.k0 = (q / 16) * 64; w.n0 = (q % 16) * 64; return w; } r -= I2;
    if (r < I3) { w.src = p.w_out + (size_t)l * DM * DM; w.ld = DM; w.K = DM; w.dst = (bf16_t*)(p.ws + OFF_WO); w.mat = 2; w.k0 = (r / 16) * 64; w.n0 = (r % 16) * 64; return w; } r -= I3;
    if (r < I4) { w.src = p.w_mlp_in + (size_t)l * DM * DFF; w.ld = DFF; w.K = DM; w.dst = (bf16_t*)(p.ws + OFF_W1); w.mat = 2; w.k0 = (r / 64) * 64; w.n0 = (r % 64) * 64; return w; } r -= I4;
    w.src = p.w_mlp_out + (size_t)l * DFF * DM; w.ld = DM; w.K = DFF; w.dst = (bf16_t*)(p.ws + OFF_W2); w.mat = 2; w.k0 = (r / 16) * 64; w.n0 = (r % 16) * 64; return w;
}
__device__ __forceinline__ void wload(const WItem& w, int tid, float (&v)[8]) {
    const int nn = tid & 63; const int c = wmap(w.mat, w.n0 + nn);
#pragma unroll
    for (int i = 0; i < 8; ++i) { const int kk = i * 8 + (tid >> 6); v[i] = (c >= 0) ? w.src[(size_t)(w.k0 + kk) * w.ld + c] : 0.f; }
}
__device__ __forceinline__ void wconv_phase(const Params& p, int l, LAS unsigned char* lds) {
    LAS float* scr = (LAS float*)lds;
    constexpr int NI = 16 * 56 + 16 * 64 + 4 * 4 * 16 + 16 * 16 + 16 * 64 + 64 * 16;
    const int tid = TIDX, G = gridDim.x;
    int it = blockIdx.x;
    if (it >= NI) return;
    WItem w0 = wdecode(p, l, it), w1 = w0, w2 = w0; float v0[8], v1[8], v2[8];
    wload(w0, tid, v0);
    if (it + G < NI) { w1 = wdecode(p, l, it + G); wload(w1, tid, v1); }
    for (; it < NI; it += G) {
        if (it + 2 * G < NI) { w2 = wdecode(p, l, it + 2 * G); wload(w2, tid, v2); }
        { const int nn = tid & 63;
#pragma unroll
          for (int i = 0; i < 8; ++i) scr[(i * 8 + (tid >> 6)) * 65 + nn] = v0[i]; }
        __syncthreads();
        { const int kk2 = (tid & 31) * 2;
#pragma unroll
          for (int i = 0; i < 4; ++i) { const int nn = i * 16 + (tid >> 5); *(unsigned*)(w0.dst + (size_t)(w0.n0 + nn) * w0.K + w0.k0 + kk2) = pk2(scr[kk2 * 65 + nn], scr[(kk2 + 1) * 65 + nn]); } }
        __syncthreads();
        w0 = w1; w1 = w2;
#pragma unroll
        for (int i = 0; i < 8; ++i) { v0[i] = v1[i]; v1[i] = v2[i]; }
    }
}

__device__ __forceinline__ void sb_task(const Params& p, int l, LAS unsigned char* lds, int task) {
    constexpr int VTS = 140;
    const int tid = TIDX, wave = tid >> 6, lane = tid & 63, ll = lane & 15, qd = lane >> 4;
    const int bh = task >> 7, qi = 127 - (task & 127), b = bh >> 2, h = bh & 3, q0 = qi * 128;
    const bf16_t* base = (const bf16_t*)(p.ws + OFF_B) + (size_t)b * SEQ * NP;
    LAS bf16_t* vt = (LAS bf16_t*)lds;
    LAS int* flag = (LAS int*)(lds + 64 * VTS * 2);
    bf16x8 qf[2];
#pragma unroll
    for (int ks = 0; ks < 2; ++ks) qf[ks] = *(const bf16x8*)(base + (size_t)(q0 + wave * 16 + ll) * NP + C_SBQ + h * 64 + ks * 32 + qd * 8);
    float carry = 0.f;
    f32x4 oacc[4];
#pragma unroll
    for (int c = 0; c < 4; ++c) oacc[c] = (f32x4){0.f, 0.f, 0.f, 0.f};
    bf16x8 kc[8][2], va, vc;
#define SB_LOAD(jj, K_, A_, C_) do { _Pragma("unroll") for (int g = 0; g < 8; ++g) _Pragma("unroll") for (int ks = 0; ks < 2; ++ks) \
            K_[g][ks] = *(const bf16x8*)(base + (size_t)((jj) * 128 + g * 16 + ll) * NP + C_SBK + h * 64 + ks * 32 + qd * 8); \
        const bf16_t* vp_ = base + (size_t)((jj) * 128 + 2 * (tid >> 3)) * NP + C_SBV + h * 64 + (tid & 7) * 8; A_ = *(const bf16x8*)vp_; C_ = *(const bf16x8*)(vp_ + NP); } while (0)
    SB_LOAD(qi, kc, va, vc);
    for (int j = qi; j >= 0; --j) {
        bf16x8 kn[8][2], van, vcn;
        { const int jn = j > 0 ? j - 1 : 0; SB_LOAD(jn, kn, van, vcn); }
        {
#pragma unroll
            for (int e = 0; e < 8; ++e) *(LAS unsigned*)(vt + ((tid & 7) * 8 + e) * VTS + 2 * (tid >> 3)) = (unsigned)(unsigned short)va[e] | ((unsigned)(unsigned short)vc[e] << 16);
        }
        f32x4 s[8];
#pragma unroll
        for (int g = 0; g < 8; ++g) { s[g] = (f32x4){0.f, 0.f, 0.f, 0.f};
#pragma unroll
            for (int ks = 0; ks < 2; ++ks) s[g] = MFMA16(kc[g][ks], qf[ks], s[g]); }
        const bool diag = (j == qi);
        f32x4 sp[8], lb[8]; float Gt[8], abq[8];
#pragma unroll
        for (int g = 0; g < 8; ++g) {
#pragma unroll
            for (int r = 0; r < 4; ++r) { const float z = s[g][r] * 0.125f; float spv = softplusf_(z), lbv = z - spv;
                if (diag && !(16 * g + 4 * qd + r < wave * 16 + ll)) { spv = 0.f; lbv = -INFINITY; }
                sp[g][r] = spv; lb[g][r] = lbv; }
            const float L = (sp[g][0] + sp[g][1]) + (sp[g][2] + sp[g][3]);
            const float L0 = __shfl(L, ll), L1 = __shfl(L, ll + 16), L2 = __shfl(L, ll + 32), L3 = __shfl(L, ll + 48);
            Gt[g] = (L0 + L1) + (L2 + L3);
            abq[g] = (qd < 1 ? L1 : 0.f) + (qd < 2 ? L2 : 0.f) + (qd < 3 ? L3 : 0.f);
        }
        float run = 0.f; bf16x8 pf[4]; f32x4 w[8];
#pragma unroll
        for (int g = 7; g >= 0; --g) {
            const float bs = carry - run - abq[g];
            w[g][3] = __expf(lb[g][3] + bs);
            w[g][2] = __expf(lb[g][2] + bs - sp[g][3]);
            w[g][1] = __expf(lb[g][1] + bs - (sp[g][3] + sp[g][2]));
            w[g][0] = __expf(lb[g][0] + bs - (sp[g][3] + sp[g][2] + sp[g][1]));
            run += Gt[g];
        }
#pragma unroll
        for (int g2 = 0; g2 < 4; ++g2) pf[g2] = pk8(w[2 * g2], w[2 * g2 + 1]);
        carry -= run;
        __syncthreads();
        {
            bf16x8 af[4][4];
#pragma unroll
            for (int c = 0; c < 4; ++c)
#pragma unroll
                for (int g2 = 0; g2 < 4; ++g2) { const LAS bf16_t* vr = vt + (16 * c + ll) * VTS + 32 * g2 + 4 * qd; af[c][g2] = mk8(*(const LAS u32x2*)vr, *(const LAS u32x2*)(vr + 16)); }
            __builtin_amdgcn_sched_barrier(0);
#pragma unroll
            for (int c = 0; c < 4; ++c)
#pragma unroll
                for (int g2 = 0; g2 < 4; ++g2) oacc[c] = MFMA16(af[c][g2], pf[g2], oacc[c]);
        }
        const int done = __all(carry < -104.f) ? 1 : 0;
        if (lane == 0) flag[wave] = done;
        __syncthreads();
        int all = 1;
#pragma unroll
        for (int i = 0; i < 8; ++i) all &= flag[i];
        if (__builtin_amdgcn_readfirstlane(all)) break;
        __syncthreads();
#pragma unroll
        for (int g = 0; g < 8; ++g) { kc[g][0] = kn[g][0]; kc[g][1] = kn[g][1]; }
        va = van; vc = vcn;
    }
#undef SB_LOAD
    bf16_t* op = (bf16_t*)(p.ws + OFF_O) + (size_t)(b * SEQ + q0 + wave * 16 + ll) * DM + O_SB + h * 64 + 4 * qd;
#pragma unroll
    for (int c = 0; c < 4; ++c) { u32x2 o; o.x = pk2(oacc[c][0], oacc[c][1]); o.y = pk2(oacc[c][2], oacc[c][3]); *(u32x2*)(op + 16 * c) = o; }
    __syncthreads();
}

__device__ __forceinline__ void dil_task(const Params& p, int l, LAS unsigned char* lds, int pat, int task) {
    constexpr int RS = 72, VTS = 268;
    const int tid = TIDX, wave = tid >> 6, lane = tid & 63, ll = lane & 15, qd = lane >> 4;
    const int dil = pat == 0 ? 1 : (pat == 1 ? 4 : 16), nb = (SEQ / dil) / 128;
    const int n = task % nb, r = (task / nb) % dil, bh = task / (nb * dil), b = bh >> 2, h = bh & 3;
    const bf16_t* base = (const bf16_t*)(p.ws + OFF_B) + (size_t)b * SEQ * NP;
    LAS bf16_t* qs = (LAS bf16_t*)lds;
    LAS bf16_t* ks = qs + 128 * RS;
    LAS bf16_t* vt = ks + 256 * RS;
    LAS float* gq = (LAS float*)(vt + 64 * VTS);
    if (tid < 128) gq[tid] = tid < 64 ? p.dil_q_g[l * 64 + tid] : p.dil_k_g[l * 64 + tid - 64];
    bf16x8 vreg[2][2];
#pragma unroll
    for (int ps = 0; ps < 2; ++ps) { const int kj = 2 * (ps * 64 + (tid >> 3)), idx = n * 128 - 128 + kj;
        vreg[ps][0] = (bf16x8){0, 0, 0, 0, 0, 0, 0, 0}; vreg[ps][1] = (bf16x8){0, 0, 0, 0, 0, 0, 0, 0};
        if (idx >= 0) { const bf16_t* vp = base + (size_t)(idx * dil + r) * NP + C_LV + h * 64 + (tid & 7) * 8; vreg[ps][0] = *(const bf16x8*)vp; vreg[ps][1] = *(const bf16x8*)(vp + (size_t)dil * NP); } }
    __syncthreads();
    if (tid < 384) {
        const bool isq = tid < 128; const int idx = isq ? n * 128 + tid : n * 128 - 128 + (tid - 128);
        LAS bf16_t* dst = isq ? qs + tid * RS : ks + (tid - 128) * RS;
        if (idx >= 0) {
            const int pos = idx * dil + r;
            const bf16_t* src = base + (size_t)pos * NP + (isq ? C_LQ : C_LK) + h * 64;
            float xv[64]; float ss = 0.f;
#pragma unroll
            for (int c8 = 0; c8 < 8; ++c8) { const u32x4 u = *(const u32x4*)(src + c8 * 8);
                xv[c8 * 8 + 0] = bflo(u.x); xv[c8 * 8 + 1] = bfhi(u.x); xv[c8 * 8 + 2] = bflo(u.y); xv[c8 * 8 + 3] = bfhi(u.y);
                xv[c8 * 8 + 4] = bflo(u.z); xv[c8 * 8 + 5] = bfhi(u.z); xv[c8 * 8 + 6] = bflo(u.w); xv[c8 * 8 + 7] = bfhi(u.w); }
#pragma unroll
            for (int c = 0; c < 64; ++c) ss += xv[c] * xv[c];
            const float rstd = rsqrtf(ss * (1.f / 64.f) + EPS);
            const LAS float* gg = gq + (isq ? 0 : 64);
#pragma unroll
            for (int c = 0; c < 64; ++c) xv[c] = xv[c] * rstd * gg[c];
#pragma unroll
            for (int i = 0; i < 8; ++i) {
                const float invf = exp2f(-(float)i * (18.931568569324174f / 8.f));
                const float ang = (float)pos * invf;
                double rev = (double)ang * 0.15915494309189535; rev -= rint(rev);
                const float a2 = (float)(rev * 6.283185307179586);
                const float cs = __cosf(a2), sn = __sinf(a2);
                const float x1 = xv[i], x2 = xv[i + 8]; xv[i] = x1 * cs - x2 * sn; xv[i + 8] = x2 * cs + x1 * sn;
            }
#pragma unroll
            for (int c8 = 0; c8 < 8; ++c8) { u32x4 o; o.x = pk2(xv[c8 * 8], xv[c8 * 8 + 1]); o.y = pk2(xv[c8 * 8 + 2], xv[c8 * 8 + 3]); o.z = pk2(xv[c8 * 8 + 4], xv[c8 * 8 + 5]); o.w = pk2(xv[c8 * 8 + 6], xv[c8 * 8 + 7]);
                *(LAS u32x4*)(dst + c8 * 8) = o; }
        } else {
#pragma unroll
            for (int c8 = 0; c8 < 8; ++c8) *(LAS u32x4*)(dst + c8 * 8) = (u32x4){0u, 0u, 0u, 0u};
        }
    }
    {
#pragma unroll
        for (int ps = 0; ps < 2; ++ps) { const int kj = 2 * (ps * 64 + (tid >> 3));
#pragma unroll
            for (int e = 0; e < 8; ++e) *(LAS unsigned*)(vt + ((tid & 7) * 8 + e) * VTS + kj) = (unsigned)(unsigned short)vreg[ps][0][e] | ((unsigned)(unsigned short)vreg[ps][1][e] << 16); }
    }
    __syncthreads();
    const size_t tok = (size_t)b * SEQ + (size_t)(n * 128 + 16 * wave + ll) * dil + r;
    bf16_t* op = (bf16_t*)(p.ws + OFF_O) + tok * DM + O_DIL + h * 64 + 4 * qd;
    float* st = (float*)(p.ws + OFF_DSTAT) + (tok * 4 + h) * 2;
    u32x2 pv[4]; float mo = 0.f, dd = 0.f;
    if (pat > 0) { mo = st[0]; dd = st[1];
#pragma unroll
        for (int c = 0; c < 4; ++c) pv[c] = *(const u32x2*)(op + 16 * c); }
    bf16x8 qf[2];
#pragma unroll
    for (int k2 = 0; k2 < 2; ++k2) qf[k2] = *(const LAS bf16x8*)(qs + (16 * wave + ll) * RS + k2 * 32 + qd * 8);
    f32x4 s[10]; float mx = -INFINITY;
    {   bf16x8 kf[10][2];
#pragma unroll
        for (int gi = 0; gi < 10; ++gi) { const int g = wave + gi, gc = g < 16 ? g : 15;
#pragma unroll
            for (int k2 = 0; k2 < 2; ++k2) kf[gi][k2] = *(const LAS bf16x8*)(ks + (16 * gc + ll) * RS + k2 * 32 + qd * 8); }
        __builtin_amdgcn_sched_barrier(0);
#pragma unroll
        for (int gi = 0; gi < 10; ++gi) { s[gi] = (f32x4){0.f, 0.f, 0.f, 0.f};
#pragma unroll
            for (int k2 = 0; k2 < 2; ++k2) s[gi] = MFMA16(kf[gi][k2], qf[k2], s[gi]); }
    }
#pragma unroll
    for (int gi = 0; gi < 10; ++gi) {
        const int g = wave + gi;
#pragma unroll
        for (int rr = 0; rr < 4; ++rr) { const int kj = 16 * g + 4 * qd + rr, m = (16 * wave + ll) + 128 - kj;
            const bool valid = (g < 16) && (m >= 0) && (m <= 128) && (n * 128 - 128 + kj >= 0);
            const float v = valid ? s[gi][rr] * 0.125f : -INFINITY; s[gi][rr] = v; mx = fmaxf(mx, v); }
    }
    mx = fmaxf(mx, __shfl_xor(mx, 16)); mx = fmaxf(mx, __shfl_xor(mx, 32));
    float den = 0.f; bf16x8 pf[5];
#pragma unroll
    for (int gi = 0; gi < 10; ++gi)
#pragma unroll
        for (int rr = 0; rr < 4; ++rr) { const float e = __expf(s[gi][rr] - mx); s[gi][rr] = e; den += e; }
    den += __shfl_xor(den, 16); den += __shfl_xor(den, 32);
#pragma unroll
    for (int g2 = 0; g2 < 5; ++g2) pf[g2] = pk8(s[2 * g2], s[2 * g2 + 1]);
    f32x4 oacc[4];
    {   bf16x8 af[4][5];
#pragma unroll
        for (int c = 0; c < 4; ++c)
#pragma unroll
            for (int g2 = 0; g2 < 5; ++g2) {
                const int ga = wave + 2 * g2, gb = ga + 1, gac = ga < 16 ? ga : 15, gbc = gb < 16 ? gb : 15;
                const LAS bf16_t* vr = vt + (16 * c + ll) * VTS + 4 * qd;
                af[c][g2] = mk8(*(const LAS u32x2*)(vr + 16 * gac), *(const LAS u32x2*)(vr + 16 * gbc)); }
        __builtin_amdgcn_sched_barrier(0);
#pragma unroll
        for (int c = 0; c < 4; ++c) { oacc[c] = (f32x4){0.f, 0.f, 0.f, 0.f};
#pragma unroll
            for (int g2 = 0; g2 < 5; ++g2) oacc[c] = MFMA16(af[c][g2], pf[g2], oacc[c]); }
    }
    float wa = 0.f, wb = 1.f, D = den, M = mx;
    if (pat > 0) { M = fmaxf(mo, mx); wa = dd * __expf(mo - M); wb = __expf(mx - M); D = wa + den * wb; }
    const float inv = __builtin_amdgcn_rcpf(D);
#pragma unroll
    for (int c = 0; c < 4; ++c) { f32x4 o = oacc[c] * wb;
        if (pat > 0) { const u32x2 u = pv[c]; o[0] += wa * bflo(u.x); o[1] += wa * bfhi(u.x); o[2] += wa * bflo(u.y); o[3] += wa * bfhi(u.y); }
        u32x2 q; q.x = pk2(o[0] * inv, o[1] * inv); q.y = pk2(o[2] * inv, o[3] * inv); *(u32x2*)(op + 16 * c) = q; }
    if (pat < 2 && qd == 0) { st[0] = M; st[1] = D; }
    __syncthreads();
}

__device__ __forceinline__ void gla_load(const Params& p, int l, const bf16_t* prow  , int h, LAS float* qL, LAS float* kL, LAS float* bL, LAS float* lrL, LAS float* w2L) {
    const int tid = TIDX;
    if (tid < 128) { const int t = tid >> 1, c8 = (tid & 1) * 8; const u32x4 u = *(const u32x4*)(prow + (size_t)t * NP + C_GLR + c8); LAS float* d = lrL + t * 16 + c8;
        d[0] = bflo(u.x); d[1] = bfhi(u.x); d[2] = bflo(u.y); d[3] = bfhi(u.y); d[4] = bflo(u.z); d[5] = bfhi(u.z); d[6] = bflo(u.w); d[7] = bfhi(u.w); }
    { const int j = tid >> 5, c = tid & 31; w2L[tid] = p.gla_w_lr2[(size_t)l * 16 * 128 + j * 128 + h * 32 + c]; }
    if (tid < 32) w2L[512 + tid] = p.gla_b_lr[l * 128 + h * 32 + tid];
    { const int isk = tid >> 8, t = (tid & 255) >> 2, c8 = (tid & 3) * 8; const u32x4 u = *(const u32x4*)(prow + (size_t)t * NP + (isk ? C_GK : C_GQ) + h * 32 + c8);
        const float sc = isk ? 1.f : 0.17677669529663687f; LAS float* d = (isk ? kL : qL) + t * 33 + c8;
        d[0] = bflo(u.x) * sc; d[1] = bfhi(u.x) * sc; d[2] = bflo(u.y) * sc; d[3] = bfhi(u.y) * sc; d[4] = bflo(u.z) * sc; d[5] = bfhi(u.z) * sc; d[6] = bflo(u.w) * sc; d[7] = bfhi(u.w) * sc; }
    __syncthreads();
    for (int i = tid; i < 64 * 32; i += 512) { const int t = i >> 5, c = i & 31; float a = w2L[512 + c];
#pragma unroll
        for (int j = 0; j < 16; ++j) a += lrL[t * 16 + j] * w2L[j * 32 + c];
        bL[t * 33 + c] = -softplusf_(-a) * (1.f / 16.f); }
    __syncthreads();
    {
        const int wv = tid >> 6, ln = tid & 63;
#pragma unroll
        for (int q = 0; q < 4; ++q) { const int c = wv * 4 + q; float v = bL[ln * 33 + c];
#pragma unroll
            for (int o = 1; o < 64; o <<= 1) { const float u = __shfl_up(v, o); if (ln >= o) v += u; }
            bL[ln * 33 + c] = v; }
    }
    __syncthreads();
}
__device__ __forceinline__ void gla_a_task(const Params& p, int l, LAS unsigned char* lds, int task) {
    const int tid = TIDX, wave = tid >> 6, lane = tid & 63, ll = lane & 15, qd = lane >> 4, bh = task >> 8, ch = task & 255, b = bh >> 2, h = bh & 3;
    const bf16_t* prow = (const bf16_t*)(p.ws + OFF_B) + ((size_t)b * SEQ + ch * 64) * NP;
    LAS float* qL = (LAS float*)lds; LAS float* kL = qL + 64 * 33; LAS float* bL = kL + 64 * 33; LAS float* lrL = bL + 64 * 33; LAS float* w2L = lrL + 1024;
    LAS bf16_t* vt = (LAS bf16_t*)(w2L + 576);
    LAS bf16_t* kT = vt + 64 * 72;
    { const int tp = tid >> 4, c4 = (tid & 15) * 4;
      const u32x2 u0 = *(const u32x2*)(prow + (size_t)(2 * tp) * NP + C_GV + h * 64 + c4), u1 = *(const u32x2*)(prow + (size_t)(2 * tp + 1) * NP + C_GV + h * 64 + c4);
      *(LAS unsigned*)(vt + (c4 + 0) * 72 + 2 * tp) = (u0.x & 0xffffu) | (u1.x << 16); *(LAS unsigned*)(vt + (c4 + 1) * 72 + 2 * tp) = (u0.x >> 16) | (u1.x & 0xffff0000u);
      *(LAS unsigned*)(vt + (c4 + 2) * 72 + 2 * tp) = (u0.y & 0xffffu) | (u1.y << 16); *(LAS unsigned*)(vt + (c4 + 3) * 72 + 2 * tp) = (u0.y >> 16) | (u1.y & 0xffff0000u); }
    gla_load(p, l, prow, h, qL, kL, bL, lrL, w2L);
    { const int c = tid >> 4, t4 = (tid & 15) * 4; const float bl = bL[63 * 33 + c]; float kv[4];
#pragma unroll
      for (int e = 0; e < 4; ++e) kv[e] = kL[(t4 + e) * 33 + c] * __expf(bl - bL[(t4 + e) * 33 + c]);
      *(LAS unsigned*)(kT + c * 72 + t4) = pk2(kv[0], kv[1]); *(LAS unsigned*)(kT + c * 72 + t4 + 2) = pk2(kv[2], kv[3]); }
    __syncthreads();
    const int ct = wave >> 2, dt = wave & 3; f32x4 acc = {0.f, 0.f, 0.f, 0.f};
#pragma unroll
    for (int k2 = 0; k2 < 2; ++k2) acc = MFMA16(*(const LAS bf16x8*)(kT + (16 * ct + ll) * 72 + k2 * 32 + qd * 8), *(const LAS bf16x8*)(vt + (16 * dt + ll) * 72 + k2 * 32 + qd * 8), acc);
    float* U = (float*)(p.ws + OFF_GLAU) + (size_t)task * 2048;
#pragma unroll
    for (int r = 0; r < 4; ++r) U[(16 * ct + 4 * qd + r) * 64 + 16 * dt + ll] = acc[r];
    if (tid < 32) ((float*)(p.ws + OFF_GLAA))[(size_t)task * 32 + tid] = __expf(bL[63 * 33 + tid]);
    __syncthreads();
}
__device__ __forceinline__ void gla_scan_task(const Params& p, LAS unsigned char* lds, int task, unsigned* ready) {
    const int tid = TIDX, bh = task >> 2, qt = task & 3, e = qt * 512 + tid, cl = tid >> 6;
    float* U = (float*)(p.ws + OFF_GLAU) + (size_t)bh * 256 * 2048 + e;
    const float* A = (const float*)(p.ws + OFF_GLAA) + (size_t)bh * 256 * 32 + qt * 8;
    LAS float* aL = (LAS float*)lds;
#pragma unroll
    for (int k = 0; k < 4; ++k) { const int idx = tid + 512 * k; aL[idx] = A[(idx >> 3) * 32 + (idx & 7)]; }
    __syncthreads();
    float st = 0.f;
    for (int n0 = 0; n0 < 256; n0 += 16) {
        float u[16];
#pragma unroll
        for (int k = 0; k < 16; ++k) u[k] = U[(size_t)(n0 + k) * 2048];
#pragma unroll
        for (int k = 0; k < 16; ++k) { U[(size_t)(n0 + k) * 2048] = st; st = aL[(n0 + k) * 8 + cl] * st + u[k]; }
    }
    asm volatile("s_waitcnt vmcnt(0)" ::: "memory");
    __syncthreads();
    if (tid == 0) { __builtin_amdgcn_fence(__ATOMIC_RELEASE, "agent"); asm volatile("s_waitcnt vmcnt(0)" ::: "memory");
        __hip_atomic_fetch_add(ready, 1u, __ATOMIC_RELAXED, __HIP_MEMORY_SCOPE_AGENT); }
    __syncthreads();
}
__device__ __forceinline__ void gla_c_task(const Params& p, int l, LAS unsigned char* lds, int task, unsigned* ready) {
    const int tid = TIDX, wave = tid >> 6, lane = tid & 63, ll = lane & 15, qd = lane >> 4, bh = task >> 8, ch = task & 255, b = bh >> 2, h = bh & 3;
    if (tid == 0) {
        unsigned sp = 0; while (__hip_atomic_load(ready + bh, __ATOMIC_RELAXED, __HIP_MEMORY_SCOPE_AGENT) < 4u && ++sp < (1u << 24)) __builtin_amdgcn_s_sleep(2);
        __builtin_amdgcn_fence(__ATOMIC_ACQUIRE, "agent"); asm volatile("s_waitcnt vmcnt(0)" ::: "memory"); }
    __syncthreads();
    const bf16_t* prow = (const bf16_t*)(p.ws + OFF_B) + ((size_t)b * SEQ + ch * 64) * NP;
    LAS float* qL = (LAS float*)lds; LAS float* kL = qL + 64 * 33; LAS float* bL = kL + 64 * 33; LAS float* lrL = bL + 64 * 33; LAS float* w2L = lrL + 1024;
    LAS float* ssL = w2L + 576;
    LAS bf16_t* vt = (LAS bf16_t*)(ssL + 512);
    LAS bf16_t* sT = vt + 64 * 72;
    { const int tp = tid >> 4, c4 = (tid & 15) * 4;
      const u32x2 u0 = *(const u32x2*)(prow + (size_t)(2 * tp) * NP + C_GV + h * 64 + c4), u1 = *(const u32x2*)(prow + (size_t)(2 * tp + 1) * NP + C_GV + h * 64 + c4);
      *(LAS unsigned*)(vt + (c4 + 0) * 72 + 2 * tp) = (u0.x & 0xffffu) | (u1.x << 16); *(LAS unsigned*)(vt + (c4 + 1) * 72 + 2 * tp) = (u0.x >> 16) | (u1.x & 0xffff0000u);
      *(LAS unsigned*)(vt + (c4 + 2) * 72 + 2 * tp) = (u0.y & 0xffffu) | (u1.y << 16); *(LAS unsigned*)(vt + (c4 + 3) * 72 + 2 * tp) = (u0.y >> 16) | (u1.y & 0xffff0000u); }
    { const float* U = (const float*)(p.ws + OFF_GLAU) + (size_t)task * 2048; const int c = tid >> 4, d4 = (tid & 15) * 4; const f32x4 u = *(const f32x4*)(U + c * 64 + d4);
#pragma unroll
      for (int e = 0; e < 4; ++e) sT[(d4 + e) * 40 + c] = f2bf(u[e]); }
    const int I = wave >> 1, dh = wave & 1, t = 16 * I + ll;
    u32x2 rgl[2];
#pragma unroll
    for (int cc = 0; cc < 2; ++cc) rgl[cc] = *(const u32x2*)(prow + (size_t)t * NP + C_GR + h * 64 + 16 * (2 * dh + cc) + 4 * qd);
    gla_load(p, l, prow, h, qL, kL, bL, lrL, w2L);
    float qv[8], bt[8], rI[8];
#pragma unroll
    for (int e = 0; e < 8; ++e) { qv[e] = qL[t * 33 + 8 * qd + e]; bt[e] = bL[t * 33 + 8 * qd + e]; rI[e] = I > 0 ? bL[(16 * I - 1) * 33 + 8 * qd + e] : 0.f; }
    f32x4 qa, qb2, qc, qd2;
#pragma unroll
    for (int e = 0; e < 4; ++e) { qa[e] = qv[e] * __expf(bt[e] - rI[e]); qb2[e] = qv[4 + e] * __expf(bt[4 + e] - rI[4 + e]); qc[e] = qv[e] * __expf(bt[e]); qd2[e] = qv[4 + e] * __expf(bt[4 + e]); }
    const bf16x8 qfI = pk8(qa, qb2), qfin = pk8(qc, qd2);
    f32x4 at[4];
#pragma unroll
    for (int J = 0; J < 4; ++J) { at[J] = (f32x4){0.f, 0.f, 0.f, 0.f};
        if (J < I) { const int j = 16 * J + ll; f32x4 ka, kb2;
#pragma unroll
            for (int e = 0; e < 4; ++e) { ka[e] = kL[j * 33 + 8 * qd + e] * __expf(rI[e] - bL[j * 33 + 8 * qd + e]); kb2[e] = kL[j * 33 + 8 * qd + 4 + e] * __expf(rI[4 + e] - bL[j * 33 + 8 * qd + 4 + e]); }
            at[J] = MFMA16(pk8(ka, kb2), qfI, at[J]); } }
    {
        f32x4 dsum = {0.f, 0.f, 0.f, 0.f};
#pragma unroll 8
        for (int c = 0; c < 32; ++c) { const float q_ = qL[t * 33 + c], b_ = bL[t * 33 + c];
#pragma unroll
            for (int r = 0; r < 4; ++r) { const int j = 16 * I + 4 * qd + r; dsum[r] += q_ * kL[j * 33 + c] * __expf(fminf(b_ - bL[j * 33 + c], 0.f)); } }
#pragma unroll
        for (int r = 0; r < 4; ++r) dsum[r] = (4 * qd + r <= ll) ? dsum[r] : 0.f;
#pragma unroll
        for (int J = 0; J < 4; ++J) if (J == I) at[J] = dsum;
    }
    bf16x8 pf[2]; pf[0] = pk8(at[0], at[1]); pf[1] = pk8(at[2], at[3]);
    f32x4 oacc[2]; float ss = 0.f;
#pragma unroll
    for (int cc = 0; cc < 2; ++cc) { const int cg = 2 * dh + cc; f32x4 acc = {0.f, 0.f, 0.f, 0.f};
#pragma unroll
        for (int g2 = 0; g2 < 2; ++g2) { const LAS bf16_t* vr = vt + (16 * cg + ll) * 72 + 32 * g2 + 4 * qd; acc = MFMA16(mk8(*(const LAS u32x2*)vr, *(const LAS u32x2*)(vr + 16)), pf[g2], acc); }
        acc = MFMA16(*(const LAS bf16x8*)(sT + (16 * cg + ll) * 40 + 8 * qd), qfin, acc);
        oacc[cc] = acc; ss += acc[0] * acc[0] + acc[1] * acc[1] + acc[2] * acc[2] + acc[3] * acc[3]; }
    ssL[t * 8 + dh * 4 + qd] = ss;
    __syncthreads();
    float tot = 0.f;
#pragma unroll
    for (int e = 0; e < 8; ++e) tot += ssL[t * 8 + e];
    const float rstd = rsqrtf(tot * (1.f / 64.f) + EPS);
#pragma unroll
    for (int cc = 0; cc < 2; ++cc) { const int d = 16 * (2 * dh + cc) + 4 * qd;
        const u32x2 rg = rgl[cc];
        const float rr[4] = {bflo(rg.x), bfhi(rg.x), bflo(rg.y), bfhi(rg.y)}; float ov[4];
#pragma unroll
        for (int e = 0; e < 4; ++e) ov[e] = oacc[cc][e] * rstd * p.gla_norm_g[l * 64 + d + e] * rr[e] * sigmoidf_(rr[e]);
        u32x2 o; o.x = pk2(ov[0], ov[1]); o.y = pk2(ov[2], ov[3]);
        *(u32x2*)((bf16_t*)(p.ws + OFF_O) + ((size_t)b * SEQ + ch * 64 + t) * DM + O_GLA + h * 64 + d) = o; }
    __syncthreads();
}

__device__ __forceinline__ void dn_prep_task(const Params& p, int l, LAS unsigned char* lds, int task) {
    const int tid = TIDX, bh = task >> 8, ch = task & 255, b = bh >> 2, h = bh & 3, t0 = ch * 64;
    const bf16_t* pb = (const bf16_t*)(p.ws + OFF_B) + (size_t)b * SEQ * NP;
    LAS float* qn = (LAS float*)lds; LAS float* kn = qn + 64 * 65; LAS float* vv = kn + 64 * 65; LAS float* Lw = vv + 64 * 65; LAS float* X = Lw + 64 * 65;
    LAS float* Gc = X + 64 * 129; LAS float* be = Gc + 64;
    LAS bf16_t* qb = (LAS bf16_t*)(be + 64); LAS bf16_t* kb = qb + 64 * 72;
    bf16_t graw_a = 0, graw_b = 0;
    if (tid < 64) { const bf16_t* pr0 = pb + (size_t)(t0 + tid) * NP; graw_a = pr0[C_DA + h]; graw_b = pr0[C_DB + h]; }
    {
        LAS float* cwL = (LAS float*)(kb + 64 * 72);
        if (tid < 192) *(LAS f32x4*)(cwL + tid * 4) = *(const f32x4*)(p.dn_conv_w + ((size_t)l * 768 + (tid >> 6) * 256 + h * 64 + (tid & 63)) * 4);
        u32x4 xd[3][4];
#pragma unroll
        for (int it = 0; it < 3; ++it) { const int q = tid + 512 * it, t = q / 24, cc8 = (q % 24) * 8, chg = (cc8 >> 6) * 256 + h * 64 + (cc8 & 63);
#pragma unroll
            for (int i = 0; i < 4; ++i) { const int tt = t0 + t - 3 + i; xd[it][i] = tt >= 0 ? *(const u32x4*)(pb + (size_t)tt * NP + C_DQKV + chg) : (u32x4){0u, 0u, 0u, 0u}; } }
        __syncthreads();
#pragma unroll
        for (int it = 0; it < 3; ++it) { const int q = tid + 512 * it, t = q / 24, cc8 = (q % 24) * 8, sec = cc8 >> 6, c = cc8 & 63;
            float acc[8];
#pragma unroll
            for (int e = 0; e < 8; ++e) acc[e] = 0.f;
#pragma unroll
            for (int i = 0; i < 4; ++i) { const u32x4 u = xd[it][i]; const float xs[8] = {bflo(u.x), bfhi(u.x), bflo(u.y), bfhi(u.y), bflo(u.z), bfhi(u.z), bflo(u.w), bfhi(u.w)};
#pragma unroll
                for (int e = 0; e < 8; ++e) acc[e] += cwL[(cc8 + e) * 4 + i] * xs[e]; }
            LAS float* dst = (sec == 0 ? qn : (sec == 1 ? kn : vv)) + t * 65 + c;
#pragma unroll
            for (int e = 0; e < 8; ++e) dst[e] = acc[e] * sigmoidf_(acc[e]); }
    }
    __syncthreads();
    { LAS float* row = ((tid >> 2) < 64 ? qn : kn) + ((tid >> 2) & 63) * 65 + (tid & 3) * 16; float ss = 0.f;
#pragma unroll
        for (int c = 0; c < 16; ++c) ss += row[c] * row[c];
        ss += __shfl_xor(ss, 1); ss += __shfl_xor(ss, 2);
        const float sc = rsqrtf(ss + EPS) * ((tid >> 2) < 64 ? 0.125f : 1.f);
        LAS bf16_t* rb = ((tid >> 2) < 64 ? qb : kb) + ((tid >> 2) & 63) * 72 + (tid & 3) * 16;
#pragma unroll
        for (int c = 0; c < 16; c += 2) { const float v0 = row[c] * sc, v1 = row[c + 1] * sc; row[c] = v0; row[c + 1] = v1; *(LAS unsigned*)(rb + c) = pk2(v0, v1); } }
    if (tid < 64) {
        be[tid] = sigmoidf_(bf2f(graw_b));
        float g = -__expf(p.dn_a_log[l * 4 + h]) * softplusf_(bf2f(graw_a) + p.dn_dt_bias[l * 4 + h]);
#pragma unroll
        for (int o = 1; o < 64; o <<= 1) { const float v = __shfl_up(g, o); if (tid >= o) g += v; }
        Gc[tid] = g; }
    __syncthreads();
    bf16_t* ob = (bf16_t*)(p.ws + OFF_DN) + (size_t)task * 5 * 4096;
    {
        const int wave = tid >> 6, lane = tid & 63, ll = lane & 15, qd = lane >> 4, ti = wave >> 1;
#pragma unroll
        for (int tt = 0; tt < 2; ++tt) { const int tj = (wave & 1) * 2 + tt;
            f32x4 ck = {0.f, 0.f, 0.f, 0.f}, cs = {0.f, 0.f, 0.f, 0.f};
            if (tj <= ti) {
#pragma unroll
                for (int k2 = 0; k2 < 2; ++k2) {
                    const bf16x8 ki = *(const LAS bf16x8*)(kb + (16 * ti + ll) * 72 + k2 * 32 + qd * 8), kj = *(const LAS bf16x8*)(kb + (16 * tj + ll) * 72 + k2 * 32 + qd * 8);
                    const bf16x8 qi = *(const LAS bf16x8*)(qb + (16 * ti + ll) * 72 + k2 * 32 + qd * 8);
                    ck = MFMA16(ki, kj, ck);
                    cs = MFMA16(kj, qi, cs);
                } }
#pragma unroll
            for (int r = 0; r < 4; ++r) { const int i = 16 * ti + 4 * qd + r, j = 16 * tj + ll;
                Lw[i * 65 + j] = j < i ? be[i] * ck[r] * __expf(Gc[i] - Gc[j]) : 0.f; }
            { const int i = 16 * ti + ll; float sv[4];
#pragma unroll
              for (int r = 0; r < 4; ++r) { const int j = 16 * tj + 4 * qd + r; sv[r] = j <= i ? cs[r] * __expf(Gc[i] - Gc[j]) : 0.f; }
              u32x2 o; o.x = pk2(sv[0], sv[1]); o.y = pk2(sv[2], sv[3]); *(u32x2*)(ob + 4 * 4096 + i * 64 + 16 * tj + 4 * qd) = o; }
        }
    }
    for (int idx = tid; idx < 4096; idx += 512) { const int i = idx >> 6, j = idx & 63;
        X[i * 129 + j] = vv[i * 65 + j] * be[i]; X[i * 129 + 64 + j] = kn[i * 65 + j] * be[i] * __expf(Gc[i]); }
    __syncthreads();
    {
        const int col = tid >> 2, part = tid & 3;
        float xr[16];
#pragma unroll
        for (int k = 0; k < 16; ++k) xr[k] = 0.f;
#pragma unroll
        for (int i = 0; i < 64; ++i) { float s0 = 0.f, s1 = 0.f;
#pragma unroll
            for (int k = 0; k < (i + 3) / 4; ++k) { const float t_ = Lw[i * 65 + 4 * k + part] * xr[k]; if (k & 1) s1 += t_; else s0 += t_; }
            s0 += s1; s0 += __shfl_xor(s0, 1); s0 += __shfl_xor(s0, 2);
            const float xi = X[i * 129 + col] - s0;
            if (part == (i & 3)) xr[i >> 2] = xi; }
#pragma unroll
        for (int k = 0; k < 16; ++k) X[(4 * k + part) * 129 + col] = xr[k];
    }
    __syncthreads();
    const float Gl = Gc[63];
    for (int i2 = tid; i2 < 2048; i2 += 512) { const int a = i2 >> 5, c = (i2 & 31) * 2;
        *(unsigned*)(ob + 0 * 4096 + a * 64 + c) = pk2(X[a * 129 + 64 + c], X[a * 129 + 65 + c]);
        *(unsigned*)(ob + 1 * 4096 + a * 64 + c) = pk2(kn[c * 65 + a] * __expf(Gl - Gc[c]), kn[(c + 1) * 65 + a] * __expf(Gl - Gc[c + 1]));
        *(unsigned*)(ob + 2 * 4096 + a * 64 + c) = pk2(X[c * 129 + a], X[(c + 1) * 129 + a]);
        const float eg = __expf(Gc[a]);
        *(unsigned*)(ob + 3 * 4096 + a * 64 + c) = pk2(qn[a * 65 + c] * eg, qn[a * 65 + c + 1] * eg); }
    if (tid == 0) ((float*)(p.ws + OFF_DNA))[task] = __expf(Gl);
    __syncthreads();
}
__device__ __forceinline__ void dn_scan_task(const Params& p, int l, LAS unsigned char* lds, int task) {
    constexpr int RS = 72, MATB = 64 * RS * 2  , STG = 4 * MATB + 16 * RS * 2;
    const int tid = TIDX, wave = tid >> 6, lane = tid & 63, ll = lane & 15, qd = lane >> 4, bh = task >> 2, b = bh >> 2, h = bh & 3;
    const bf16_t* cb = (const bf16_t*)(p.ws + OFF_DN) + (size_t)bh * 256 * 5 * 4096;
    const float* al = (const float*)(p.ws + OFF_DNA) + bh * 256;
    const int lrow = tid >> 3, lc8 = tid & 7;
    LAS float* alL = (LAS float*)(lds + 3 * STG);
    if (tid < 256) alL[tid] = al[tid];
    u32x4 pre[3][5];
    const int d0 = (task & 3) * 16;
#define DN_ISSUE(n, st) do { const int n_ = (n) < 255 ? (n) : 255; _Pragma("unroll") for (int m_ = 0; m_ < 4; ++m_) pre[st][m_] = *(const u32x4*)(cb + ((size_t)n_ * 5 + (m_ < 2 ? m_ : m_ + 1)) * 4096 + tid * 8); \
        pre[st][4] = *(const u32x4*)(cb + ((size_t)n_ * 5 + 2) * 4096 + d0 * 64 + (tid & 127) * 8); } while (0)
#define DN_COMMIT(st) do { LAS unsigned char* sb_ = lds + (st) * STG; _Pragma("unroll") for (int m_ = 0; m_ < 4; ++m_) *(LAS u32x4*)(sb_ + m_ * MATB + lrow * (RS * 2) + lc8 * 16) = pre[st][m_]; \
        if (tid < 128) *(LAS u32x4*)(sb_ + 4 * MATB + lrow * (RS * 2) + lc8 * 16) = pre[st][4]; } while (0)
    DN_ISSUE(0, 0); DN_ISSUE(1, 1); DN_COMMIT(0); DN_COMMIT(1); DN_ISSUE(2, 2); DN_ISSUE(3, 0); DN_ISSUE(4, 1);
    f32x4 S[4];
#pragma unroll
    for (int m = 0; m < 4; ++m) S[m] = (f32x4){0.f, 0.f, 0.f, 0.f};
    __syncthreads();
#define DN_FRAG(mat, mt, k2) ({ const LAS bf16_t* _r = (const LAS bf16_t*)(sb + (mat) * MATB) + (16 * (mt) + ll) * RS + 32 * (k2) + 4 * qd; mk8(*(const LAS u32x2*)_r, *(const LAS u32x2*)(_r + 16)); })
#define DN_STEP(n, st) do { \
        DN_COMMIT(((st) + 2) % 3); \
        DN_ISSUE((n) + 5, ((st) + 2) % 3); \
        if (wave < 1) { \
            const LAS unsigned char* sb = lds + (st) * STG; \
              \
            u32x2 uc[4]; bf16x8 fw[4][2], fk[4][2], fq[4][2], fs[4][2]; \
            _Pragma("unroll") for (int m = 0; m < 4; ++m) _Pragma("unroll") for (int k2 = 0; k2 < 2; ++k2) fw[m][k2] = DN_FRAG(0, m, k2); \
            _Pragma("unroll") for (int m = 0; m < 4; ++m) uc[m] = *(const LAS u32x2*)((const LAS bf16_t*)(sb + 4 * MATB) + ll * RS + 16 * m + 4 * qd); \
            _Pragma("unroll") for (int m = 0; m < 4; ++m) _Pragma("unroll") for (int k2 = 0; k2 < 2; ++k2) fk[m][k2] = DN_FRAG(1, m, k2); \
            const float a = alL[n]; \
            __builtin_amdgcn_sched_barrier(0); \
            bf16x8 Sb[2], Vb[2]; \
            Sb[0] = pk8(S[0], S[1]); Sb[1] = pk8(S[2], S[3]); \
            f32x4 vn[4], oo[4]; \
            _Pragma("unroll") for (int m = 0; m < 4; ++m) { f32x4 acc = {0.f, 0.f, 0.f, 0.f}; \
                _Pragma("unroll") for (int k2 = 0; k2 < 2; ++k2) acc = MFMA16(fw[m][k2], Sb[k2], acc); \
                vn[m][0] = bflo(uc[m].x) - acc[0]; vn[m][1] = bfhi(uc[m].x) - acc[1]; vn[m][2] = bflo(uc[m].y) - acc[2]; vn[m][3] = bfhi(uc[m].y) - acc[3]; } \
            Vb[0] = pk8(vn[0], vn[1]); Vb[1] = pk8(vn[2], vn[3]); \
            _Pragma("unroll") for (int m = 0; m < 4; ++m) _Pragma("unroll") for (int k2 = 0; k2 < 2; ++k2) { fq[m][k2] = DN_FRAG(2, m, k2); fs[m][k2] = DN_FRAG(3, m, k2); } \
            __builtin_amdgcn_sched_barrier(0); \
            _Pragma("unroll") for (int m = 0; m < 4; ++m) { f32x4 acc = S[m] * a; \
                _Pragma("unroll") for (int k2 = 0; k2 < 2; ++k2) acc = MFMA16(fk[m][k2], Vb[k2], acc); \
                S[m] = acc; } \
            _Pragma("unroll") for (int m = 0; m < 4; ++m) { f32x4 acc = {0.f, 0.f, 0.f, 0.f};   \
                _Pragma("unroll") for (int k2 = 0; k2 < 2; ++k2) { acc = MFMA16(Sb[k2], fq[m][k2], acc); acc = MFMA16(Vb[k2], fs[m][k2], acc); } \
                oo[m] = acc; } \
            bf16_t* op = (bf16_t*)(p.ws + OFF_O) + ((size_t)b * SEQ + (n) * 64 + ll) * DM + O_DN + h * 64 + d0 + 4 * qd; \
            _Pragma("unroll") for (int m = 0; m < 4; ++m) { u32x2 o; o.x = pk2(oo[m][0], oo[m][1]); o.y = pk2(oo[m][2], oo[m][3]); *(u32x2*)(op + (size_t)(16 * m) * DM) = o; } \
        } \
        __syncthreads(); \
    } while (0)
    for (int n = 0; n < 255; n += 3) { DN_STEP(n, 0); DN_STEP(n + 1, 1); DN_STEP(n + 2, 2); }
    DN_STEP(255, 0);
#undef DN_STEP
#undef DN_FRAG
#undef DN_ISSUE
#undef DN_COMMIT
}
__device__ __forceinline__ void dn_norm_task(const Params& p, int l, int task8) {
    const int tid = TIDX, d8 = (tid & 7) * 8;
    u32x4 uu[8], gg[8];
#pragma unroll
    for (int sub = 0; sub < 8; ++sub) { const int pair = (task8 * 8 + sub) * 64 + (tid >> 3), tok = pair >> 2, h = pair & 3;
        uu[sub] = *(const u32x4*)((const bf16_t*)(p.ws + OFF_O) + (size_t)tok * DM + O_DN + h * 64 + d8);
        gg[sub] = *(const u32x4*)((const bf16_t*)(p.ws + OFF_B) + (size_t)tok * NP + C_DG + h * 64 + d8); }
    float gn[8];
#pragma unroll
    for (int e = 0; e < 8; ++e) gn[e] = p.dn_norm_g[l * 64 + d8 + e];
#pragma unroll
    for (int sub = 0; sub < 8; ++sub) { const int pair = (task8 * 8 + sub) * 64 + (tid >> 3), tok = pair >> 2, h = pair & 3;
        const u32x4 u = uu[sub], gt = gg[sub];
        const float ov[8] = {bflo(u.x), bfhi(u.x), bflo(u.y), bfhi(u.y), bflo(u.z), bfhi(u.z), bflo(u.w), bfhi(u.w)};
        const float gv[8] = {bflo(gt.x), bfhi(gt.x), bflo(gt.y), bfhi(gt.y), bflo(gt.z), bfhi(gt.z), bflo(gt.w), bfhi(gt.w)};
        float ss = 0.f;
#pragma unroll
        for (int e = 0; e < 8; ++e) ss += ov[e] * ov[e];
        ss += __shfl_xor(ss, 1); ss += __shfl_xor(ss, 2); ss += __shfl_xor(ss, 4);
        const float rstd = rsqrtf(ss * (1.f / 64.f) + EPS);
        float r[8];
#pragma unroll
        for (int e = 0; e < 8; ++e) r[e] = ov[e] * rstd * gn[e] * gv[e] * sigmoidf_(gv[e]);
        u32x4 o; o.x = pk2(r[0], r[1]); o.y = pk2(r[2], r[3]); o.z = pk2(r[4], r[5]); o.w = pk2(r[6], r[7]);
        *(u32x4*)((bf16_t*)(p.ws + OFF_O) + (size_t)tok * DM + O_DN + h * 64 + d8) = o; }
}

__device__ __forceinline__ int next_task(int* cnt, LAS int* slot, int& pre) {
    __syncthreads();
    if (TIDX == 0) *slot = pre;
    __syncthreads();
    const int t = __builtin_amdgcn_readfirstlane(*slot);
    if (TIDX == 0) pre = atomicAdd(cnt, 1);
    return t;
}
__device__ __forceinline__ void mix_phase(const Params& p, int l, int k, LAS unsigned char* lds) {
    int* cnt = (int*)(p.ws + OFF_CNT) + l * 3 + k;
    LAS int* slot = (LAS int*)(lds + LDS_BYTES + 16);
    int pre = 0; if (TIDX == 0) pre = atomicAdd(cnt, 1);
    unsigned* gready = (unsigned*)(p.ws + OFF_CNT) + 32 + l * 8;
    if (k == 0) {
        for (;;) { int t = next_task(cnt, slot, pre);
            if (t < 2048) { dn_prep_task(p, l, lds, t); continue; } t -= 2048;
            if (t < 1024) { dil_task(p, l, lds, 0, t); continue; } t -= 1024;
            if (t < 2048) { gla_a_task(p, l, lds, t); continue; }
            break; }
    } else if (k == 1) {
        for (;;) { int t = next_task(cnt, slot, pre);
            if (t < 32) { dn_scan_task(p, l, lds, t); continue; } t -= 32;
            if (t < 32) { gla_scan_task(p, lds, t, gready + (t >> 2)); continue; } t -= 32;
            if (t < 1024) { sb_task(p, l, lds, t); continue; } t -= 1024;
            if (t < 1024) { dil_task(p, l, lds, 1, t); continue; } t -= 1024;
            if (t < 2048) { gla_c_task(p, l, lds, t, gready); continue; }
            break; }
    } else {
        for (;;) { int t = next_task(cnt, slot, pre);
            if (t < 1024) { dil_task(p, l, lds, 2, t); continue; } t -= 1024;
            if (t < 256) { dn_norm_task(p, l, t); continue; }
            break; }
    }
}

#define XB_TMO      128
#define XB_XCNT(j)  (256  + 64 * (j))
#define XB_XSUB(j)  (1280 + 64 * (j))
#define XB_XGEN(j)  (2304 + 64 * (j))
#define XB_TOP      3328
#define XB_TOPGEN   3392
#define XCD_BAR_WORDS 3456
#define XB_SPIN_CAP (1u << 22)
__device__ __forceinline__ unsigned xb_ld(unsigned* p)              { return __hip_atomic_load(p, __ATOMIC_RELAXED, __HIP_MEMORY_SCOPE_AGENT); }
__device__ __forceinline__ unsigned xb_add(unsigned* p, unsigned v) { return __hip_atomic_fetch_add(p, v, __ATOMIC_RELAXED, __HIP_MEMORY_SCOPE_AGENT); }
__device__ __forceinline__ unsigned xb_xcc_id() { return (unsigned)__builtin_amdgcn_s_getreg((3 << 11) | 20) & 0xFu; }
#define XB_SPIN(cond, bar) do { unsigned _sp = 0; while (cond) { __builtin_amdgcn_s_sleep(1); \
    if ((++_sp & 255u) == 0u) { if (xb_ld(&(bar)[XB_TMO])) break; if (_sp > XB_SPIN_CAP) { atomicAdd(&(bar)[XB_TMO], 1u); break; } } } } while (0)
struct XcdBarrier { unsigned* bar; unsigned x; volatile LAS unsigned* st; };
__device__ __forceinline__ XcdBarrier xcd_barrier_post(unsigned* bar, volatile LAS unsigned* st) {
    XcdBarrier b; b.bar = bar; b.x = xb_xcc_id(); b.st = st;
    if (TIDX == 0) (void)xb_add(&bar[XB_XCNT(b.x)], 1u);
    return b;
}
__device__ __forceinline__ void xcd_barrier_complete(unsigned* bar, unsigned x, unsigned& nloc, unsigned& nx) {
    const unsigned G = gridDim.x * gridDim.y * gridDim.z;
    unsigned sum, cnt, mine, sp = 0u;
    for (;;) {
        sum = 0u; cnt = 0u; mine = 0u;
#pragma unroll
        for (unsigned j = 0; j < 16; ++j) { const unsigned c = xb_ld(&bar[XB_XCNT(j)]); sum += c; cnt += (c > 0u) ? 1u : 0u; mine = (j == x) ? c : mine; }
        if (sum == G) break;
        __builtin_amdgcn_s_sleep(1);
        if ((++sp & 255u) == 0u) { if (xb_ld(&bar[XB_TMO])) break; if (sp > XB_SPIN_CAP) { atomicAdd(&bar[XB_TMO], 1u); break; } }
    }
    nloc = mine > 0u ? mine : 1u; nx = cnt > 0u ? cnt : 1u;
}
__device__ __forceinline__ void xcd_barrier(const XcdBarrier& b) {
    asm volatile("s_waitcnt vmcnt(0)" ::: "memory");
    __syncthreads();
    if (TIDX == 0) {
        unsigned* bar = b.bar;
        __builtin_amdgcn_s_waitcnt(0);
        unsigned nloc = b.st[0], nx = b.st[1];
        if (nloc == 0u) { xcd_barrier_complete(bar, b.x, nloc, nx); b.st[0] = nloc; b.st[1] = nx; }
        const unsigned old = xb_add(&bar[XB_XSUB(b.x)], 1u);
        const unsigned gen = old / nloc;
        if (old + 1u == (gen + 1u) * nloc) {
            __builtin_amdgcn_fence(__ATOMIC_RELEASE, "agent");
            asm volatile("s_waitcnt vmcnt(0)" ::: "memory");
            const unsigned og = xb_add(&bar[XB_TOP], 1u);
            const unsigned tg = og / nx;
            if (og + 1u == (tg + 1u) * nx) xb_add(&bar[XB_TOPGEN], 1u);
            else XB_SPIN(xb_ld(&bar[XB_TOPGEN]) == tg, bar);
            __builtin_amdgcn_fence(__ATOMIC_ACQUIRE, "agent");
            xb_add(&bar[XB_XGEN(b.x)], 1u);
            asm volatile("s_waitcnt vmcnt(0)" ::: "memory");
        } else {
            XB_SPIN(xb_ld(&bar[XB_XGEN(b.x)]) == gen, bar);
            __builtin_amdgcn_fence(__ATOMIC_ACQUIRE, "agent");
            asm volatile("s_waitcnt vmcnt(0)" ::: "memory");
        }
    }
    __syncthreads();
}

__global__ void __launch_bounds__(512) fwd_kernel(Params p) {
    extern __shared__ __attribute__((aligned(16))) unsigned char shm[];
    LAS unsigned char* lds = (LAS unsigned char*)shm;
    cg::grid_group grid = cg::this_grid();
    unsigned char* ws = p.ws;
    volatile LAS unsigned* bst = (volatile LAS unsigned*)(lds + LDS_BYTES);
    if (TIDX < 2) bst[TIDX] = 0u;
    __syncthreads();
    XcdBarrier gbar; gbar.bar = (unsigned*)(ws + OFF_BAR); gbar.x = 0; gbar.st = bst;
    if (p.ph_hi - p.ph_lo > 1) gbar = xcd_barrier_post((unsigned*)(ws + OFF_BAR), bst);
    if (p.ph_hi > 1000000) grid.sync();
    for (int ph = p.ph_lo; ph < p.ph_hi; ++ph) {
        const int l = ph / NPH, k = ph % NPH;
        const float* xin = (l == 0) ? p.x : p.out;
        if (k == 0) {
            wconv_phase(p, l, lds);
            rmsnorm_phase(xin, p.g_mix + l * DM, (bf16_t*)(ws + OFF_H));
        } else if (k == 8) {
            rmsnorm_phase(p.out, p.g_mlp + l * DM, (bf16_t*)(ws + OFF_H));
        } else if (k >= 2 && k <= 4) {
            mix_phase(p, l, k - 2, lds);
        } else {
            pg8::Epi E; E.mode = 0; E.O = (bf16_t*)(ws + OFF_B); E.ldc = NP; E.Xin = xin; E.Xout = p.out; E.Y = (const bf16_t*)(ws + OFF_B);
            const bf16_t* A = (const bf16_t*)(ws + OFF_H); const bf16_t* Bt = (const bf16_t*)(ws + OFF_WIN); int lda = DM, a_sh = 0, a_mul = 0, N = NP, K = DM;
            if (k == 5) { E.ldc = 4096; A = (const bf16_t*)(ws + OFF_O); a_sh = 2; a_mul = 256; Bt = (const bf16_t*)(ws + OFF_WB); N = 4096; K = 256; }
            else if (k == 6) { E.mode = 3; E.O = (bf16_t*)(ws + OFF_O); Bt = (const bf16_t*)(ws + OFF_WG); N = 4096; }
            else if (k == 7) { E.mode = 2; A = (const bf16_t*)(ws + OFF_O); Bt = (const bf16_t*)(ws + OFF_WO); N = DM; }
            else if (k == 9) { E.mode = 1; E.ldc = DFF; Bt = (const bf16_t*)(ws + OFF_W1); N = DFF; }
            else if (k == 10) { E.mode = 2; E.Xin = p.out; A = (const bf16_t*)(ws + OFF_B); lda = DFF; Bt = (const bf16_t*)(ws + OFF_W2); N = DM; K = DFF; }
            run_gemm(lds, A, lda, a_sh, a_mul, Bt, N, K, E);
        }
        if (ph + 1 < p.ph_hi) xcd_barrier(gbar);
    }
}

#ifndef ONE_LAUNCH
#define ONE_LAUNCH 1
#endif
extern "C" void kernel_launch(void* const* d_in, const int* in_sizes, int n_in, void* d_out, int out_size, void* d_ws, size_t ws_size, hipStream_t stream) {
    static int grid = 0;
    if (grid == 0) {
        if (n_in != 17 || out_size != T_TOK * DM || ws_size < WS_END) { fprintf(stderr, "kernel_launch: unexpected shapes / workspace (%zu < %zu)\n", ws_size, (size_t)WS_END); grid = -1; return; }
        int dev = 0, cus = 0, per_cu = 0;
        hipGetDevice(&dev); hipDeviceGetAttribute(&cus, hipDeviceAttributeMultiprocessorCount, dev);
        if (hipFuncSetAttribute((const void*)fwd_kernel, hipFuncAttributeMaxDynamicSharedMemorySize, LDS_TOTAL) != hipSuccess) { fprintf(stderr, "hipFuncSetAttribute failed\n"); grid = -1; return; }
        if (hipOccupancyMaxActiveBlocksPerMultiprocessor(&per_cu, (const void*)fwd_kernel, 512, LDS_TOTAL) != hipSuccess || per_cu < 1) per_cu = 1;
        grid = cus * per_cu;
    }
    if (grid < 0) return;
    Params p{};
    p.x = (const float*)d_in[0]; p.g_mix = (const float*)d_in[1]; p.g_mlp = (const float*)d_in[2]; p.w_in = (const float*)d_in[3]; p.gla_w_lr2 = (const float*)d_in[4];
    p.gla_b_lr = (const float*)d_in[5]; p.gla_norm_g = (const float*)d_in[6]; p.dn_conv_w = (const float*)d_in[7]; p.dn_a_log = (const float*)d_in[8]; p.dn_dt_bias = (const float*)d_in[9];
    p.dn_norm_g = (const float*)d_in[10]; p.dil_q_g = (const float*)d_in[11]; p.dil_k_g = (const float*)d_in[12]; p.w_branch = (const float*)d_in[13]; p.w_out = (const float*)d_in[14];
    p.w_mlp_in = (const float*)d_in[15]; p.w_mlp_out = (const float*)d_in[16]; p.out = (float*)d_out; p.ws = (unsigned char*)d_ws;
    if (hipMemsetAsync((char*)d_ws + OFF_CNT, 0, 256 + 16384, stream) != hipSuccess) { fprintf(stderr, "memset failed\n"); return; }
#if ONE_LAUNCH
    p.ph_lo = 0; p.ph_hi = NLAYER * NPH;
    void* args[] = {&p};
    hipError_t e = hipLaunchCooperativeKernel((const void*)fwd_kernel, dim3(grid), dim3(512), args, LDS_TOTAL, stream);
    if (e != hipSuccess) fprintf(stderr, "cooperative launch failed: %s (grid %d)\n", hipGetErrorString(e), grid);
#else
    for (int ph = 0; ph < NLAYER * NPH; ++ph) { p.ph_lo = ph; p.ph_hi = ph + 1; hipLaunchKernelGGL(fwd_kernel, dim3(grid), dim3(512), LDS_TOTAL, stream, p); }
#endif
}
```

```cpp
#include <hip/hip_runtime.h>
#include <hip/hip_cooperative_groups.h>
#include <cstdio>
namespace cg = cooperative_groups;

#define LAS __attribute__((address_space(3)))
typedef unsigned short bf16_t;
typedef short bf16x8 __attribute__((ext_vector_type(8)));
typedef short bf16x4 __attribute__((ext_vector_type(4)));
typedef float f32x4 __attribute__((ext_vector_type(4)));
typedef unsigned u32x4 __attribute__((ext_vector_type(4)));
typedef unsigned u32x2 __attribute__((ext_vector_type(2)));

constexpr int T_TOK = 32768, SEQ = 16384, DM = 1024, NP = 3584, DFF = 4096;
constexpr int C_SBQ = 0, C_SBK = 256, C_SBV = 512, C_GQ = 768, C_GK = 896, C_GV = 1024, C_GLR = 1280, C_GR = 1296, C_DQKV = 1552, C_DA = 2320, C_DB = 2324,
              C_DG = 2328, C_LQ = 2584, C_LK = 2840, C_LV = 3096, C_GATE = 3352, N_IN = 7448;
constexpr int O_SB = 0, O_GLA = 256, O_DN = 512, O_DIL = 768;
constexpr float EPS = 1e-6f;
constexpr int NLAYER = 4, NPH = 11;
constexpr size_t SZ_WIN = (size_t)NP * DM * 2, SZ_WG = (size_t)4096 * DM * 2, SZ_WB = (size_t)4096 * 256 * 2, SZ_WO = (size_t)DM * DM * 2, SZ_W1 = (size_t)DFF * DM * 2, SZ_W2 = (size_t)DM * DFF * 2;
constexpr size_t OFF_WIN = 0, OFF_WG = OFF_WIN + SZ_WIN, OFF_WB = OFF_WG + SZ_WG, OFF_WO = OFF_WB + SZ_WB, OFF_W1 = OFF_WO + SZ_WO, OFF_W2 = OFF_W1 + SZ_W1;
constexpr size_t OFF_B = OFF_W2 + SZ_W2;
constexpr size_t SZ_B = (size_t)T_TOK * 4096 * 2;
constexpr size_t OFF_GLAU = OFF_B + (size_t)T_TOK * NP * 2;
constexpr size_t OFF_GLAA = OFF_GLAU + (size_t)2048 * 2048 * 4;
constexpr size_t OFF_DSTAT = OFF_GLAA + (size_t)2048 * 32 * 4;
constexpr size_t OFF_DNA = OFF_DSTAT + (size_t)T_TOK * 4 * 2 * 4;
constexpr size_t OFF_H = OFF_B + SZ_B;
constexpr size_t OFF_O = OFF_H + (size_t)T_TOK * DM * 2;
constexpr size_t OFF_DN = OFF_O + (size_t)T_TOK * DM * 2;
constexpr size_t OFF_CNT = OFF_DN + (size_t)2048 * 5 * 8192;
constexpr size_t OFF_BAR = OFF_CNT + 256;
constexpr size_t WS_END = OFF_BAR + 16384;
static_assert(OFF_DNA + 2048 * 4 <= OFF_H, "region B overflow");
constexpr int LDS_BYTES = 131072, LDS_TOTAL = LDS_BYTES + 64;

struct Params {
    const float* x; const float* g_mix; const float* g_mlp; const float* w_in; const float* gla_w_lr2; const float* gla_b_lr; const float* gla_norm_g;
    const float* dn_conv_w; const float* dn_a_log; const float* dn_dt_bias; const float* dn_norm_g; const float* dil_q_g; const float* dil_k_g;
    const float* w_branch; const float* w_out; const float* w_mlp_in; const float* w_mlp_out;
    float* out; unsigned char* ws; int ph_lo, ph_hi;
};

typedef __bf16 bf16v2_t __attribute__((ext_vector_type(2)));
typedef float f32v2_t __attribute__((ext_vector_type(2)));
__device__ __forceinline__ unsigned pk2(float lo, float hi) { f32v2_t v = {lo, hi}; bf16v2_t b = __builtin_convertvector(v, bf16v2_t); return __builtin_bit_cast(unsigned, b); }
__device__ __forceinline__ float bf2f(bf16_t b) { return __uint_as_float(((unsigned)b) << 16); }
__device__ __forceinline__ float bflo(unsigned u) { return __uint_as_float(u << 16); }
__device__ __forceinline__ float bfhi(unsigned u) { return __uint_as_float(u & 0xffff0000u); }
__device__ __forceinline__ bf16_t f2bf(float f) { return (bf16_t)(pk2(f, 0.f) & 0xffffu); }
__device__ __forceinline__ float wave_sum(float v) {
#pragma unroll
    for (int o = 1; o < 64; o <<= 1) v += __shfl_xor(v, o);
    return v;
}
__device__ __forceinline__ float sigmoidf_(float x) { return __builtin_amdgcn_rcpf(1.f + __expf(-x)); }
__device__ __forceinline__ float sigmoid_fast(float x) { return __builtin_amdgcn_rcpf(1.f + __expf(-x)); }
__device__ __forceinline__ float softplusf_(float z) { return fmaxf(z, 0.f) + __logf(1.f + __expf(-fabsf(z))); }
__device__ __forceinline__ bf16x8 mk8(u32x2 a, u32x2 b) { u32x4 t; t.x = a.x; t.y = a.y; t.z = b.x; t.w = b.y; return __builtin_bit_cast(bf16x8, t); }
__device__ __forceinline__ bf16x8 pk8(f32x4 a, f32x4 b) { u32x4 t; t.x = pk2(a[0], a[1]); t.y = pk2(a[2], a[3]); t.z = pk2(b[0], b[1]); t.w = pk2(b[2], b[3]); return __builtin_bit_cast(bf16x8, t); }
__device__ __forceinline__ int tid_opaque() { int t = (int)threadIdx.x; asm volatile("" : "+v"(t)); return t; }
#define TIDX tid_opaque()
#define MFMA16(a, b, c) __builtin_amdgcn_mfma_f32_16x16x32_bf16((a), (b), (c), 0, 0, 0)

namespace pg8 {
constexpr int BM = 256, BK = 64, HALF = 128, HTB = HALF * BK * 2, NXCD = 8, WGM = 8;
__device__ __forceinline__ int lds_byte(int r, int c) { const int st = (r >> 4) * 2 + (c >> 5), rr = r & 15, cc = c & 31, ob = rr * 64 + cc * 2; return st * 1024 + (ob ^ (((ob >> 9) & 1) << 5)); }
__device__ __forceinline__ void stage_rc(int b, int& R, int& C) { const int st = b / 1024, sb = b % 1024, swz = sb ^ (((sb >> 9) & 1) << 5); R = (st >> 1) * 16 + swz / 64; C = (st & 1) * 32 + (swz % 64) / 2; }
__device__ __forceinline__ int perm32(int rho) { const int n = rho >> 4, i = rho & 15; return 8 * (i >> 2) + 4 * n + (i & 3); }
struct Unit { int pm, pn; };
struct Gemm { const bf16_t* A; const bf16_t* Bt; int M, N, K, lda, a_sh, a_mul; };
struct StaticOrder {
    int nM, nN, nwg, G, c;
    __device__ void init(int M, int N, int G_, int c_) { nM = M / BM; nN = N / BM; nwg = nM * nN; G = G_; c = c_; }
    __device__ bool next(int i, Unit& u) const {
        const long L = (long)i * G + c; if (L >= nwg) return false;
        int wgid = (int)L; { const int q = nwg / NXCD, r = nwg % NXCD, xcd = wgid % NXCD, off = wgid / NXCD; wgid = (xcd < r ? xcd * (q + 1) : r * (q + 1) + (xcd - r) * q) + off; }
        const int nig = WGM * nN, gid = wgid / nig, fm = gid * WGM, gsz = (nM - fm) < WGM ? (nM - fm) : WGM;
        u.pm = fm + ((wgid % nig) % gsz); u.pn = (wgid % nig) / gsz; return true;
    }
};
struct Epi {
    int mode; bf16_t* O; int ldc; const float* Xin; float* Xout; const bf16_t* Y;
    __device__ __forceinline__ void operator()(const f32x4 (&acc)[2][2][4][2], const Unit& u, int wr, int wc, int fr, int fq) const {
        const int row0 = u.pm * BM + wr * 64 + fr;
        if (mode < 2) {
            const int col0 = u.pn * BM + wc * 32 + 8 * fq;
#pragma unroll
            for (int ai = 0; ai < 2; ++ai)
#pragma unroll
                for (int m = 0; m < 4; ++m) { bf16_t* rowp = O + (size_t)(row0 + ai * HALF + m * 16) * ldc + col0;
#pragma unroll
                    for (int bj = 0; bj < 2; ++bj) { f32x4 v0 = acc[ai][bj][m][0], v1 = acc[ai][bj][m][1];
                        if (mode == 1) {
#pragma unroll
                            for (int j = 0; j < 4; ++j) { float a = fmaxf(v0[j], 0.f), b = fmaxf(v1[j], 0.f); v0[j] = a * a; v1[j] = b * b; } }
                        u32x4 o; o.x = pk2(v0[0], v0[1]); o.y = pk2(v0[2], v0[3]); o.z = pk2(v1[0], v1[1]); o.w = pk2(v1[2], v1[3]);
                        *(u32x4*)(rowp + bj * HALF) = o; } }
        } else if (mode == 2) {
            const int col0 = u.pn * BM + wc * 32 + 4 * fq;
#pragma unroll
            for (int ai = 0; ai < 2; ++ai) { f32x4 xi[4][2][2];
#pragma unroll
                for (int m = 0; m < 4; ++m) { const size_t ro = (size_t)(row0 + ai * HALF + m * 16) * DM + col0;
#pragma unroll
                    for (int bj = 0; bj < 2; ++bj)
#pragma unroll
                        for (int n = 0; n < 2; ++n) xi[m][bj][n] = *(const f32x4*)(Xin + ro + bj * HALF + n * 16); }
                __builtin_amdgcn_sched_barrier(0);
#pragma unroll
                for (int m = 0; m < 4; ++m) { const size_t ro = (size_t)(row0 + ai * HALF + m * 16) * DM + col0;
#pragma unroll
                    for (int bj = 0; bj < 2; ++bj)
#pragma unroll
                        for (int n = 0; n < 2; ++n) *(f32x4*)(Xout + ro + bj * HALF + n * 16) = xi[m][bj][n] + acc[ai][bj][m][n]; }
                __builtin_amdgcn_sched_barrier(0); }
        } else {
            const int ch0 = u.pn * 64 + wc * 16 + 4 * fq;
#pragma unroll
            for (int ai = 0; ai < 2; ++ai) { u32x2 y[4][2][2];
#pragma unroll
                for (int m = 0; m < 4; ++m) { const size_t row = (size_t)(row0 + ai * HALF + m * 16);
#pragma unroll
                    for (int bj = 0; bj < 2; ++bj)
#pragma unroll
                        for (int n = 0; n < 2; ++n) y[m][bj][n] = *(const u32x2*)(Y + row * 4096 + (2 * bj + n) * 1024 + ch0); }
                __builtin_amdgcn_sched_barrier(0);
#pragma unroll
                for (int m = 0; m < 4; ++m) { const size_t row = (size_t)(row0 + ai * HALF + m * 16); f32x4 s = {0.f, 0.f, 0.f, 0.f};
#pragma unroll
                    for (int bj = 0; bj < 2; ++bj)
#pragma unroll
                        for (int n = 0; n < 2; ++n) { const u32x2 yy = y[m][bj][n]; const f32x4 a = acc[ai][bj][m][n];
                            s[0] += sigmoid_fast(a[0]) * bflo(yy.x); s[1] += sigmoid_fast(a[1]) * bfhi(yy.x); s[2] += sigmoid_fast(a[2]) * bflo(yy.y); s[3] += sigmoid_fast(a[3]) * bfhi(yy.y); }
                    u32x2 o; o.x = pk2(s[0], s[1]); o.y = pk2(s[2], s[3]); *(u32x2*)(O + row * DM + ch0) = o; }
                __builtin_amdgcn_sched_barrier(0); }
        }
    }
};

__device__ __forceinline__ void gemm_phase(LAS unsigned char* lds, const Gemm g, const StaticOrder& S, const Epi& E) {
    const int tid = TIDX, wid = __builtin_amdgcn_readfirstlane(tid >> 6), lane = tid & 63, wr = wid >> 2, wc = wid & 3, fr = lane & 15, fq = lane >> 4;
    const int K = g.K, nt = K / BK, lda = g.lda;
    unsigned voffA[2], voffB[2];
#pragma unroll
    for (int i = 0; i < 2; ++i) { int R, C; stage_rc(tid * 16 + i * 8192, R, C); const int Rb = (E.mode < 2) ? ((R & ~31) + perm32(R & 31)) : R;
        voffA[i] = (unsigned)(R * lda + C) * 2u; voffB[i] = (unsigned)(Rb * K + C) * 2u; }
    const size_t kstep = (size_t)(BK * 2);
    const size_t hstepA = (size_t)HALF * lda * 2, hstepB = (size_t)HALF * K * 2;
    const size_t tstepA = 2 * hstepA, tstepB = 2 * hstepB;
    const unsigned ldsw = (unsigned)wid * 1024u;
    const int aoff = lds_byte(wr * 64 + fr, fq * 8), boff = lds_byte(wc * 32 + fr, fq * 8);
#define PG8_SA(b, h) (((b) * 2 + (h)) * HTB)
#define PG8_SB(b, h) ((4 + (b) * 2 + (h)) * HTB)
#define PG8_STAGE(bufoff, gbase, voff) do { _Pragma("unroll") for (int _i = 0; _i < 2; ++_i) \
        __builtin_amdgcn_global_load_lds((const unsigned*)((const char*)(gbase) + (voff)[_i]), (LAS unsigned*)(lds + (bufoff) + ldsw + _i * 8192), 16, 0, 0); } while (0)
#define PG8_LDA(dst, b, h) do { _Pragma("unroll") for (int m = 0; m < 4; ++m) _Pragma("unroll") for (int k = 0; k < 2; ++k) dst[m][k] = *(const LAS bf16x8*)(lds + PG8_SA(b, h) + aoff + m * 2048 + k * 1024); } while (0)
#define PG8_LDB(dst, b, h) do { _Pragma("unroll") for (int n = 0; n < 2; ++n) _Pragma("unroll") for (int k = 0; k < 2; ++k) dst[n][k] = *(const LAS bf16x8*)(lds + PG8_SB(b, h) + boff + n * 2048 + k * 1024); } while (0)
#define PG8_MMA(ai, bj, At, Bt) do { __builtin_amdgcn_s_setprio(1); _Pragma("unroll") for (int m = 0; m < 4; ++m) _Pragma("unroll") for (int n = 0; n < 2; ++n) _Pragma("unroll") for (int k = 0; k < 2; ++k) \
        acc[ai][bj][m][n] = __builtin_amdgcn_mfma_f32_16x16x32_bf16(Bt[n][k], At[m][k], acc[ai][bj][m][n], 0, 0, 0); __builtin_amdgcn_s_setprio(0); } while (0)
#define PG8_WAIT_V(n) asm volatile("s_waitcnt vmcnt(" #n ")" ::: "memory")
#define PG8_WAIT_L(n) asm volatile("s_waitcnt lgkmcnt(" #n ")" ::: "memory")
#define PG8_BAR __builtin_amdgcn_s_barrier()
#define PG8_SCHED __builtin_amdgcn_sched_barrier(0)
#define PG8_APTR(u) ((const char*)g.A + (size_t)(u).pm * tstepA + (size_t)(((u).pn >> g.a_sh) * g.a_mul) * 2)
    Unit cur, nxt; int ui = 0;
    if (!S.next(0, cur)) return;
    f32x4 acc[2][2][4][2];
#pragma unroll
    for (int a = 0; a < 2; ++a)
#pragma unroll
        for (int b = 0; b < 2; ++b)
#pragma unroll
            for (int m = 0; m < 4; ++m)
#pragma unroll
                for (int n = 0; n < 2; ++n) acc[a][b][m][n] = (f32x4){0.f, 0.f, 0.f, 0.f};
    bf16x8 At[4][2], B0[2][2], B1[2][2];
    const char* cA = PG8_APTR(cur); const char* cB = (const char*)g.Bt + (size_t)cur.pn * tstepB;
    PG8_STAGE(PG8_SB(0, 0), cB, voffB); PG8_STAGE(PG8_SB(0, 1), cB + hstepB, voffB); PG8_STAGE(PG8_SA(0, 0), cA, voffA); PG8_STAGE(PG8_SA(0, 1), cA + hstepA, voffA);
    if (wr == 1) PG8_BAR;
    PG8_WAIT_V(2); PG8_BAR;
    PG8_STAGE(PG8_SB(1, 0), cB + kstep, voffB); PG8_STAGE(PG8_SA(1, 0), cA + kstep, voffA); PG8_STAGE(PG8_SB(1, 1), cB + hstepB + kstep, voffB);
    PG8_WAIT_V(6); PG8_BAR;
    for (;;) {
        const bool has_next = S.next(ui + 1, nxt);
        const char* nA = has_next ? PG8_APTR(nxt) : cA; const char* nB = has_next ? (const char*)g.Bt + (size_t)nxt.pn * tstepB : cB;
        for (int t = 0; t < nt; t += 2) {
            const bool last = (t == nt - 2);
            const char* a1 = cA + (size_t)(t + 1) * kstep;
            const char* a2 = last ? nA : cA + (size_t)(t + 2) * kstep; const char* b2 = last ? nB : cB + (size_t)(t + 2) * kstep;
            const char* a3 = a2 + kstep; const char* b3 = b2 + kstep;
            PG8_LDB(B0, 0, 0); PG8_LDB(B1, 0, 1); PG8_SCHED; PG8_LDA(At, 0, 0); PG8_STAGE(PG8_SA(1, 1), a1 + hstepA, voffA);
            PG8_WAIT_V(8); PG8_WAIT_L(0); PG8_BAR; PG8_MMA(0, 0, At, B0); PG8_MMA(0, 1, At, B1); PG8_BAR; PG8_SCHED;
            PG8_LDA(At, 0, 1); PG8_STAGE(PG8_SB(0, 0), b2, voffB); PG8_STAGE(PG8_SB(0, 1), b2 + hstepB, voffB); PG8_STAGE(PG8_SA(0, 0), a2, voffA);
            PG8_WAIT_V(8); PG8_WAIT_L(0); PG8_BAR; PG8_MMA(1, 0, At, B0); PG8_MMA(1, 1, At, B1); PG8_BAR; PG8_SCHED;
            PG8_LDB(B0, 1, 0); PG8_LDB(B1, 1, 1); PG8_SCHED; PG8_LDA(At, 1, 0); PG8_STAGE(PG8_SA(0, 1), a2 + hstepA, voffA);
            PG8_WAIT_V(8); PG8_WAIT_L(0); PG8_BAR; PG8_MMA(0, 0, At, B0); PG8_MMA(0, 1, At, B1); PG8_BAR; PG8_SCHED;
            PG8_LDA(At, 1, 1); PG8_STAGE(PG8_SB(1, 0), b3, voffB); PG8_STAGE(PG8_SB(1, 1), b3 + hstepB, voffB); PG8_STAGE(PG8_SA(1, 0), a3, voffA);
            PG8_WAIT_V(8); PG8_WAIT_L(0); PG8_BAR; PG8_MMA(1, 0, At, B0); PG8_MMA(1, 1, At, B1); PG8_BAR; PG8_SCHED;
        }
        if (wr == 0) PG8_BAR;
        E(acc, cur, wr, wc, fr, fq);
        if (!has_next) break;
#pragma unroll
        for (int a = 0; a < 2; ++a)
#pragma unroll
            for (int b = 0; b < 2; ++b)
#pragma unroll
                for (int m = 0; m < 4; ++m)
#pragma unroll
                    for (int n = 0; n < 2; ++n) acc[a][b][m][n] = (f32x4){0.f, 0.f, 0.f, 0.f};
        cur = nxt; cA = nA; cB = nB; ++ui;
        if (wr == 1) PG8_BAR;
    }
    PG8_WAIT_V(0);
    PG8_BAR;
#undef PG8_SA
#undef PG8_SB
#undef PG8_STAGE
#undef PG8_LDA
#undef PG8_LDB
#undef PG8_MMA
#undef PG8_WAIT_V
#undef PG8_WAIT_L
#undef PG8_BAR
#undef PG8_SCHED
#undef PG8_APTR
}
}

__device__ __forceinline__ void run_gemm(LAS unsigned char* lds, const bf16_t* A, int lda, int a_sh, int a_mul, const bf16_t* Bt, int N, int K, const pg8::Epi& E) {
    pg8::Gemm g; g.A = A; g.Bt = Bt; g.M = T_TOK; g.N = N; g.K = K; g.lda = lda; g.a_sh = a_sh; g.a_mul = a_mul;
    pg8::StaticOrder S; S.init(T_TOK, N, (int)gridDim.x, (int)blockIdx.x);
    pg8::gemm_phase(lds, g, S, E);
}

__device__ __forceinline__ void rmsnorm_phase(const float* X, const float* g, bf16_t* H) {
    const int lane = TIDX & 63, gw = blockIdx.x * 8 + (TIDX >> 6), NW = gridDim.x * 8;
    f32x4 gv[4];
#pragma unroll
    for (int j = 0; j < 4; ++j) gv[j] = *(const f32x4*)(g + 4 * (lane + 64 * j));
    for (int row = gw; row < T_TOK; row += 4 * NW) {
        f32x4 v[4][4];
#pragma unroll
        for (int q = 0; q < 4; ++q) { const int rr = row + q * NW; if (rr < T_TOK) {
#pragma unroll
            for (int j = 0; j < 4; ++j) v[q][j] = *(const f32x4*)(X + (size_t)rr * DM + 4 * (lane + 64 * j)); } }
#pragma unroll
        for (int q = 0; q < 4; ++q) { const int rr = row + q * NW; if (rr < T_TOK) { float s = 0.f;
#pragma unroll
            for (int j = 0; j < 4; ++j) s += v[q][j][0] * v[q][j][0] + v[q][j][1] * v[q][j][1] + v[q][j][2] * v[q][j][2] + v[q][j][3] * v[q][j][3];
            const float rstd = rsqrtf(wave_sum(s) * (1.f / DM) + EPS);
#pragma unroll
            for (int j = 0; j < 4; ++j) { u32x2 o; o.x = pk2(v[q][j][0] * rstd * gv[j][0], v[q][j][1] * rstd * gv[j][1]); o.y = pk2(v[q][j][2] * rstd * gv[j][2], v[q][j][3] * rstd * gv[j][3]);
                *(u32x2*)(H + (size_t)rr * DM + 4 * (lane + 64 * j)) = o; } } }
    }
}
__device__ __forceinline__ int wmap(int mat, int j) {
    if (mat == 0) return j < C_GATE ? j : -1;
    if (mat == 1) { const int pn = j >> 8, rho = j & 255, bj = rho >> 7, wc = (rho >> 5) & 3, n = (rho >> 4) & 1, fq = (rho >> 2) & 3, jj = rho & 3;
        return C_GATE + (2 * bj + n) * 1024 + 64 * pn + 16 * wc + 4 * fq + jj; }
    return j;
}
struct WItem { const float* src; bf16_t* dst; int ld, K, mat, k0, n0; };
__device__ __forceinline__ WItem wdecode(const Params& p, int l, int r) {
    constexpr int I0 = 16 * 56, I1 = 16 * 64, I2 = 4 * 4 * 16, I3 = 16 * 16, I4 = 16 * 64;
    WItem w;
    if (r < I0) { w.src = p.w_in + (size_t)l * DM * N_IN; w.ld = N_IN; w.K = DM; w.dst = (bf16_t*)(p.ws + OFF_WIN); w.mat = 0; w.k0 = (r / 56) * 64; w.n0 = (r % 56) * 64; return w; } r -= I0;
    if (r < I1) { w.src = p.w_in + (size_t)l * DM * N_IN; w.ld = N_IN; w.K = DM; w.dst = (bf16_t*)(p.ws + OFF_WG); w.mat = 1; w.k0 = (r / 64) * 64; w.n0 = (r % 64) * 64; return w; } r -= I1;
    if (r < I2) { const int nb = r / 64, q = r % 64; w.src = p.w_branch + ((size_t)l * 4 + nb) * 256 * DM; w.ld = DM; w.K = 256; w.dst = (bf16_t*)(p.ws + OFF_WB) + (size_t)nb * 1024 * 256; w.mat = 2; w.k0 = (q / 16) * 64; w.n0 = (q % 16) * 64; return w; } r -= I2;
    if (r < I3) { w.src = p.w_out + (size_t)l * DM * DM; w.ld = DM; w.K = DM; w.dst = (bf16_t*)(p.ws + OFF_WO); w.mat = 2; w.k0 = (r / 16) * 64; w.n0 = (r % 16) * 64; return w; } r -= I3;
    if (r < I4) { w.src = p.w_mlp_in + (size_t)l * DM * DFF; w.ld = DFF; w.K = DM; w.dst = (bf16_t*)(p.ws + OFF_W1); w.mat = 2; w.k0 = (r / 64) * 64; w.n0 = (r % 64) * 64; return w; } r -= I4;
    w.src = p.w_mlp_out + (size_t)l * DFF * DM; w.ld = DM; w.K = DFF; w.dst = (bf16_t*)(p.ws + OFF_W2); w.mat = 2; w.k0 = (r / 16) * 64; w.n0 = (r % 16) * 64; return w;
}
__device__ __forceinline__ void wload(const WItem& w, int tid, float (&v)[8]) {
    const int nn = tid & 63; const int c = wmap(w.mat, w.n0 + nn);
#pragma unroll
    for (int i = 0; i < 8; ++i) { const int kk = i * 8 + (tid >> 6); v[i] = (c >= 0) ? w.src[(size_t)(w.k0 + kk) * w.ld + c] : 0.f; }
}
__device__ __forceinline__ void wconv_phase(const Params& p, int l, LAS unsigned char* lds) {
    LAS float* scr = (LAS float*)lds;
    constexpr int NI = 16 * 56 + 16 * 64 + 4 * 4 * 16 + 16 * 16 + 16 * 64 + 64 * 16;
    const int tid = TIDX, G = gridDim.x;
    int it = blockIdx.x;
    if (it >= NI) return;
    WItem w0 = wdecode(p, l, it), w1 = w0, w2 = w0; float v0[8], v1[8], v2[8];
    wload(w0, tid, v0);
    if (it + G < NI) { w1 = wdecode(p, l, it + G); wload(w1, tid, v1); }
    for (; it < NI; it += G) {
        if (it + 2 * G < NI) { w2 = wdecode(p, l, it + 2 * G); wload(w2, tid, v2); }
        { const int nn = tid & 63;
#pragma unroll
          for (int i = 0; i < 8; ++i) scr[(i * 8 + (tid >> 6)) * 65 + nn] = v0[i]; }
        __syncthreads();
        { const int kk2 = (tid & 31) * 2;
#pragma unroll
          for (int i = 0; i < 4; ++i) { const int nn = i * 16 + (tid >> 5); *(unsigned*)(w0.dst + (size_t)(w0.n0 + nn) * w0.K + w0.k0 + kk2) = pk2(scr[kk2 * 65 + nn], scr[(kk2 + 1) * 65 + nn]); } }
        __syncthreads();
        w0 = w1; w1 = w2;
#pragma unroll
        for (int i = 0; i < 8; ++i) { v0[i] = v1[i]; v1[i] = v2[i]; }
    }
}

__device__ __forceinline__ void sb_task(const Params& p, int l, LAS unsigned char* lds, int task) {
    constexpr int VTS = 140;
    const int tid = TIDX, wave = tid >> 6, lane = tid & 63, ll = lane & 15, qd = lane >> 4;
    const int bh = task >> 7, qi = 127 - (task & 127), b = bh >> 2, h = bh & 3, q0 = qi * 128;
    const bf16_t* base = (const bf16_t*)(p.ws + OFF_B) + (size_t)b * SEQ * NP;
    LAS bf16_t* vt = (LAS bf16_t*)lds;
    LAS int* flag = (LAS int*)(lds + 64 * VTS * 2);
    bf16x8 qf[2];
#pragma unroll
    for (int ks = 0; ks < 2; ++ks) qf[ks] = *(const bf16x8*)(base + (size_t)(q0 + wave * 16 + ll) * NP + C_SBQ + h * 64 + ks * 32 + qd * 8);
    float carry = 0.f;
    f32x4 oacc[4];
#pragma unroll
    for (int c = 0; c < 4; ++c) oacc[c] = (f32x4){0.f, 0.f, 0.f, 0.f};
    bf16x8 kc[8][2], va, vc;
#define SB_LOAD(jj, K_, A_, C_) do { _Pragma("unroll") for (int g = 0; g < 8; ++g) _Pragma("unroll") for (int ks = 0; ks < 2; ++ks) \
            K_[g][ks] = *(const bf16x8*)(base + (size_t)((jj) * 128 + g * 16 + ll) * NP + C_SBK + h * 64 + ks * 32 + qd * 8); \
        const bf16_t* vp_ = base + (size_t)((jj) * 128 + 2 * (tid >> 3)) * NP + C_SBV + h * 64 + (tid & 7) * 8; A_ = *(const bf16x8*)vp_; C_ = *(const bf16x8*)(vp_ + NP); } while (0)
    SB_LOAD(qi, kc, va, vc);
    for (int j = qi; j >= 0; --j) {
        bf16x8 kn[8][2], van, vcn;
        { const int jn = j > 0 ? j - 1 : 0; SB_LOAD(jn, kn, van, vcn); }
        {
#pragma unroll
            for (int e = 0; e < 8; ++e) *(LAS unsigned*)(vt + ((tid & 7) * 8 + e) * VTS + 2 * (tid >> 3)) = (unsigned)(unsigned short)va[e] | ((unsigned)(unsigned short)vc[e] << 16);
        }
        f32x4 s[8];
#pragma unroll
        for (int g = 0; g < 8; ++g) { s[g] = (f32x4){0.f, 0.f, 0.f, 0.f};
#pragma unroll
            for (int ks = 0; ks < 2; ++ks) s[g] = MFMA16(kc[g][ks], qf[ks], s[g]); }
        const bool diag = (j == qi);
        f32x4 sp[8], lb[8]; float Gt[8], abq[8];
#pragma unroll
        for (int g = 0; g < 8; ++g) {
#pragma unroll
            for (int r = 0; r < 4; ++r) { const float z = s[g][r] * 0.18033688011112042f;
                float spv = fmaxf(z, 0.f) + __builtin_amdgcn_logf(1.f + __builtin_amdgcn_exp2f(-fabsf(z))), lbv = z - spv;
                if (diag && !(16 * g + 4 * qd + r < wave * 16 + ll)) { spv = 0.f; lbv = -INFINITY; }
                sp[g][r] = spv; lb[g][r] = lbv; }
            const float L = (sp[g][0] + sp[g][1]) + (sp[g][2] + sp[g][3]);
            const float L0 = __shfl(L, ll), L1 = __shfl(L, ll + 16), L2 = __shfl(L, ll + 32), L3 = __shfl(L, ll + 48);
            Gt[g] = (L0 + L1) + (L2 + L3);
            abq[g] = (qd < 1 ? L1 : 0.f) + (qd < 2 ? L2 : 0.f) + (qd < 3 ? L3 : 0.f);
        }
        float run = 0.f; bf16x8 pf[4]; f32x4 w[8];
#pragma unroll
        for (int g = 7; g >= 0; --g) {
            const float bs = carry - run - abq[g];
            w[g][3] = __builtin_amdgcn_exp2f(lb[g][3] + bs);
            w[g][2] = __builtin_amdgcn_exp2f(lb[g][2] + bs - sp[g][3]);
            w[g][1] = __builtin_amdgcn_exp2f(lb[g][1] + bs - (sp[g][3] + sp[g][2]));
            w[g][0] = __builtin_amdgcn_exp2f(lb[g][0] + bs - (sp[g][3] + sp[g][2] + sp[g][1]));
            run += Gt[g];
        }
#pragma unroll
        for (int g2 = 0; g2 < 4; ++g2) pf[g2] = pk8(w[2 * g2], w[2 * g2 + 1]);
        carry -= run;
        __syncthreads();
        {
            bf16x8 af[4][4];
#pragma unroll
            for (int c = 0; c < 4; ++c)
#pragma unroll
                for (int g2 = 0; g2 < 4; ++g2) { const LAS bf16_t* vr = vt + (16 * c + ll) * VTS + 32 * g2 + 4 * qd; af[c][g2] = mk8(*(const LAS u32x2*)vr, *(const LAS u32x2*)(vr + 16)); }
            __builtin_amdgcn_sched_barrier(0);
#pragma unroll
            for (int c = 0; c < 4; ++c)
#pragma unroll
                for (int g2 = 0; g2 < 4; ++g2) oacc[c] = MFMA16(af[c][g2], pf[g2], oacc[c]);
        }
        const int done = __all(carry < -150.05f) ? 1 : 0;
        if (lane == 0) flag[wave] = done;
        __syncthreads();
        int all = 1;
#pragma unroll
        for (int i = 0; i < 8; ++i) all &= flag[i];
        if (__builtin_amdgcn_readfirstlane(all)) break;
        __syncthreads();
#pragma unroll
        for (int g = 0; g < 8; ++g) { kc[g][0] = kn[g][0]; kc[g][1] = kn[g][1]; }
        va = van; vc = vcn;
    }
#undef SB_LOAD
    bf16_t* op = (bf16_t*)(p.ws + OFF_O) + (size_t)(b * SEQ + q0 + wave * 16 + ll) * DM + O_SB + h * 64 + 4 * qd;
#pragma unroll
    for (int c = 0; c < 4; ++c) { u32x2 o; o.x = pk2(oacc[c][0], oacc[c][1]); o.y = pk2(oacc[c][2], oacc[c][3]); *(u32x2*)(op + 16 * c) = o; }
    __syncthreads();
}

__device__ __forceinline__ void dil_task(const Params& p, int l, LAS unsigned char* lds, int pat, int task) {
    constexpr int RS = 72, VTS = 268;
    const int tid = TIDX, wave = tid >> 6, lane = tid & 63, ll = lane & 15, qd = lane >> 4;
    const int dil = pat == 0 ? 1 : (pat == 1 ? 4 : 16), nb = (SEQ / dil) / 128;
    const int n = task % nb, r = (task / nb) % dil, bh = task / (nb * dil), b = bh >> 2, h = bh & 3;
    const bf16_t* base = (const bf16_t*)(p.ws + OFF_B) + (size_t)b * SEQ * NP;
    LAS bf16_t* qs = (LAS bf16_t*)lds;
    LAS bf16_t* ks = qs + 128 * RS;
    LAS bf16_t* vt = ks + 256 * RS;
    LAS float* gq = (LAS float*)(vt + 64 * VTS);
    if (tid < 128) gq[tid] = tid < 64 ? p.dil_q_g[l * 64 + tid] : p.dil_k_g[l * 64 + tid - 64];
    bf16x8 vreg[2][2];
#pragma unroll
    for (int ps = 0; ps < 2; ++ps) { const int kj = 2 * (ps * 64 + (tid >> 3)), idx = n * 128 - 128 + kj;
        vreg[ps][0] = (bf16x8){0, 0, 0, 0, 0, 0, 0, 0}; vreg[ps][1] = (bf16x8){0, 0, 0, 0, 0, 0, 0, 0};
        if (idx >= 0) { const bf16_t* vp = base + (size_t)(idx * dil + r) * NP + C_LV + h * 64 + (tid & 7) * 8; vreg[ps][0] = *(const bf16x8*)vp; vreg[ps][1] = *(const bf16x8*)(vp + (size_t)dil * NP); } }
    __syncthreads();
    if (tid < 384) {
        const bool isq = tid < 128; const int idx = isq ? n * 128 + tid : n * 128 - 128 + (tid - 128);
        LAS bf16_t* dst = isq ? qs + tid * RS : ks + (tid - 128) * RS;
        if (idx >= 0) {
            const int pos = idx * dil + r;
            const bf16_t* src = base + (size_t)pos * NP + (isq ? C_LQ : C_LK) + h * 64;
            float xv[64]; float ss = 0.f;
#pragma unroll
            for (int c8 = 0; c8 < 8; ++c8) { const u32x4 u = *(const u32x4*)(src + c8 * 8);
                xv[c8 * 8 + 0] = bflo(u.x); xv[c8 * 8 + 1] = bfhi(u.x); xv[c8 * 8 + 2] = bflo(u.y); xv[c8 * 8 + 3] = bfhi(u.y);
                xv[c8 * 8 + 4] = bflo(u.z); xv[c8 * 8 + 5] = bfhi(u.z); xv[c8 * 8 + 6] = bflo(u.w); xv[c8 * 8 + 7] = bfhi(u.w); }
#pragma unroll
            for (int c = 0; c < 64; ++c) ss += xv[c] * xv[c];
            const float rstd = rsqrtf(ss * (1.f / 64.f) + EPS);
            const LAS float* gg = gq + (isq ? 0 : 64);
#pragma unroll
            for (int c = 0; c < 64; ++c) xv[c] = xv[c] * rstd * gg[c];
#pragma unroll
            for (int i = 0; i < 8; ++i) {
                const float invf = exp2f(-(float)i * (18.931568569324174f / 8.f));
                const float ang = (float)pos * invf;
                double rev = (double)ang * 0.15915494309189535; rev -= rint(rev);
                const float a2 = (float)(rev * 6.283185307179586);
                const float cs = __cosf(a2), sn = __sinf(a2);
                const float x1 = xv[i], x2 = xv[i + 8]; xv[i] = x1 * cs - x2 * sn; xv[i + 8] = x2 * cs + x1 * sn;
            }
#pragma unroll
            for (int c8 = 0; c8 < 8; ++c8) { u32x4 o; o.x = pk2(xv[c8 * 8], xv[c8 * 8 + 1]); o.y = pk2(xv[c8 * 8 + 2], xv[c8 * 8 + 3]); o.z = pk2(xv[c8 * 8 + 4], xv[c8 * 8 + 5]); o.w = pk2(xv[c8 * 8 + 6], xv[c8 * 8 + 7]);
                *(LAS u32x4*)(dst + c8 * 8) = o; }
        } else {
#pragma unroll
            for (int c8 = 0; c8 < 8; ++c8) *(LAS u32x4*)(dst + c8 * 8) = (u32x4){0u, 0u, 0u, 0u};
        }
    }
    {
#pragma unroll
        for (int ps = 0; ps < 2; ++ps) { const int kj = 2 * (ps * 64 + (tid >> 3));
#pragma unroll
            for (int e = 0; e < 8; ++e) *(LAS unsigned*)(vt + ((tid & 7) * 8 + e) * VTS + kj) = (unsigned)(unsigned short)vreg[ps][0][e] | ((unsigned)(unsigned short)vreg[ps][1][e] << 16); }
    }
    __syncthreads();
    const size_t tok = (size_t)b * SEQ + (size_t)(n * 128 + 16 * wave + ll) * dil + r;
    bf16_t* op = (bf16_t*)(p.ws + OFF_O) + tok * DM + O_DIL + h * 64 + 4 * qd;
    float* st = (float*)(p.ws + OFF_DSTAT) + (tok * 4 + h) * 2;
    u32x2 pv[4]; float mo = 0.f, dd = 0.f;
    if (pat > 0) { mo = st[0]; dd = st[1];
#pragma unroll
        for (int c = 0; c < 4; ++c) pv[c] = *(const u32x2*)(op + 16 * c); }
    bf16x8 qf[2];
#pragma unroll
    for (int k2 = 0; k2 < 2; ++k2) qf[k2] = *(const LAS bf16x8*)(qs + (16 * wave + ll) * RS + k2 * 32 + qd * 8);
    f32x4 s[10]; float mx = -INFINITY;
    {   bf16x8 kf[10][2];
#pragma unroll
        for (int gi = 0; gi < 10; ++gi) { const int g = wave + gi, gc = g < 16 ? g : 15;
#pragma unroll
            for (int k2 = 0; k2 < 2; ++k2) kf[gi][k2] = *(const LAS bf16x8*)(ks + (16 * gc + ll) * RS + k2 * 32 + qd * 8); }
        __builtin_amdgcn_sched_barrier(0);
#pragma unroll
        for (int gi = 0; gi < 10; ++gi) { s[gi] = (f32x4){0.f, 0.f, 0.f, 0.f};
#pragma unroll
            for (int k2 = 0; k2 < 2; ++k2) s[gi] = MFMA16(kf[gi][k2], qf[k2], s[gi]); }
    }
#pragma unroll
    for (int gi = 0; gi < 10; ++gi) {
        const int g = wave + gi;
#pragma unroll
        for (int rr = 0; rr < 4; ++rr) { const int kj = 16 * g + 4 * qd + rr, m = (16 * wave + ll) + 128 - kj;
            const bool valid = (g < 16) && (m >= 0) && (m <= 128) && (n * 128 - 128 + kj >= 0);
            const float v = valid ? s[gi][rr] * 0.125f : -INFINITY; s[gi][rr] = v; mx = fmaxf(mx, v); }
    }
    mx = fmaxf(mx, __shfl_xor(mx, 16)); mx = fmaxf(mx, __shfl_xor(mx, 32));
    float den = 0.f; bf16x8 pf[5];
#pragma unroll
    for (int gi = 0; gi < 10; ++gi)
#pragma unroll
        for (int rr = 0; rr < 4; ++rr) { const float e = __expf(s[gi][rr] - mx); s[gi][rr] = e; den += e; }
    den += __shfl_xor(den, 16); den += __shfl_xor(den, 32);
#pragma unroll
    for (int g2 = 0; g2 < 5; ++g2) pf[g2] = pk8(s[2 * g2], s[2 * g2 + 1]);
    f32x4 oacc[4];
    {   bf16x8 af[4][5];
#pragma unroll
        for (int c = 0; c < 4; ++c)
#pragma unroll
            for (int g2 = 0; g2 < 5; ++g2) {
                const int ga = wave + 2 * g2, gb = ga + 1, gac = ga < 16 ? ga : 15, gbc = gb < 16 ? gb : 15;
                const LAS bf16_t* vr = vt + (16 * c + ll) * VTS + 4 * qd;
                af[c][g2] = mk8(*(const LAS u32x2*)(vr + 16 * gac), *(const LAS u32x2*)(vr + 16 * gbc)); }
        __builtin_amdgcn_sched_barrier(0);
#pragma unroll
        for (int c = 0; c < 4; ++c) { oacc[c] = (f32x4){0.f, 0.f, 0.f, 0.f};
#pragma unroll
            for (int g2 = 0; g2 < 5; ++g2) oacc[c] = MFMA16(af[c][g2], pf[g2], oacc[c]); }
    }
    float wa = 0.f, wb = 1.f, D = den, M = mx;
    if (pat > 0) { M = fmaxf(mo, mx); wa = dd * __expf(mo - M); wb = __expf(mx - M); D = wa + den * wb; }
    const float inv = __builtin_amdgcn_rcpf(D);
#pragma unroll
    for (int c = 0; c < 4; ++c) { f32x4 o = oacc[c] * wb;
        if (pat > 0) { const u32x2 u = pv[c]; o[0] += wa * bflo(u.x); o[1] += wa * bfhi(u.x); o[2] += wa * bflo(u.y); o[3] += wa * bfhi(u.y); }
        u32x2 q; q.x = pk2(o[0] * inv, o[1] * inv); q.y = pk2(o[2] * inv, o[3] * inv); *(u32x2*)(op + 16 * c) = q; }
    if (pat < 2 && qd == 0) { st[0] = M; st[1] = D; }
    __syncthreads();
}

__device__ __forceinline__ void gla_load(const Params& p, int l, const bf16_t* prow  , int h, LAS float* qL, LAS float* kL, LAS float* bL, LAS float* lrL, LAS float* w2L) {
    const int tid = TIDX;
    if (tid < 128) { const int t = tid >> 1, c8 = (tid & 1) * 8; const u32x4 u = *(const u32x4*)(prow + (size_t)t * NP + C_GLR + c8); LAS float* d = lrL + t * 16 + c8;
        d[0] = bflo(u.x); d[1] = bfhi(u.x); d[2] = bflo(u.y); d[3] = bfhi(u.y); d[4] = bflo(u.z); d[5] = bfhi(u.z); d[6] = bflo(u.w); d[7] = bfhi(u.w); }
    { const int j = tid >> 5, c = tid & 31; w2L[tid] = p.gla_w_lr2[(size_t)l * 16 * 128 + j * 128 + h * 32 + c]; }
    if (tid < 32) w2L[512 + tid] = p.gla_b_lr[l * 128 + h * 32 + tid];
    { const int isk = tid >> 8, t = (tid & 255) >> 2, c8 = (tid & 3) * 8; const u32x4 u = *(const u32x4*)(prow + (size_t)t * NP + (isk ? C_GK : C_GQ) + h * 32 + c8);
        const float sc = isk ? 1.f : 0.17677669529663687f; LAS float* d = (isk ? kL : qL) + t * 33 + c8;
        d[0] = bflo(u.x) * sc; d[1] = bfhi(u.x) * sc; d[2] = bflo(u.y) * sc; d[3] = bfhi(u.y) * sc; d[4] = bflo(u.z) * sc; d[5] = bfhi(u.z) * sc; d[6] = bflo(u.w) * sc; d[7] = bfhi(u.w) * sc; }
    __syncthreads();
    for (int i = tid; i < 64 * 32; i += 512) { const int t = i >> 5, c = i & 31; float a = w2L[512 + c];
#pragma unroll
        for (int j = 0; j < 16; ++j) a += lrL[t * 16 + j] * w2L[j * 32 + c];
        bL[t * 33 + c] = -softplusf_(-a) * (1.f / 16.f); }
    __syncthreads();
    {
        const int wv = tid >> 6, ln = tid & 63;
#pragma unroll
        for (int q = 0; q < 4; ++q) { const int c = wv * 4 + q; float v = bL[ln * 33 + c];
#pragma unroll
            for (int o = 1; o < 64; o <<= 1) { const float u = __shfl_up(v, o); if (ln >= o) v += u; }
            bL[ln * 33 + c] = v; }
    }
    __syncthreads();
}
__device__ __forceinline__ void gla_a_task(const Params& p, int l, LAS unsigned char* lds, int task) {
    const int tid = TIDX, wave = tid >> 6, lane = tid & 63, ll = lane & 15, qd = lane >> 4, bh = task >> 8, ch = task & 255, b = bh >> 2, h = bh & 3;
    const bf16_t* prow = (const bf16_t*)(p.ws + OFF_B) + ((size_t)b * SEQ + ch * 64) * NP;
    LAS float* qL = (LAS float*)lds; LAS float* kL = qL + 64 * 33; LAS float* bL = kL + 64 * 33; LAS float* lrL = bL + 64 * 33; LAS float* w2L = lrL + 1024;
    LAS bf16_t* vt = (LAS bf16_t*)(w2L + 576);
    LAS bf16_t* kT = vt + 64 * 72;
    { const int tp = tid >> 4, c4 = (tid & 15) * 4;
      const u32x2 u0 = *(const u32x2*)(prow + (size_t)(2 * tp) * NP + C_GV + h * 64 + c4), u1 = *(const u32x2*)(prow + (size_t)(2 * tp + 1) * NP + C_GV + h * 64 + c4);
      *(LAS unsigned*)(vt + (c4 + 0) * 72 + 2 * tp) = (u0.x & 0xffffu) | (u1.x << 16); *(LAS unsigned*)(vt + (c4 + 1) * 72 + 2 * tp) = (u0.x >> 16) | (u1.x & 0xffff0000u);
      *(LAS unsigned*)(vt + (c4 + 2) * 72 + 2 * tp) = (u0.y & 0xffffu) | (u1.y << 16); *(LAS unsigned*)(vt + (c4 + 3) * 72 + 2 * tp) = (u0.y >> 16) | (u1.y & 0xffff0000u); }
    gla_load(p, l, prow, h, qL, kL, bL, lrL, w2L);
    { const int c = tid >> 4, t4 = (tid & 15) * 4; const float bl = bL[63 * 33 + c]; float kv[4];
#pragma unroll
      for (int e = 0; e < 4; ++e) kv[e] = kL[(t4 + e) * 33 + c] * __expf(bl - bL[(t4 + e) * 33 + c]);
      *(LAS unsigned*)(kT + c * 72 + t4) = pk2(kv[0], kv[1]); *(LAS unsigned*)(kT + c * 72 + t4 + 2) = pk2(kv[2], kv[3]); }
    __syncthreads();
    const int ct = wave >> 2, dt = wave & 3; f32x4 acc = {0.f, 0.f, 0.f, 0.f};
#pragma unroll
    for (int k2 = 0; k2 < 2; ++k2) acc = MFMA16(*(const LAS bf16x8*)(kT + (16 * ct + ll) * 72 + k2 * 32 + qd * 8), *(const LAS bf16x8*)(vt + (16 * dt + ll) * 72 + k2 * 32 + qd * 8), acc);
    float* U = (float*)(p.ws + OFF_GLAU) + (size_t)task * 2048;
#pragma unroll
    for (int r = 0; r < 4; ++r) U[(16 * ct + 4 * qd + r) * 64 + 16 * dt + ll] = acc[r];
    if (tid < 32) ((float*)(p.ws + OFF_GLAA))[(size_t)task * 32 + tid] = __expf(bL[63 * 33 + tid]);
    __syncthreads();
}
__device__ __forceinline__ void gla_scan_task(const Params& p, LAS unsigned char* lds, int task, unsigned* ready) {
    const int tid = TIDX, bh = task >> 2, qt = task & 3, e = qt * 512 + tid, cl = tid >> 6;
    float* U = (float*)(p.ws + OFF_GLAU) + (size_t)bh * 256 * 2048 + e;
    const float* A = (const float*)(p.ws + OFF_GLAA) + (size_t)bh * 256 * 32 + qt * 8;
    LAS float* aL = (LAS float*)lds;
#pragma unroll
    for (int k = 0; k < 4; ++k) { const int idx = tid + 512 * k; aL[idx] = A[(idx >> 3) * 32 + (idx & 7)]; }
    __syncthreads();
    float st = 0.f;
    for (int n0 = 0; n0 < 256; n0 += 16) {
        float u[16];
#pragma unroll
        for (int k = 0; k < 16; ++k) u[k] = U[(size_t)(n0 + k) * 2048];
#pragma unroll
        for (int k = 0; k < 16; ++k) { U[(size_t)(n0 + k) * 2048] = st; st = aL[(n0 + k) * 8 + cl] * st + u[k]; }
    }
    asm volatile("s_waitcnt vmcnt(0)" ::: "memory");
    __syncthreads();
    if (tid == 0) { __builtin_amdgcn_fence(__ATOMIC_RELEASE, "agent"); asm volatile("s_waitcnt vmcnt(0)" ::: "memory");
        __hip_atomic_fetch_add(ready, 1u, __ATOMIC_RELAXED, __HIP_MEMORY_SCOPE_AGENT); }
    __syncthreads();
}
__device__ __forceinline__ void gla_c_task(const Params& p, int l, LAS unsigned char* lds, int task, unsigned* ready) {
    const int tid = TIDX, wave = tid >> 6, lane = tid & 63, ll = lane & 15, qd = lane >> 4, bh = task >> 8, ch = task & 255, b = bh >> 2, h = bh & 3;
    if (tid == 0) {
        unsigned sp = 0; while (__hip_atomic_load(ready + bh, __ATOMIC_RELAXED, __HIP_MEMORY_SCOPE_AGENT) < 4u && ++sp < (1u << 24)) __builtin_amdgcn_s_sleep(2);
        __builtin_amdgcn_fence(__ATOMIC_ACQUIRE, "agent"); asm volatile("s_waitcnt vmcnt(0)" ::: "memory"); }
    __syncthreads();
    const bf16_t* prow = (const bf16_t*)(p.ws + OFF_B) + ((size_t)b * SEQ + ch * 64) * NP;
    LAS float* qL = (LAS float*)lds; LAS float* kL = qL + 64 * 33; LAS float* bL = kL + 64 * 33; LAS float* lrL = bL + 64 * 33; LAS float* w2L = lrL + 1024;
    LAS float* ssL = w2L + 576;
    LAS bf16_t* vt = (LAS bf16_t*)(ssL + 512);
    LAS bf16_t* sT = vt + 64 * 72;
    { const int tp = tid >> 4, c4 = (tid & 15) * 4;
      const u32x2 u0 = *(const u32x2*)(prow + (size_t)(2 * tp) * NP + C_GV + h * 64 + c4), u1 = *(const u32x2*)(prow + (size_t)(2 * tp + 1) * NP + C_GV + h * 64 + c4);
      *(LAS unsigned*)(vt + (c4 + 0) * 72 + 2 * tp) = (u0.x & 0xffffu) | (u1.x << 16); *(LAS unsigned*)(vt + (c4 + 1) * 72 + 2 * tp) = (u0.x >> 16) | (u1.x & 0xffff0000u);
      *(LAS unsigned*)(vt + (c4 + 2) * 72 + 2 * tp) = (u0.y & 0xffffu) | (u1.y << 16); *(LAS unsigned*)(vt + (c4 + 3) * 72 + 2 * tp) = (u0.y >> 16) | (u1.y & 0xffff0000u); }
    { const float* U = (const float*)(p.ws + OFF_GLAU) + (size_t)task * 2048; const int c = tid >> 4, d4 = (tid & 15) * 4; const f32x4 u = *(const f32x4*)(U + c * 64 + d4);
#pragma unroll
      for (int e = 0; e < 4; ++e) sT[(d4 + e) * 40 + c] = f2bf(u[e]); }
    const int I = wave >> 1, dh = wave & 1, t = 16 * I + ll;
    u32x2 rgl[2];
#pragma unroll
    for (int cc = 0; cc < 2; ++cc) rgl[cc] = *(const u32x2*)(prow + (size_t)t * NP + C_GR + h * 64 + 16 * (2 * dh + cc) + 4 * qd);
    gla_load(p, l, prow, h, qL, kL, bL, lrL, w2L);
    float qv[8], bt[8], rI[8];
#pragma unroll
    for (int e = 0; e < 8; ++e) { qv[e] = qL[t * 33 + 8 * qd + e]; bt[e] = bL[t * 33 + 8 * qd + e]; rI[e] = I > 0 ? bL[(16 * I - 1) * 33 + 8 * qd + e] : 0.f; }
    f32x4 qa, qb2, qc, qd2;
#pragma unroll
    for (int e = 0; e < 4; ++e) { qa[e] = qv[e] * __expf(bt[e] - rI[e]); qb2[e] = qv[4 + e] * __expf(bt[4 + e] - rI[4 + e]); qc[e] = qv[e] * __expf(bt[e]); qd2[e] = qv[4 + e] * __expf(bt[4 + e]); }
    const bf16x8 qfI = pk8(qa, qb2), qfin = pk8(qc, qd2);
    f32x4 at[4];
#pragma unroll
    for (int J = 0; J < 4; ++J) { at[J] = (f32x4){0.f, 0.f, 0.f, 0.f};
        if (J < I) { const int j = 16 * J + ll; f32x4 ka, kb2;
#pragma unroll
            for (int e = 0; e < 4; ++e) { ka[e] = kL[j * 33 + 8 * qd + e] * __expf(rI[e] - bL[j * 33 + 8 * qd + e]); kb2[e] = kL[j * 33 + 8 * qd + 4 + e] * __expf(rI[4 + e] - bL[j * 33 + 8 * qd + 4 + e]); }
            at[J] = MFMA16(pk8(ka, kb2), qfI, at[J]); } }
    {
        f32x4 dsum = {0.f, 0.f, 0.f, 0.f};
#pragma unroll 8
        for (int c = 0; c < 32; ++c) { const float q_ = qL[t * 33 + c], b_ = bL[t * 33 + c];
#pragma unroll
            for (int r = 0; r < 4; ++r) { const int j = 16 * I + 4 * qd + r; dsum[r] += q_ * kL[j * 33 + c] * __expf(fminf(b_ - bL[j * 33 + c], 0.f)); } }
#pragma unroll
        for (int r = 0; r < 4; ++r) dsum[r] = (4 * qd + r <= ll) ? dsum[r] : 0.f;
#pragma unroll
        for (int J = 0; J < 4; ++J) if (J == I) at[J] = dsum;
    }
    bf16x8 pf[2]; pf[0] = pk8(at[0], at[1]); pf[1] = pk8(at[2], at[3]);
    f32x4 oacc[2]; float ss = 0.f;
#pragma unroll
    for (int cc = 0; cc < 2; ++cc) { const int cg = 2 * dh + cc; f32x4 acc = {0.f, 0.f, 0.f, 0.f};
#pragma unroll
        for (int g2 = 0; g2 < 2; ++g2) { const LAS bf16_t* vr = vt + (16 * cg + ll) * 72 + 32 * g2 + 4 * qd; acc = MFMA16(mk8(*(const LAS u32x2*)vr, *(const LAS u32x2*)(vr + 16)), pf[g2], acc); }
        acc = MFMA16(*(const LAS bf16x8*)(sT + (16 * cg + ll) * 40 + 8 * qd), qfin, acc);
        oacc[cc] = acc; ss += acc[0] * acc[0] + acc[1] * acc[1] + acc[2] * acc[2] + acc[3] * acc[3]; }
    ssL[t * 8 + dh * 4 + qd] = ss;
    __syncthreads();
    float tot = 0.f;
#pragma unroll
    for (int e = 0; e < 8; ++e) tot += ssL[t * 8 + e];
    const float rstd = rsqrtf(tot * (1.f / 64.f) + EPS);
#pragma unroll
    for (int cc = 0; cc < 2; ++cc) { const int d = 16 * (2 * dh + cc) + 4 * qd;
        const u32x2 rg = rgl[cc];
        const float rr[4] = {bflo(rg.x), bfhi(rg.x), bflo(rg.y), bfhi(rg.y)}; float ov[4];
#pragma unroll
        for (int e = 0; e < 4; ++e) ov[e] = oacc[cc][e] * rstd * p.gla_norm_g[l * 64 + d + e] * rr[e] * sigmoidf_(rr[e]);
        u32x2 o; o.x = pk2(ov[0], ov[1]); o.y = pk2(ov[2], ov[3]);
        *(u32x2*)((bf16_t*)(p.ws + OFF_O) + ((size_t)b * SEQ + ch * 64 + t) * DM + O_GLA + h * 64 + d) = o; }
    __syncthreads();
}

__device__ __forceinline__ void dn_prep_task(const Params& p, int l, LAS unsigned char* lds, int task) {
    const int tid = TIDX, bh = task >> 8, ch = task & 255, b = bh >> 2, h = bh & 3, t0 = ch * 64;
    const bf16_t* pb = (const bf16_t*)(p.ws + OFF_B) + (size_t)b * SEQ * NP;
    LAS float* qn = (LAS float*)lds; LAS float* kn = qn + 64 * 65; LAS float* vv = kn + 64 * 65; LAS float* Lw = vv + 64 * 65; LAS float* X = Lw + 64 * 65;
    LAS float* Gc = X + 64 * 129; LAS float* be = Gc + 64;
    LAS bf16_t* qb = (LAS bf16_t*)(be + 64); LAS bf16_t* kb = qb + 64 * 72;
    bf16_t graw_a = 0, graw_b = 0;
    if (tid < 64) { const bf16_t* pr0 = pb + (size_t)(t0 + tid) * NP; graw_a = pr0[C_DA + h]; graw_b = pr0[C_DB + h]; }
    {
        LAS float* cwL = (LAS float*)(kb + 64 * 72);
        if (tid < 192) *(LAS f32x4*)(cwL + tid * 4) = *(const f32x4*)(p.dn_conv_w + ((size_t)l * 768 + (tid >> 6) * 256 + h * 64 + (tid & 63)) * 4);
        u32x4 xd[3][4];
#pragma unroll
        for (int it = 0; it < 3; ++it) { const int q = tid + 512 * it, t = q / 24, cc8 = (q % 24) * 8, chg = (cc8 >> 6) * 256 + h * 64 + (cc8 & 63);
#pragma unroll
            for (int i = 0; i < 4; ++i) { const int tt = t0 + t - 3 + i; xd[it][i] = tt >= 0 ? *(const u32x4*)(pb + (size_t)tt * NP + C_DQKV + chg) : (u32x4){0u, 0u, 0u, 0u}; } }
        __syncthreads();
#pragma unroll
        for (int it = 0; it < 3; ++it) { const int q = tid + 512 * it, t = q / 24, cc8 = (q % 24) * 8, sec = cc8 >> 6, c = cc8 & 63;
            float acc[8];
#pragma unroll
            for (int e = 0; e < 8; ++e) acc[e] = 0.f;
#pragma unroll
            for (int i = 0; i < 4; ++i) { const u32x4 u = xd[it][i]; const float xs[8] = {bflo(u.x), bfhi(u.x), bflo(u.y), bfhi(u.y), bflo(u.z), bfhi(u.z), bflo(u.w), bfhi(u.w)};
#pragma unroll
                for (int e = 0; e < 8; ++e) acc[e] += cwL[(cc8 + e) * 4 + i] * xs[e]; }
            LAS float* dst = (sec == 0 ? qn : (sec == 1 ? kn : vv)) + t * 65 + c;
#pragma unroll
            for (int e = 0; e < 8; ++e) dst[e] = acc[e] * sigmoidf_(acc[e]); }
    }
    __syncthreads();
    { LAS float* row = ((tid >> 2) < 64 ? qn : kn) + ((tid >> 2) & 63) * 65 + (tid & 3) * 16; float ss = 0.f;
#pragma unroll
        for (int c = 0; c < 16; ++c) ss += row[c] * row[c];
        ss += __shfl_xor(ss, 1); ss += __shfl_xor(ss, 2);
        const float sc = rsqrtf(ss + EPS) * ((tid >> 2) < 64 ? 0.125f : 1.f);
        LAS bf16_t* rb = ((tid >> 2) < 64 ? qb : kb) + ((tid >> 2) & 63) * 72 + (tid & 3) * 16;
#pragma unroll
        for (int c = 0; c < 16; c += 2) { const float v0 = row[c] * sc, v1 = row[c + 1] * sc; row[c] = v0; row[c + 1] = v1; *(LAS unsigned*)(rb + c) = pk2(v0, v1); } }
    if (tid < 64) {
        be[tid] = sigmoidf_(bf2f(graw_b));
        float g = -__expf(p.dn_a_log[l * 4 + h]) * softplusf_(bf2f(graw_a) + p.dn_dt_bias[l * 4 + h]);
#pragma unroll
        for (int o = 1; o < 64; o <<= 1) { const float v = __shfl_up(g, o); if (tid >= o) g += v; }
        Gc[tid] = g; }
    __syncthreads();
    bf16_t* ob = (bf16_t*)(p.ws + OFF_DN) + (size_t)task * 5 * 4096;
    {
        const int wave = tid >> 6, lane = tid & 63, ll = lane & 15, qd = lane >> 4, ti = wave >> 1;
#pragma unroll
        for (int tt = 0; tt < 2; ++tt) { const int tj = (wave & 1) * 2 + tt;
            f32x4 ck = {0.f, 0.f, 0.f, 0.f}, cs = {0.f, 0.f, 0.f, 0.f};
            if (tj <= ti) {
#pragma unroll
                for (int k2 = 0; k2 < 2; ++k2) {
                    const bf16x8 ki = *(const LAS bf16x8*)(kb + (16 * ti + ll) * 72 + k2 * 32 + qd * 8), kj = *(const LAS bf16x8*)(kb + (16 * tj + ll) * 72 + k2 * 32 + qd * 8);
                    const bf16x8 qi = *(const LAS bf16x8*)(qb + (16 * ti + ll) * 72 + k2 * 32 + qd * 8);
                    ck = MFMA16(ki, kj, ck);
                    cs = MFMA16(kj, qi, cs);
                } }
#pragma unroll
            for (int r = 0; r < 4; ++r) { const int i = 16 * ti + 4 * qd + r, j = 16 * tj + ll;
                Lw[i * 65 + j] = j < i ? be[i] * ck[r] * __expf(Gc[i] - Gc[j]) : 0.f; }
            { const int i = 16 * ti + ll; float sv[4];
#pragma unroll
              for (int r = 0; r < 4; ++r) { const int j = 16 * tj + 4 * qd + r; sv[r] = j <= i ? cs[r] * __expf(Gc[i] - Gc[j]) : 0.f; }
              u32x2 o; o.x = pk2(sv[0], sv[1]); o.y = pk2(sv[2], sv[3]); *(u32x2*)(ob + 4 * 4096 + i * 64 + 16 * tj + 4 * qd) = o; }
        }
    }
    for (int idx = tid; idx < 4096; idx += 512) { const int i = idx >> 6, j = idx & 63;
        X[i * 129 + j] = vv[i * 65 + j] * be[i]; X[i * 129 + 64 + j] = kn[i * 65 + j] * be[i] * __expf(Gc[i]); }
    __syncthreads();
    {
        const int col = tid >> 2, part = tid & 3;
        float xr[16];
#pragma unroll
        for (int k = 0; k < 16; ++k) xr[k] = 0.f;
#pragma unroll
        for (int i = 0; i < 64; ++i) { float s0 = 0.f, s1 = 0.f;
#pragma unroll
            for (int k = 0; k < (i + 3) / 4; ++k) { const float t_ = Lw[i * 65 + 4 * k + part] * xr[k]; if (k & 1) s1 += t_; else s0 += t_; }
            s0 += s1; s0 += __shfl_xor(s0, 1); s0 += __shfl_xor(s0, 2);
            const float xi = X[i * 129 + col] - s0;
            if (part == (i & 3)) xr[i >> 2] = xi; }
#pragma unroll
        for (int k = 0; k < 16; ++k) X[(4 * k + part) * 129 + col] = xr[k];
    }
    __syncthreads();
    const float Gl = Gc[63];
    for (int i2 = tid; i2 < 2048; i2 += 512) { const int a = i2 >> 5, c = (i2 & 31) * 2;
        *(unsigned*)(ob + 0 * 4096 + a * 64 + c) = pk2(X[a * 129 + 64 + c], X[a * 129 + 65 + c]);
        *(unsigned*)(ob + 1 * 4096 + a * 64 + c) = pk2(kn[c * 65 + a] * __expf(Gl - Gc[c]), kn[(c + 1) * 65 + a] * __expf(Gl - Gc[c + 1]));
        *(unsigned*)(ob + 2 * 4096 + a * 64 + c) = pk2(X[c * 129 + a], X[(c + 1) * 129 + a]);
        const float eg = __expf(Gc[a]);
        *(unsigned*)(ob + 3 * 4096 + a * 64 + c) = pk2(qn[a * 65 + c] * eg, qn[a * 65 + c + 1] * eg); }
    if (tid == 0) ((float*)(p.ws + OFF_DNA))[task] = __expf(Gl);
    __syncthreads();
}
__device__ __forceinline__ void dn_scan_task(const Params& p, int l, LAS unsigned char* lds, int task) {
    constexpr int RS = 72, MATB = 64 * RS * 2  , STG = 4 * MATB + 16 * RS * 2;
    const int tid = TIDX, wave = tid >> 6, lane = tid & 63, ll = lane & 15, qd = lane >> 4, bh = task >> 2, b = bh >> 2, h = bh & 3;
    const bf16_t* cb = (const bf16_t*)(p.ws + OFF_DN) + (size_t)bh * 256 * 5 * 4096;
    const float* al = (const float*)(p.ws + OFF_DNA) + bh * 256;
    const int lrow = tid >> 3, lc8 = tid & 7;
    LAS float* alL = (LAS float*)(lds + 3 * STG);
    if (tid < 256) alL[tid] = al[tid];
    u32x4 pre[3][5];
    const int d0 = (task & 3) * 16;
#define DN_ISSUE(n, st) do { const int n_ = (n) < 255 ? (n) : 255; _Pragma("unroll") for (int m_ = 0; m_ < 4; ++m_) pre[st][m_] = *(const u32x4*)(cb + ((size_t)n_ * 5 + (m_ < 2 ? m_ : m_ + 1)) * 4096 + tid * 8); \
        pre[st][4] = *(const u32x4*)(cb + ((size_t)n_ * 5 + 2) * 4096 + d0 * 64 + (tid & 127) * 8); } while (0)
#define DN_COMMIT(st) do { LAS unsigned char* sb_ = lds + (st) * STG; _Pragma("unroll") for (int m_ = 0; m_ < 4; ++m_) *(LAS u32x4*)(sb_ + m_ * MATB + lrow * (RS * 2) + lc8 * 16) = pre[st][m_]; \
        if (tid < 128) *(LAS u32x4*)(sb_ + 4 * MATB + lrow * (RS * 2) + lc8 * 16) = pre[st][4]; } while (0)
    DN_ISSUE(0, 0); DN_ISSUE(1, 1); DN_COMMIT(0); DN_COMMIT(1); DN_ISSUE(2, 2); DN_ISSUE(3, 0); DN_ISSUE(4, 1);
    f32x4 S[4];
#pragma unroll
    for (int m = 0; m < 4; ++m) S[m] = (f32x4){0.f, 0.f, 0.f, 0.f};
    __syncthreads();
#define DN_FRAG(mat, mt, k2) ({ const LAS bf16_t* _r = (const LAS bf16_t*)(sb + (mat) * MATB) + (16 * (mt) + ll) * RS + 32 * (k2) + 4 * qd; mk8(*(const LAS u32x2*)_r, *(const LAS u32x2*)(_r + 16)); })
#define DN_STEP(n, st) do { \
        DN_COMMIT(((st) + 2) % 3); \
        DN_ISSUE((n) + 5, ((st) + 2) % 3); \
        if (wave < 1) { \
            const LAS unsigned char* sb = lds + (st) * STG; \
              \
            u32x2 uc[4]; bf16x8 fw[4][2], fk[4][2], fq[4][2], fs[4][2]; \
            _Pragma("unroll") for (int m = 0; m < 4; ++m) _Pragma("unroll") for (int k2 = 0; k2 < 2; ++k2) fw[m][k2] = DN_FRAG(0, m, k2); \
            _Pragma("unroll") for (int m = 0; m < 4; ++m) uc[m] = *(const LAS u32x2*)((const LAS bf16_t*)(sb + 4 * MATB) + ll * RS + 16 * m + 4 * qd); \
            _Pragma("unroll") for (int m = 0; m < 4; ++m) _Pragma("unroll") for (int k2 = 0; k2 < 2; ++k2) fk[m][k2] = DN_FRAG(1, m, k2); \
            const float a = alL[n]; \
            __builtin_amdgcn_sched_barrier(0); \
            bf16x8 Sb[2], Vb[2]; \
            Sb[0] = pk8(S[0], S[1]); Sb[1] = pk8(S[2], S[3]); \
            f32x4 vn[4], oo[4]; \
            _Pragma("unroll") for (int m = 0; m < 4; ++m) { f32x4 acc = {0.f, 0.f, 0.f, 0.f}; \
                _Pragma("unroll") for (int k2 = 0; k2 < 2; ++k2) acc = MFMA16(fw[m][k2], Sb[k2], acc); \
                vn[m][0] = bflo(uc[m].x) - acc[0]; vn[m][1] = bfhi(uc[m].x) - acc[1]; vn[m][2] = bflo(uc[m].y) - acc[2]; vn[m][3] = bfhi(uc[m].y) - acc[3]; } \
            Vb[0] = pk8(vn[0], vn[1]); Vb[1] = pk8(vn[2], vn[3]); \
            _Pragma("unroll") for (int m = 0; m < 4; ++m) _Pragma("unroll") for (int k2 = 0; k2 < 2; ++k2) { fq[m][k2] = DN_FRAG(2, m, k2); fs[m][k2] = DN_FRAG(3, m, k2); } \
            __builtin_amdgcn_sched_barrier(0); \
            _Pragma("unroll") for (int m = 0; m < 4; ++m) { f32x4 acc = S[m] * a; \
                _Pragma("unroll") for (int k2 = 0; k2 < 2; ++k2) acc = MFMA16(fk[m][k2], Vb[k2], acc); \
                S[m] = acc; } \
            _Pragma("unroll") for (int m = 0; m < 4; ++m) { f32x4 acc = {0.f, 0.f, 0.f, 0.f};   \
                _Pragma("unroll") for (int k2 = 0; k2 < 2; ++k2) { acc = MFMA16(Sb[k2], fq[m][k2], acc); acc = MFMA16(Vb[k2], fs[m][k2], acc); } \
                oo[m] = acc; } \
            bf16_t* op = (bf16_t*)(p.ws + OFF_O) + ((size_t)b * SEQ + (n) * 64 + ll) * DM + O_DN + h * 64 + d0 + 4 * qd; \
            _Pragma("unroll") for (int m = 0; m < 4; ++m) { u32x2 o; o.x = pk2(oo[m][0], oo[m][1]); o.y = pk2(oo[m][2], oo[m][3]); *(u32x2*)(op + (size_t)(16 * m) * DM) = o; } \
        } \
        __syncthreads(); \
    } while (0)
    for (int n = 0; n < 255; n += 3) { DN_STEP(n, 0); DN_STEP(n + 1, 1); DN_STEP(n + 2, 2); }
    DN_STEP(255, 0);
#undef DN_STEP
#undef DN_FRAG
#undef DN_ISSUE
#undef DN_COMMIT
}
__device__ __forceinline__ void dn_norm_task(const Params& p, int l, int task8) {
    const int tid = TIDX, d8 = (tid & 7) * 8;
    u32x4 uu[8], gg[8];
#pragma unroll
    for (int sub = 0; sub < 8; ++sub) { const int pair = (task8 * 8 + sub) * 64 + (tid >> 3), tok = pair >> 2, h = pair & 3;
        uu[sub] = *(const u32x4*)((const bf16_t*)(p.ws + OFF_O) + (size_t)tok * DM + O_DN + h * 64 + d8);
        gg[sub] = *(const u32x4*)((const bf16_t*)(p.ws + OFF_B) + (size_t)tok * NP + C_DG + h * 64 + d8); }
    float gn[8];
#pragma unroll
    for (int e = 0; e < 8; ++e) gn[e] = p.dn_norm_g[l * 64 + d8 + e];
#pragma unroll
    for (int sub = 0; sub < 8; ++sub) { const int pair = (task8 * 8 + sub) * 64 + (tid >> 3), tok = pair >> 2, h = pair & 3;
        const u32x4 u = uu[sub], gt = gg[sub];
        const float ov[8] = {bflo(u.x), bfhi(u.x), bflo(u.y), bfhi(u.y), bflo(u.z), bfhi(u.z), bflo(u.w), bfhi(u.w)};
        const float gv[8] = {bflo(gt.x), bfhi(gt.x), bflo(gt.y), bfhi(gt.y), bflo(gt.z), bfhi(gt.z), bflo(gt.w), bfhi(gt.w)};
        float ss = 0.f;
#pragma unroll
        for (int e = 0; e < 8; ++e) ss += ov[e] * ov[e];
        ss += __shfl_xor(ss, 1); ss += __shfl_xor(ss, 2); ss += __shfl_xor(ss, 4);
        const float rstd = rsqrtf(ss * (1.f / 64.f) + EPS);
        float r[8];
#pragma unroll
        for (int e = 0; e < 8; ++e) r[e] = ov[e] * rstd * gn[e] * gv[e] * sigmoidf_(gv[e]);
        u32x4 o; o.x = pk2(r[0], r[1]); o.y = pk2(r[2], r[3]); o.z = pk2(r[4], r[5]); o.w = pk2(r[6], r[7]);
        *(u32x4*)((bf16_t*)(p.ws + OFF_O) + (size_t)tok * DM + O_DN + h * 64 + d8) = o; }
}

__device__ __forceinline__ int next_task(int* cnt, LAS int* slot, int& pre) {
    __syncthreads();
    if (TIDX == 0) *slot = pre;
    __syncthreads();
    const int t = __builtin_amdgcn_readfirstlane(*slot);
    if (TIDX == 0) pre = atomicAdd(cnt, 1);
    return t;
}
__device__ __forceinline__ void mix_phase(const Params& p, int l, int k, LAS unsigned char* lds) {
    int* cnt = (int*)(p.ws + OFF_CNT) + l * 3 + k;
    LAS int* slot = (LAS int*)(lds + LDS_BYTES + 16);
    int pre = 0; if (TIDX == 0) pre = atomicAdd(cnt, 1);
    unsigned* gready = (unsigned*)(p.ws + OFF_CNT) + 32 + l * 8;
    if (k == 0) {
        for (;;) { int t = next_task(cnt, slot, pre);
            if (t < 2048) { dn_prep_task(p, l, lds, t); continue; } t -= 2048;
            if (t < 1024) { dil_task(p, l, lds, 0, t); continue; } t -= 1024;
            if (t < 2048) { gla_a_task(p, l, lds, t); continue; }
            break; }
    } else if (k == 1) {
        for (;;) { int t = next_task(cnt, slot, pre);
            if (t < 32) { dn_scan_task(p, l, lds, t); continue; } t -= 32;
            if (t < 32) { gla_scan_task(p, lds, t, gready + (t >> 2)); continue; } t -= 32;
            if (t < 1024) { sb_task(p, l, lds, t); continue; } t -= 1024;
            if (t < 1024) { dil_task(p, l, lds, 1, t); continue; } t -= 1024;
            if (t < 2048) { gla_c_task(p, l, lds, t, gready); continue; }
            break; }
    } else {
        for (;;) { int t = next_task(cnt, slot, pre);
            if (t < 1024) { dil_task(p, l, lds, 2, t); continue; } t -= 1024;
            if (t < 256) { dn_norm_task(p, l, t); continue; }
            break; }
    }
}

#define XB_TMO      128
#define XB_XCNT(j)  (256  + 64 * (j))
#define XB_XSUB(j)  (1280 + 64 * (j))
#define XB_XGEN(j)  (2304 + 64 * (j))
#define XB_TOP      3328
#define XB_TOPGEN   3392
#define XCD_BAR_WORDS 3456
#define XB_SPIN_CAP (1u << 22)
__device__ __forceinline__ unsigned xb_ld(unsigned* p)              { return __hip_atomic_load(p, __ATOMIC_RELAXED, __HIP_MEMORY_SCOPE_AGENT); }
__device__ __forceinline__ unsigned xb_add(unsigned* p, unsigned v) { return __hip_atomic_fetch_add(p, v, __ATOMIC_RELAXED, __HIP_MEMORY_SCOPE_AGENT); }
__device__ __forceinline__ unsigned xb_xcc_id() { return (unsigned)__builtin_amdgcn_s_getreg((3 << 11) | 20) & 0xFu; }
#define XB_SPIN(cond, bar) do { unsigned _sp = 0; while (cond) { __builtin_amdgcn_s_sleep(1); \
    if ((++_sp & 255u) == 0u) { if (xb_ld(&(bar)[XB_TMO])) break; if (_sp > XB_SPIN_CAP) { atomicAdd(&(bar)[XB_TMO], 1u); break; } } } } while (0)
struct XcdBarrier { unsigned* bar; unsigned x; volatile LAS unsigned* st; };
__device__ __forceinline__ XcdBarrier xcd_barrier_post(unsigned* bar, volatile LAS unsigned* st) {
    XcdBarrier b; b.bar = bar; b.x = xb_xcc_id(); b.st = st;
    if (TIDX == 0) (void)xb_add(&bar[XB_XCNT(b.x)], 1u);
    return b;
}
__device__ __forceinline__ void xcd_barrier_complete(unsigned* bar, unsigned x, unsigned& nloc, unsigned& nx) {
    const unsigned G = gridDim.x * gridDim.y * gridDim.z;
    unsigned sum, cnt, mine, sp = 0u;
    for (;;) {
        sum = 0u; cnt = 0u; mine = 0u;
#pragma unroll
        for (unsigned j = 0; j < 16; ++j) { const unsigned c = xb_ld(&bar[XB_XCNT(j)]); sum += c; cnt += (c > 0u) ? 1u : 0u; mine = (j == x) ? c : mine; }
        if (sum == G) break;
        __builtin_amdgcn_s_sleep(1);
        if ((++sp & 255u) == 0u) { if (xb_ld(&bar[XB_TMO])) break; if (sp > XB_SPIN_CAP) { atomicAdd(&bar[XB_TMO], 1u); break; } }
    }
    nloc = mine > 0u ? mine : 1u; nx = cnt > 0u ? cnt : 1u;
}
__device__ __forceinline__ void xcd_barrier(const XcdBarrier& b) {
    asm volatile("s_waitcnt vmcnt(0)" ::: "memory");
    __syncthreads();
    if (TIDX == 0) {
        unsigned* bar = b.bar;
        __builtin_amdgcn_s_waitcnt(0);
        unsigned nloc = b.st[0], nx = b.st[1];
        if (nloc == 0u) { xcd_barrier_complete(bar, b.x, nloc, nx); b.st[0] = nloc; b.st[1] = nx; }
        const unsigned old = xb_add(&bar[XB_XSUB(b.x)], 1u);
        const unsigned gen = old / nloc;
        if (old + 1u == (gen + 1u) * nloc) {
            __builtin_amdgcn_fence(__ATOMIC_RELEASE, "agent");
            asm volatile("s_waitcnt vmcnt(0)" ::: "memory");
            const unsigned og = xb_add(&bar[XB_TOP], 1u);
            const unsigned tg = og / nx;
            if (og + 1u == (tg + 1u) * nx) xb_add(&bar[XB_TOPGEN], 1u);
            else XB_SPIN(xb_ld(&bar[XB_TOPGEN]) == tg, bar);
            __builtin_amdgcn_fence(__ATOMIC_ACQUIRE, "agent");
            xb_add(&bar[XB_XGEN(b.x)], 1u);
            asm volatile("s_waitcnt vmcnt(0)" ::: "memory");
        } else {
            XB_SPIN(xb_ld(&bar[XB_XGEN(b.x)]) == gen, bar);
            __builtin_amdgcn_fence(__ATOMIC_ACQUIRE, "agent");
            asm volatile("s_waitcnt vmcnt(0)" ::: "memory");
        }
    }
    __syncthreads();
}

__global__ void __launch_bounds__(512) fwd_kernel(Params p) {
    extern __shared__ __attribute__((aligned(16))) unsigned char shm[];
    LAS unsigned char* lds = (LAS unsigned char*)shm;
    cg::grid_group grid = cg::this_grid();
    unsigned char* ws = p.ws;
    volatile LAS unsigned* bst = (volatile LAS unsigned*)(lds + LDS_BYTES);
    if (TIDX < 2) bst[TIDX] = 0u;
    __syncthreads();
    XcdBarrier gbar; gbar.bar = (unsigned*)(ws + OFF_BAR); gbar.x = 0; gbar.st = bst;
    if (p.ph_hi - p.ph_lo > 1) gbar = xcd_barrier_post((unsigned*)(ws + OFF_BAR), bst);
    if (p.ph_hi > 1000000) grid.sync();
    for (int ph = p.ph_lo; ph < p.ph_hi; ++ph) {
        const int l = ph / NPH, k = ph % NPH;
        const float* xin = (l == 0) ? p.x : p.out;
        if (k == 0) {
            wconv_phase(p, l, lds);
            rmsnorm_phase(xin, p.g_mix + l * DM, (bf16_t*)(ws + OFF_H));
        } else if (k == 8) {
            rmsnorm_phase(p.out, p.g_mlp + l * DM, (bf16_t*)(ws + OFF_H));
        } else if (k >= 2 && k <= 4) {
            mix_phase(p, l, k - 2, lds);
        } else {
            pg8::Epi E; E.mode = 0; E.O = (bf16_t*)(ws + OFF_B); E.ldc = NP; E.Xin = xin; E.Xout = p.out; E.Y = (const bf16_t*)(ws + OFF_B);
            const bf16_t* A = (const bf16_t*)(ws + OFF_H); const bf16_t* Bt = (const bf16_t*)(ws + OFF_WIN); int lda = DM, a_sh = 0, a_mul = 0, N = NP, K = DM;
            if (k == 5) { E.ldc = 4096; A = (const bf16_t*)(ws + OFF_O); a_sh = 2; a_mul = 256; Bt = (const bf16_t*)(ws + OFF_WB); N = 4096; K = 256; }
            else if (k == 6) { E.mode = 3; E.O = (bf16_t*)(ws + OFF_O); Bt = (const bf16_t*)(ws + OFF_WG); N = 4096; }
            else if (k == 7) { E.mode = 2; A = (const bf16_t*)(ws + OFF_O); Bt = (const bf16_t*)(ws + OFF_WO); N = DM; }
            else if (k == 9) { E.mode = 1; E.ldc = DFF; Bt = (const bf16_t*)(ws + OFF_W1); N = DFF; }
            else if (k == 10) { E.mode = 2; E.Xin = p.out; A = (const bf16_t*)(ws + OFF_B); lda = DFF; Bt = (const bf16_t*)(ws + OFF_W2); N = DM; K = DFF; }
            run_gemm(lds, A, lda, a_sh, a_mul, Bt, N, K, E);
        }
        if (ph + 1 < p.ph_hi) xcd_barrier(gbar);
    }
}

#ifndef ONE_LAUNCH
#define ONE_LAUNCH 1
#endif
extern "C" void kernel_launch(void* const* d_in, const int* in_sizes, int n_in, void* d_out, int out_size, void* d_ws, size_t ws_size, hipStream_t stream) {
    static int grid = 0;
    if (grid == 0) {
        if (n_in != 17 || out_size != T_TOK * DM || ws_size < WS_END) { fprintf(stderr, "kernel_launch: unexpected shapes / workspace (%zu < %zu)\n", ws_size, (size_t)WS_END); grid = -1; return; }
        int dev = 0, cus = 0, per_cu = 0;
        hipGetDevice(&dev); hipDeviceGetAttribute(&cus, hipDeviceAttributeMultiprocessorCount, dev);
        if (hipFuncSetAttribute((const void*)fwd_kernel, hipFuncAttributeMaxDynamicSharedMemorySize, LDS_TOTAL) != hipSuccess) { fprintf(stderr, "hipFuncSetAttribute failed\n"); grid = -1; return; }
        if (hipOccupancyMaxActiveBlocksPerMultiprocessor(&per_cu, (const void*)fwd_kernel, 512, LDS_TOTAL) != hipSuccess || per_cu < 1) per_cu = 1;
        grid = cus * per_cu;
    }
    if (grid < 0) return;
    Params p{};
    p.x = (const float*)d_in[0]; p.g_mix = (const float*)d_in[1]; p.g_mlp = (const float*)d_in[2]; p.w_in = (const float*)d_in[3]; p.gla_w_lr2 = (const float*)d_in[4];
    p.gla_b_lr = (const float*)d_in[5]; p.gla_norm_g = (const float*)d_in[6]; p.dn_conv_w = (const float*)d_in[7]; p.dn_a_log = (const float*)d_in[8]; p.dn_dt_bias = (const float*)d_in[9];
    p.dn_norm_g = (const float*)d_in[10]; p.dil_q_g = (const float*)d_in[11]; p.dil_k_g = (const float*)d_in[12]; p.w_branch = (const float*)d_in[13]; p.w_out = (const float*)d_in[14];
    p.w_mlp_in = (const float*)d_in[15]; p.w_mlp_out = (const float*)d_in[16]; p.out = (float*)d_out; p.ws = (unsigned char*)d_ws;
    if (hipMemsetAsync((char*)d_ws + OFF_CNT, 0, 256 + 16384, stream) != hipSuccess) { fprintf(stderr, "memset failed\n"); return; }
#if ONE_LAUNCH
    p.ph_lo = 0; p.ph_hi = NLAYER * NPH;
    void* args[] = {&p};
    hipError_t e = hipLaunchCooperativeKernel((const void*)fwd_kernel, dim3(grid), dim3(512), args, LDS_TOTAL, stream);
    if (e != hipSuccess) fprintf(stderr, "cooperative launch failed: %s (grid %d)\n", hipGetErrorString(e), grid);
#else
    for (int ph = 0; ph < NLAYER * NPH; ++ph) { p.ph_lo = ph; p.ph_hi = ph + 1; hipLaunchKernelGGL(fwd_kernel, dim3(grid), dim3(512), LDS_TOTAL, stream, p); }
#endif
}
```

```cpp
#include <hip/hip_runtime.h>
#include <hip/hip_cooperative_groups.h>
#include <cstdio>
namespace cg = cooperative_groups;

#define LAS __attribute__((address_space(3)))
typedef unsigned short bf16_t;
typedef short bf16x8 __attribute__((ext_vector_type(8)));
typedef short bf16x4 __attribute__((ext_vector_type(4)));
typedef float f32x4 __attribute__((ext_vector_type(4)));
typedef unsigned u32x4 __attribute__((ext_vector_type(4)));
typedef unsigned u32x2 __attribute__((ext_vector_type(2)));

constexpr int T_TOK = 32768, SEQ = 16384, DM = 1024, NP = 3584, DFF = 4096;
constexpr int C_SBQ = 0, C_SBK = 256, C_SBV = 512, C_GQ = 768, C_GK = 896, C_GV = 1024, C_GLR = 1280, C_GR = 1296, C_DQKV = 1552, C_DA = 2320, C_DB = 2324,
              C_DG = 2328, C_LQ = 2584, C_LK = 2840, C_LV = 3096, C_GATE = 3352, N_IN = 7448;
constexpr int O_SB = 0, O_GLA = 256, O_DN = 512, O_DIL = 768;
constexpr float EPS = 1e-6f;
constexpr int NLAYER = 4, NPH = 11;
constexpr size_t SZ_WIN = (size_t)NP * DM * 2, SZ_WG = (size_t)4096 * DM * 2, SZ_WB = (size_t)4096 * 256 * 2, SZ_WO = (size_t)DM * DM * 2, SZ_W1 = (size_t)DFF * DM * 2, SZ_W2 = (size_t)DM * DFF * 2;
constexpr size_t OFF_WIN = 0, OFF_WG = OFF_WIN + SZ_WIN, OFF_WB = OFF_WG + SZ_WG, OFF_WO = OFF_WB + SZ_WB, OFF_W1 = OFF_WO + SZ_WO, OFF_W2 = OFF_W1 + SZ_W1;
constexpr size_t OFF_B = OFF_W2 + SZ_W2;
constexpr size_t SZ_B = (size_t)T_TOK * 4096 * 2;
constexpr size_t OFF_GLAU = OFF_B + (size_t)T_TOK * NP * 2;
constexpr size_t OFF_GLAA = OFF_GLAU + (size_t)2048 * 2048 * 4;
constexpr size_t OFF_DSTAT = OFF_GLAA + (size_t)2048 * 32 * 4;
constexpr size_t OFF_DNA = OFF_DSTAT + (size_t)T_TOK * 4 * 2 * 4;
constexpr size_t OFF_H = OFF_B + SZ_B;
constexpr size_t OFF_O = OFF_H + (size_t)T_TOK * DM * 2;
constexpr size_t OFF_DN = OFF_O + (size_t)T_TOK * DM * 2;
constexpr size_t OFF_CNT = OFF_DN + (size_t)2048 * 5 * 8192;
constexpr size_t OFF_BAR = OFF_CNT + 256;
constexpr size_t WS_END = OFF_BAR + 16384;
static_assert(OFF_DNA + 2048 * 4 <= OFF_H, "region B overflow");
constexpr int LDS_BYTES = 131072, LDS_TOTAL = LDS_BYTES + 64;

struct Params {
    const float* x; const float* g_mix; const float* g_mlp; const float* w_in; const float* gla_w_lr2; const float* gla_b_lr; const float* gla_norm_g;
    const float* dn_conv_w; const float* dn_a_log; const float* dn_dt_bias; const float* dn_norm_g; const float* dil_q_g; const float* dil_k_g;
    const float* w_branch; const float* w_out; const float* w_mlp_in; const float* w_mlp_out;
    float* out; unsigned char* ws; int ph_lo, ph_hi;
};

typedef __bf16 bf16v2_t __attribute__((ext_vector_type(2)));
typedef float f32v2_t __attribute__((ext_vector_type(2)));
__device__ __forceinline__ unsigned pk2(float lo, float hi) { f32v2_t v = {lo, hi}; bf16v2_t b = __builtin_convertvector(v, bf16v2_t); return __builtin_bit_cast(unsigned, b); }
__device__ __forceinline__ float bf2f(bf16_t b) { return __uint_as_float(((unsigned)b) << 16); }
__device__ __forceinline__ float bflo(unsigned u) { return __uint_as_float(u << 16); }
__device__ __forceinline__ float bfhi(unsigned u) { return __uint_as_float(u & 0xffff0000u); }
__device__ __forceinline__ bf16_t f2bf(float f) { return (bf16_t)(pk2(f, 0.f) & 0xffffu); }
__device__ __forceinline__ float wave_sum(float v) {
#pragma unroll
    for (int o = 1; o < 64; o <<= 1) v += __shfl_xor(v, o);
    return v;
}
__device__ __forceinline__ float sigmoidf_(float x) { return __builtin_amdgcn_rcpf(1.f + __expf(-x)); }
__device__ __forceinline__ float sigmoid_fast(float x) { return __builtin_amdgcn_rcpf(1.f + __expf(-x)); }
__device__ __forceinline__ float softplusf_(float z) { return fmaxf(z, 0.f) + __logf(1.f + __expf(-fabsf(z))); }
__device__ __forceinline__ bf16x8 mk8(u32x2 a, u32x2 b) { u32x4 t; t.x = a.x; t.y = a.y; t.z = b.x; t.w = b.y; return __builtin_bit_cast(bf16x8, t); }
__device__ __forceinline__ bf16x8 pk8(f32x4 a, f32x4 b) { u32x4 t; t.x = pk2(a[0], a[1]); t.y = pk2(a[2], a[3]); t.z = pk2(b[0], b[1]); t.w = pk2(b[2], b[3]); return __builtin_bit_cast(bf16x8, t); }
__device__ __forceinline__ int tid_opaque() { int t = (int)threadIdx.x; asm volatile("" : "+v"(t)); return t; }
#define TIDX tid_opaque()
#define MFMA16(a, b, c) __builtin_amdgcn_mfma_f32_16x16x32_bf16((a), (b), (c), 0, 0, 0)

namespace pg8 {
constexpr int BM = 256, BK = 64, HALF = 128, HTB = HALF * BK * 2, NXCD = 8, WGM = 8;
__device__ __forceinline__ int lds_byte(int r, int c) { const int st = (r >> 4) * 2 + (c >> 5), rr = r & 15, cc = c & 31, ob = rr * 64 + cc * 2; return st * 1024 + (ob ^ (((ob >> 9) & 1) << 5)); }
__device__ __forceinline__ void stage_rc(int b, int& R, int& C) { const int st = b / 1024, sb = b % 1024, swz = sb ^ (((sb >> 9) & 1) << 5); R = (st >> 1) * 16 + swz / 64; C = (st & 1) * 32 + (swz % 64) / 2; }
__device__ __forceinline__ int perm32(int rho) { const int n = rho >> 4, i = rho & 15; return 8 * (i >> 2) + 4 * n + (i & 3); }
struct Unit { int pm, pn; };
struct Gemm { const bf16_t* A; const bf16_t* Bt; int M, N, K, lda, a_sh, a_mul; };
struct StaticOrder {
    int nM, nN, nwg, G, c;
    __device__ void init(int M, int N, int G_, int c_) { nM = M / BM; nN = N / BM; nwg = nM * nN; G = G_; c = c_; }
    __device__ bool next(int i, Unit& u) const {
        const long L = (long)i * G + c; if (L >= nwg) return false;
        int wgid = (int)L; { const int q = nwg / NXCD, r = nwg % NXCD, xcd = wgid % NXCD, off = wgid / NXCD; wgid = (xcd < r ? xcd * (q + 1) : r * (q + 1) + (xcd - r) * q) + off; }
        const int nig = WGM * nN, gid = wgid / nig, fm = gid * WGM, gsz = (nM - fm) < WGM ? (nM - fm) : WGM;
        u.pm = fm + ((wgid % nig) % gsz); u.pn = (wgid % nig) / gsz; return true;
    }
};
struct Epi {
    int mode; bf16_t* O; int ldc; const float* Xin; float* Xout; const bf16_t* Y;
    __device__ __forceinline__ void operator()(const f32x4 (&acc)[2][2][4][2], const Unit& u, int wr, int wc, int fr, int fq) const {
        const int row0 = u.pm * BM + wr * 64 + fr;
        if (mode < 2) {
            const int col0 = u.pn * BM + wc * 32 + 8 * fq;
#pragma unroll
            for (int ai = 0; ai < 2; ++ai)
#pragma unroll
                for (int m = 0; m < 4; ++m) { bf16_t* rowp = O + (size_t)(row0 + ai * HALF + m * 16) * ldc + col0;
#pragma unroll
                    for (int bj = 0; bj < 2; ++bj) { f32x4 v0 = acc[ai][bj][m][0], v1 = acc[ai][bj][m][1];
                        if (mode == 1) {
#pragma unroll
                            for (int j = 0; j < 4; ++j) { float a = fmaxf(v0[j], 0.f), b = fmaxf(v1[j], 0.f); v0[j] = a * a; v1[j] = b * b; } }
                        u32x4 o; o.x = pk2(v0[0], v0[1]); o.y = pk2(v0[2], v0[3]); o.z = pk2(v1[0], v1[1]); o.w = pk2(v1[2], v1[3]);
                        *(u32x4*)(rowp + bj * HALF) = o; } }
        } else if (mode == 2) {
            const int col0 = u.pn * BM + wc * 32 + 4 * fq;
#pragma unroll
            for (int ai = 0; ai < 2; ++ai) { f32x4 xi[4][2][2];
#pragma unroll
                for (int m = 0; m < 4; ++m) { const size_t ro = (size_t)(row0 + ai * HALF + m * 16) * DM + col0;
#pragma unroll
                    for (int bj = 0; bj < 2; ++bj)
#pragma unroll
                        for (int n = 0; n < 2; ++n) xi[m][bj][n] = *(const f32x4*)(Xin + ro + bj * HALF + n * 16); }
                __builtin_amdgcn_sched_barrier(0);
#pragma unroll
                for (int m = 0; m < 4; ++m) { const size_t ro = (size_t)(row0 + ai * HALF + m * 16) * DM + col0;
#pragma unroll
                    for (int bj = 0; bj < 2; ++bj)
#pragma unroll
                        for (int n = 0; n < 2; ++n) *(f32x4*)(Xout + ro + bj * HALF + n * 16) = xi[m][bj][n] + acc[ai][bj][m][n]; }
                __builtin_amdgcn_sched_barrier(0); }
        } else {
            const int ch0 = u.pn * 64 + wc * 16 + 4 * fq;
#pragma unroll
            for (int ai = 0; ai < 2; ++ai) { u32x2 y[4][2][2];
#pragma unroll
                for (int m = 0; m < 4; ++m) { const size_t row = (size_t)(row0 + ai * HALF + m * 16);
#pragma unroll
                    for (int bj = 0; bj < 2; ++bj)
#pragma unroll
                        for (int n = 0; n < 2; ++n) y[m][bj][n] = *(const u32x2*)(Y + row * 4096 + (2 * bj + n) * 1024 + ch0); }
                __builtin_amdgcn_sched_barrier(0);
#pragma unroll
                for (int m = 0; m < 4; ++m) { const size_t row = (size_t)(row0 + ai * HALF + m * 16); f32x4 s = {0.f, 0.f, 0.f, 0.f};
#pragma unroll
                    for (int bj = 0; bj < 2; ++bj)
#pragma unroll
                        for (int n = 0; n < 2; ++n) { const u32x2 yy = y[m][bj][n]; const f32x4 a = acc[ai][bj][m][n];
                            s[0] += sigmoid_fast(a[0]) * bflo(yy.x); s[1] += sigmoid_fast(a[1]) * bfhi(yy.x); s[2] += sigmoid_fast(a[2]) * bflo(yy.y); s[3] += sigmoid_fast(a[3]) * bfhi(yy.y); }
                    u32x2 o; o.x = pk2(s[0], s[1]); o.y = pk2(s[2], s[3]); *(u32x2*)(O + row * DM + ch0) = o; }
                __builtin_amdgcn_sched_barrier(0); }
        }
    }
};

__device__ __forceinline__ void gemm_phase(LAS unsigned char* lds, const Gemm g, const StaticOrder& S, const Epi& E) {
    const int tid = TIDX, wid = __builtin_amdgcn_readfirstlane(tid >> 6), lane = tid & 63, wr = wid >> 2, wc = wid & 3, fr = lane & 15, fq = lane >> 4;
    const int K = g.K, nt = K / BK, lda = g.lda;
    unsigned voffA[2], voffB[2];
#pragma unroll
    for (int i = 0; i < 2; ++i) { int R, C; stage_rc(tid * 16 + i * 8192, R, C); const int Rb = (E.mode < 2) ? ((R & ~31) + perm32(R & 31)) : R;
        voffA[i] = (unsigned)(R * lda + C) * 2u; voffB[i] = (unsigned)(Rb * K + C) * 2u; }
    const size_t kstep = (size_t)(BK * 2);
    const size_t hstepA = (size_t)HALF * lda * 2, hstepB = (size_t)HALF * K * 2;
    const size_t tstepA = 2 * hstepA, tstepB = 2 * hstepB;
    const unsigned ldsw = (unsigned)wid * 1024u;
    const int aoff = lds_byte(wr * 64 + fr, fq * 8), boff = lds_byte(wc * 32 + fr, fq * 8);
#define PG8_SA(b, h) (((b) * 2 + (h)) * HTB)
#define PG8_SB(b, h) ((4 + (b) * 2 + (h)) * HTB)
#define PG8_STAGE(bufoff, gbase, voff) do { _Pragma("unroll") for (int _i = 0; _i < 2; ++_i) \
        __builtin_amdgcn_global_load_lds((const unsigned*)((const char*)(gbase) + (voff)[_i]), (LAS unsigned*)(lds + (bufoff) + ldsw + _i * 8192), 16, 0, 0); } while (0)
#define PG8_LDA(dst, b, h) do { _Pragma("unroll") for (int m = 0; m < 4; ++m) _Pragma("unroll") for (int k = 0; k < 2; ++k) dst[m][k] = *(const LAS bf16x8*)(lds + PG8_SA(b, h) + aoff + m * 2048 + k * 1024); } while (0)
#define PG8_LDB(dst, b, h) do { _Pragma("unroll") for (int n = 0; n < 2; ++n) _Pragma("unroll") for (int k = 0; k < 2; ++k) dst[n][k] = *(const LAS bf16x8*)(lds + PG8_SB(b, h) + boff + n * 2048 + k * 1024); } while (0)
#define PG8_MMA(ai, bj, At, Bt) do { __builtin_amdgcn_s_setprio(1); _Pragma("unroll") for (int m = 0; m < 4; ++m) _Pragma("unroll") for (int n = 0; n < 2; ++n) _Pragma("unroll") for (int k = 0; k < 2; ++k) \
        acc[ai][bj][m][n] = __builtin_amdgcn_mfma_f32_16x16x32_bf16(Bt[n][k], At[m][k], acc[ai][bj][m][n], 0, 0, 0); __builtin_amdgcn_s_setprio(0); } while (0)
#define PG8_WAIT_V(n) asm volatile("s_waitcnt vmcnt(" #n ")" ::: "memory")
#define PG8_WAIT_L(n) asm volatile("s_waitcnt lgkmcnt(" #n ")" ::: "memory")
#define PG8_BAR __builtin_amdgcn_s_barrier()
#define PG8_SCHED __builtin_amdgcn_sched_barrier(0)
#define PG8_APTR(u) ((const char*)g.A + (size_t)(u).pm * tstepA + (size_t)(((u).pn >> g.a_sh) * g.a_mul) * 2)
    Unit cur, nxt; int ui = 0;
    if (!S.next(0, cur)) return;
    f32x4 acc[2][2][4][2];
#pragma unroll
    for (int a = 0; a < 2; ++a)
#pragma unroll
        for (int b = 0; b < 2; ++b)
#pragma unroll
            for (int m = 0; m < 4; ++m)
#pragma unroll
                for (int n = 0; n < 2; ++n) acc[a][b][m][n] = (f32x4){0.f, 0.f, 0.f, 0.f};
    bf16x8 At[4][2], B0[2][2], B1[2][2];
    const char* cA = PG8_APTR(cur); const char* cB = (const char*)g.Bt + (size_t)cur.pn * tstepB;
    PG8_STAGE(PG8_SB(0, 0), cB, voffB); PG8_STAGE(PG8_SB(0, 1), cB + hstepB, voffB); PG8_STAGE(PG8_SA(0, 0), cA, voffA); PG8_STAGE(PG8_SA(0, 1), cA + hstepA, voffA);
    if (wr == 1) PG8_BAR;
    PG8_WAIT_V(2); PG8_BAR;
    PG8_STAGE(PG8_SB(1, 0), cB + kstep, voffB); PG8_STAGE(PG8_SA(1, 0), cA + kstep, voffA); PG8_STAGE(PG8_SB(1, 1), cB + hstepB + kstep, voffB);
    PG8_WAIT_V(6); PG8_BAR;
    for (;;) {
        const bool has_next = S.next(ui + 1, nxt);
        const char* nA = has_next ? PG8_APTR(nxt) : cA; const char* nB = has_next ? (const char*)g.Bt + (size_t)nxt.pn * tstepB : cB;
        for (int t = 0; t < nt; t += 2) {
            const bool last = (t == nt - 2);
            const char* a1 = cA + (size_t)(t + 1) * kstep;
            const char* a2 = last ? nA : cA + (size_t)(t + 2) * kstep; const char* b2 = last ? nB : cB + (size_t)(t + 2) * kstep;
            const char* a3 = a2 + kstep; const char* b3 = b2 + kstep;
            PG8_LDB(B0, 0, 0); PG8_LDB(B1, 0, 1); PG8_SCHED; PG8_LDA(At, 0, 0); PG8_STAGE(PG8_SA(1, 1), a1 + hstepA, voffA);
            PG8_WAIT_V(8); PG8_WAIT_L(0); PG8_BAR; PG8_MMA(0, 0, At, B0); PG8_MMA(0, 1, At, B1); PG8_BAR; PG8_SCHED;
            PG8_LDA(At, 0, 1); PG8_STAGE(PG8_SB(0, 0), b2, voffB); PG8_STAGE(PG8_SB(0, 1), b2 + hstepB, voffB); PG8_STAGE(PG8_SA(0, 0), a2, voffA);
            PG8_WAIT_V(8); PG8_WAIT_L(0); PG8_BAR; PG8_MMA(1, 0, At, B0); PG8_MMA(1, 1, At, B1); PG8_BAR; PG8_SCHED;
            PG8_LDB(B0, 1, 0); PG8_LDB(B1, 1, 1); PG8_SCHED; PG8_LDA(At, 1, 0); PG8_STAGE(PG8_SA(0, 1), a2 + hstepA, voffA);
            PG8_WAIT_V(8); PG8_WAIT_L(0); PG8_BAR; PG8_MMA(0, 0, At, B0); PG8_MMA(0, 1, At, B1); PG8_BAR; PG8_SCHED;
            PG8_LDA(At, 1, 1); PG8_STAGE(PG8_SB(1, 0), b3, voffB); PG8_STAGE(PG8_SB(1, 1), b3 + hstepB, voffB); PG8_STAGE(PG8_SA(1, 0), a3, voffA);
            PG8_WAIT_V(8); PG8_WAIT_L(0); PG8_BAR; PG8_MMA(1, 0, At, B0); PG8_MMA(1, 1, At, B1); PG8_BAR; PG8_SCHED;
        }
        if (wr == 0) PG8_BAR;
        E(acc, cur, wr, wc, fr, fq);
        if (!has_next) break;
#pragma unroll
        for (int a = 0; a < 2; ++a)
#pragma unroll
            for (int b = 0; b < 2; ++b)
#pragma unroll
                for (int m = 0; m < 4; ++m)
#pragma unroll
                    for (int n = 0; n < 2; ++n) acc[a][b][m][n] = (f32x4){0.f, 0.f, 0.f, 0.f};
        cur = nxt; cA = nA; cB = nB; ++ui;
        if (wr == 1) PG8_BAR;
    }
    PG8_WAIT_V(0);
    PG8_BAR;
#undef PG8_SA
#undef PG8_SB
#undef PG8_STAGE
#undef PG8_LDA
#undef PG8_LDB
#undef PG8_MMA
#undef PG8_WAIT_V
#undef PG8_WAIT_L
#undef PG8_BAR
#undef PG8_SCHED
#undef PG8_APTR
}
}

__device__ __forceinline__ void run_gemm(LAS unsigned char* lds, const bf16_t* A, int lda, int a_sh, int a_mul, const bf16_t* Bt, int N, int K, const pg8::Epi& E) {
    pg8::Gemm g; g.A = A; g.Bt = Bt; g.M = T_TOK; g.N = N; g.K = K; g.lda = lda; g.a_sh = a_sh; g.a_mul = a_mul;
    pg8::StaticOrder S; S.init(T_TOK, N, (int)gridDim.x, (int)blockIdx.x);
    pg8::gemm_phase(lds, g, S, E);
}

__device__ __forceinline__ void rmsnorm_phase(const float* X, const float* g, bf16_t* H) {
    const int lane = TIDX & 63, gw = blockIdx.x * 8 + (TIDX >> 6), NW = gridDim.x * 8;
    f32x4 gv[4];
#pragma unroll
    for (int j = 0; j < 4; ++j) gv[j] = *(const f32x4*)(g + 4 * (lane + 64 * j));
    for (int row = gw; row < T_TOK; row += 4 * NW) {
        f32x4 v[4][4];
#pragma unroll
        for (int q = 0; q < 4; ++q) { const int rr = row + q * NW; if (rr < T_TOK) {
#pragma unroll
            for (int j = 0; j < 4; ++j) v[q][j] = *(const f32x4*)(X + (size_t)rr * DM + 4 * (lane + 64 * j)); } }
#pragma unroll
        for (int q = 0; q < 4; ++q) { const int rr = row + q * NW; if (rr < T_TOK) { float s = 0.f;
#pragma unroll
            for (int j = 0; j < 4; ++j) s += v[q][j][0] * v[q][j][0] + v[q][j][1] * v[q][j][1] + v[q][j][2] * v[q][j][2] + v[q][j][3] * v[q][j][3];
            const float rstd = rsqrtf(wave_sum(s) * (1.f / DM) + EPS);
#pragma unroll
            for (int j = 0; j < 4; ++j) { u32x2 o; o.x = pk2(v[q][j][0] * rstd * gv[j][0], v[q][j][1] * rstd * gv[j][1]); o.y = pk2(v[q][j][2] * rstd * gv[j][2], v[q][j][3] * rstd * gv[j][3]);
                *(u32x2*)(H + (size_t)rr * DM + 4 * (lane + 64 * j)) = o; } } }
    }
}
__device__ __forceinline__ int wmap(int mat, int j) {
    if (mat == 0) return j < C_GATE ? j : -1;
    if (mat == 1) { const int pn = j >> 8, rho = j & 255, bj = rho >> 7, wc = (rho >> 5) & 3, n = (rho >> 4) & 1, fq = (rho >> 2) & 3, jj = rho & 3;
        return C_GATE + (2 * bj + n) * 1024 + 64 * pn + 16 * wc + 4 * fq + jj; }
    return j;
}
struct WItem { const float* src; bf16_t* dst; int ld, K, mat, k0, n0; };
__device__ __forceinline__ WItem wdecode(const Params& p, int l, int r) {
    constexpr int I0 = 16 * 56, I1 = 16 * 64, I2 = 4 * 4 * 16, I3 = 16 * 16, I4 = 16 * 64;
    WItem w;
    if (r < I0) { w.src = p.w_in + (size_t)l * DM * N_IN; w.ld = N_IN; w.K = DM; w.dst = (bf16_t*)(p.ws + OFF_WIN); w.mat = 0; w.k0 = (r / 56) * 64; w.n0 = (r % 56) * 64; return w; } r -= I0;
    if (r < I1) { w.src = p.w_in + (size_t)l * DM * N_IN; w.ld = N_IN; w.K = DM; w.dst = (bf16_t*)(p.ws + OFF_WG); w.mat = 1; w.k0 = (r / 64) * 64; w.n0 = (r % 64) * 64; return w; } r -= I1;
    if (r < I2) { const int nb = r / 64, q = r % 64; w.src = p.w_branch + ((size_t)l * 4 + nb) * 256 * DM; w.ld = DM; w.K = 256; w.dst = (bf16_t*)(p.ws + OFF_WB) + (size_t)nb * 1024 * 256; w.mat = 2; w.k0 = (q / 16) * 64; w.n0 = (q % 16) * 64; return w; } r -= I2;
    if (r < I3) { w.src = p.w_out + (size_t)l * DM * DM; w.ld = DM; w.K = DM; w.dst = (bf16_t*)(p.ws + OFF_WO); w.mat = 2; w.k0 = (r / 16) * 64; w.n0 = (r % 16) * 64; return w; } r -= I3;
    if (r < I4) { w.src = p.w_mlp_in + (size_t)l * DM * DFF; w.ld = DFF; w.K = DM; w.dst = (bf16_t*)(p.ws + OFF_W1); w.mat = 2; w.k0 = (r / 64) * 64; w.n0 = (r % 64) * 64; return w; } r -= I4;
    w.src = p.w_mlp_out + (size_t)l * DFF * DM; w.ld = DM; w.K = DFF; w.dst = (bf16_t*)(p.ws + OFF_W2); w.mat = 2; w.k0 = (r / 16) * 64; w.n0 = (r % 16) * 64; return w;
}
__device__ __forceinline__ void wload(const WItem& w, int tid, float (&v)[8]) {
    const int nn = tid & 63; const int c = wmap(w.mat, w.n0 + nn);
#pragma unroll
    for (int i = 0; i < 8; ++i) { const int kk = i * 8 + (tid >> 6); v[i] = (c >= 0) ? w.src[(size_t)(w.k0 + kk) * w.ld + c] : 0.f; }
}
__device__ __forceinline__ void wconv_phase(const Params& p, int l, LAS unsigned char* lds) {
    LAS float* scr = (LAS float*)lds;
    constexpr int NI = 16 * 56 + 16 * 64 + 4 * 4 * 16 + 16 * 16 + 16 * 64 + 64 * 16;
    const int tid = TIDX, G = gridDim.x;
    int it = blockIdx.x;
    if (it >= NI) return;
    WItem w0 = wdecode(p, l, it), w1 = w0, w2 = w0; float v0[8], v1[8], v2[8];
    wload(w0, tid, v0);
    if (it + G < NI) { w1 = wdecode(p, l, it + G); wload(w1, tid, v1); }
    for (; it < NI; it += G) {
        if (it + 2 * G < NI) { w2 = wdecode(p, l, it + 2 * G); wload(w2, tid, v2); }
        { const int nn = tid & 63;
#pragma unroll
          for (int i = 0; i < 8; ++i) scr[(i * 8 + (tid >> 6)) * 65 + nn] = v0[i]; }
        __syncthreads();
        { const int kk2 = (tid & 31) * 2;
#pragma unroll
          for (int i = 0; i < 4; ++i) { const int nn = i * 16 + (tid >> 5); *(unsigned*)(w0.dst + (size_t)(w0.n0 + nn) * w0.K + w0.k0 + kk2) = pk2(scr[kk2 * 65 + nn], scr[(kk2 + 1) * 65 + nn]); } }
        __syncthreads();
        w0 = w1; w1 = w2;
#pragma unroll
        for (int i = 0; i < 8; ++i) { v0[i] = v1[i]; v1[i] = v2[i]; }
    }
}

__device__ __forceinline__ void sb_task(const Params& p, int l, LAS unsigned char* lds, int task) {
    constexpr int VTS = 140;
    const int tid = TIDX, wave = tid >> 6, lane = tid & 63, ll = lane & 15, qd = lane >> 4;
    const int bh = task >> 7, qi = 127 - (task & 127), b = bh >> 2, h = bh & 3, q0 = qi * 128;
    const bf16_t* base = (const bf16_t*)(p.ws + OFF_B) + (size_t)b * SEQ * NP;
    LAS bf16_t* vt = (LAS bf16_t*)lds;
    LAS int* flag = (LAS int*)(lds + 64 * VTS * 2);
    bf16x8 qf[2];
#pragma unroll
    for (int ks = 0; ks < 2; ++ks) qf[ks] = *(const bf16x8*)(base + (size_t)(q0 + wave * 16 + ll) * NP + C_SBQ + h * 64 + ks * 32 + qd * 8);
    float carry = 0.f;
    f32x4 oacc[4];
#pragma unroll
    for (int c = 0; c < 4; ++c) oacc[c] = (f32x4){0.f, 0.f, 0.f, 0.f};
    bf16x8 kc[8][2], va, vc;
#define SB_LOAD(jj, K_, A_, C_) do { _Pragma("unroll") for (int g = 0; g < 8; ++g) _Pragma("unroll") for (int ks = 0; ks < 2; ++ks) \
            K_[g][ks] = *(const bf16x8*)(base + (size_t)((jj) * 128 + g * 16 + ll) * NP + C_SBK + h * 64 + ks * 32 + qd * 8); \
        const bf16_t* vp_ = base + (size_t)((jj) * 128 + 2 * (tid >> 3)) * NP + C_SBV + h * 64 + (tid & 7) * 8; A_ = *(const bf16x8*)vp_; C_ = *(const bf16x8*)(vp_ + NP); } while (0)
    SB_LOAD(qi, kc, va, vc);
    for (int j = qi; j >= 0; --j) {
        bf16x8 kn[8][2], van, vcn;
        { const int jn = j > 0 ? j - 1 : 0; SB_LOAD(jn, kn, van, vcn); }
        {
#pragma unroll
            for (int e = 0; e < 8; ++e) *(LAS unsigned*)(vt + ((tid & 7) * 8 + e) * VTS + 2 * (tid >> 3)) = (unsigned)(unsigned short)va[e] | ((unsigned)(unsigned short)vc[e] << 16);
        }
        f32x4 s[8];
#pragma unroll
        for (int g = 0; g < 8; ++g) { s[g] = (f32x4){0.f, 0.f, 0.f, 0.f};
#pragma unroll
            for (int ks = 0; ks < 2; ++ks) s[g] = MFMA16(kc[g][ks], qf[ks], s[g]); }
        const bool diag = (j == qi);
        f32x4 sp[8], lb[8]; float Gt[8], abq[8];
#pragma unroll
        for (int g = 0; g < 8; ++g) {
#pragma unroll
            for (int r = 0; r < 4; ++r) { const float z = s[g][r] * 0.18033688011112042f;
                float spv = fmaxf(z, 0.f) + __builtin_amdgcn_logf(1.f + __builtin_amdgcn_exp2f(-fabsf(z))), lbv = z - spv;
                if (diag && !(16 * g + 4 * qd + r < wave * 16 + ll)) { spv = 0.f; lbv = -INFINITY; }
                sp[g][r] = spv; lb[g][r] = lbv; }
            const float L = (sp[g][0] + sp[g][1]) + (sp[g][2] + sp[g][3]);
            const float L0 = __shfl(L, ll), L1 = __shfl(L, ll + 16), L2 = __shfl(L, ll + 32), L3 = __shfl(L, ll + 48);
            Gt[g] = (L0 + L1) + (L2 + L3);
            abq[g] = (qd < 1 ? L1 : 0.f) + (qd < 2 ? L2 : 0.f) + (qd < 3 ? L3 : 0.f);
        }
        float run = 0.f; bf16x8 pf[4]; f32x4 w[8];
#pragma unroll
        for (int g = 7; g >= 0; --g) {
            const float bs = carry - run - abq[g];
            w[g][3] = __builtin_amdgcn_exp2f(lb[g][3] + bs);
            w[g][2] = __builtin_amdgcn_exp2f(lb[g][2] + bs - sp[g][3]);
            w[g][1] = __builtin_amdgcn_exp2f(lb[g][1] + bs - (sp[g][3] + sp[g][2]));
            w[g][0] = __builtin_amdgcn_exp2f(lb[g][0] + bs - (sp[g][3] + sp[g][2] + sp[g][1]));
            run += Gt[g];
        }
#pragma unroll
        for (int g2 = 0; g2 < 4; ++g2) pf[g2] = pk8(w[2 * g2], w[2 * g2 + 1]);
        carry -= run;
        __syncthreads();
        {
            bf16x8 af[4][4];
#pragma unroll
            for (int c = 0; c < 4; ++c)
#pragma unroll
                for (int g2 = 0; g2 < 4; ++g2) { const LAS bf16_t* vr = vt + (16 * c + ll) * VTS + 32 * g2 + 4 * qd; af[c][g2] = mk8(*(const LAS u32x2*)vr, *(const LAS u32x2*)(vr + 16)); }
            __builtin_amdgcn_sched_barrier(0);
#pragma unroll
            for (int c = 0; c < 4; ++c)
#pragma unroll
                for (int g2 = 0; g2 < 4; ++g2) oacc[c] = MFMA16(af[c][g2], pf[g2], oacc[c]);
        }
        const int done = __all(carry < -150.05f) ? 1 : 0;
        if (lane == 0) flag[wave] = done;
        __syncthreads();
        int all = 1;
#pragma unroll
        for (int i = 0; i < 8; ++i) all &= flag[i];
        if (__builtin_amdgcn_readfirstlane(all)) break;
        __syncthreads();
#pragma unroll
        for (int g = 0; g < 8; ++g) { kc[g][0] = kn[g][0]; kc[g][1] = kn[g][1]; }
        va = van; vc = vcn;
    }
#undef SB_LOAD
    bf16_t* op = (bf16_t*)(p.ws + OFF_O) + (size_t)(b * SEQ + q0 + wave * 16 + ll) * DM + O_SB + h * 64 + 4 * qd;
#pragma unroll
    for (int c = 0; c < 4; ++c) { u32x2 o; o.x = pk2(oacc[c][0], oacc[c][1]); o.y = pk2(oacc[c][2], oacc[c][3]); *(u32x2*)(op + 16 * c) = o; }
    __syncthreads();
}

__device__ __forceinline__ void dil_task(const Params& p, int l, LAS unsigned char* lds, int pat, int task) {
    constexpr int RS = 72, VTS = 268;
    const int tid = TIDX, wave = tid >> 6, lane = tid & 63, ll = lane & 15, qd = lane >> 4;
    const int dil = pat == 0 ? 1 : (pat == 1 ? 4 : 16), nb = (SEQ / dil) / 128;
    const int n = task % nb, r = (task / nb) % dil, bh = task / (nb * dil), b = bh >> 2, h = bh & 3;
    const bf16_t* base = (const bf16_t*)(p.ws + OFF_B) + (size_t)b * SEQ * NP;
    LAS bf16_t* qs = (LAS bf16_t*)lds;
    LAS bf16_t* ks = qs + 128 * RS;
    LAS bf16_t* vt = ks + 256 * RS;
    LAS float* gq = (LAS float*)(vt + 64 * VTS);
    if (tid < 128) gq[tid] = tid < 64 ? p.dil_q_g[l * 64 + tid] : p.dil_k_g[l * 64 + tid - 64];
    bf16x8 vreg[2][2];
#pragma unroll
    for (int ps = 0; ps < 2; ++ps) { const int kj = 2 * (ps * 64 + (tid >> 3)), idx = n * 128 - 128 + kj;
        vreg[ps][0] = (bf16x8){0, 0, 0, 0, 0, 0, 0, 0}; vreg[ps][1] = (bf16x8){0, 0, 0, 0, 0, 0, 0, 0};
        if (idx >= 0) { const bf16_t* vp = base + (size_t)(idx * dil + r) * NP + C_LV + h * 64 + (tid & 7) * 8; vreg[ps][0] = *(const bf16x8*)vp; vreg[ps][1] = *(const bf16x8*)(vp + (size_t)dil * NP); } }
    __syncthreads();
    if (tid < 384) {
        const bool isq = tid < 128; const int idx = isq ? n * 128 + tid : n * 128 - 128 + (tid - 128);
        LAS bf16_t* dst = isq ? qs + tid * RS : ks + (tid - 128) * RS;
        if (idx >= 0) {
            const int pos = idx * dil + r;
            const bf16_t* src = base + (size_t)pos * NP + (isq ? C_LQ : C_LK) + h * 64;
            float xv[64]; float ss = 0.f;
#pragma unroll
            for (int c8 = 0; c8 < 8; ++c8) { const u32x4 u = *(const u32x4*)(src + c8 * 8);
                xv[c8 * 8 + 0] = bflo(u.x); xv[c8 * 8 + 1] = bfhi(u.x); xv[c8 * 8 + 2] = bflo(u.y); xv[c8 * 8 + 3] = bfhi(u.y);
                xv[c8 * 8 + 4] = bflo(u.z); xv[c8 * 8 + 5] = bfhi(u.z); xv[c8 * 8 + 6] = bflo(u.w); xv[c8 * 8 + 7] = bfhi(u.w); }
#pragma unroll
            for (int c = 0; c < 64; ++c) ss += xv[c] * xv[c];
            const float rstd = rsqrtf(ss * (1.f / 64.f) + EPS);
            const LAS float* gg = gq + (isq ? 0 : 64);
#pragma unroll
            for (int c = 0; c < 64; ++c) xv[c] = xv[c] * rstd * gg[c];
#pragma unroll
            for (int i = 0; i < 8; ++i) {
                const float invf = exp2f(-(float)i * (18.931568569324174f / 8.f));
                const float ang = (float)pos * invf;
                double rev = (double)ang * 0.15915494309189535; rev -= rint(rev);
                const float a2 = (float)(rev * 6.283185307179586);
                const float cs = __cosf(a2), sn = __sinf(a2);
                const float x1 = xv[i], x2 = xv[i + 8]; xv[i] = x1 * cs - x2 * sn; xv[i + 8] = x2 * cs + x1 * sn;
            }
#pragma unroll
            for (int c8 = 0; c8 < 8; ++c8) { u32x4 o; o.x = pk2(xv[c8 * 8], xv[c8 * 8 + 1]); o.y = pk2(xv[c8 * 8 + 2], xv[c8 * 8 + 3]); o.z = pk2(xv[c8 * 8 + 4], xv[c8 * 8 + 5]); o.w = pk2(xv[c8 * 8 + 6], xv[c8 * 8 + 7]);
                *(LAS u32x4*)(dst + c8 * 8) = o; }
        } else {
#pragma unroll
            for (int c8 = 0; c8 < 8; ++c8) *(LAS u32x4*)(dst + c8 * 8) = (u32x4){0u, 0u, 0u, 0u};
        }
    }
    {
#pragma unroll
        for (int ps = 0; ps < 2; ++ps) { const int kj = 2 * (ps * 64 + (tid >> 3));
#pragma unroll
            for (int e = 0; e < 8; ++e) *(LAS unsigned*)(vt + ((tid & 7) * 8 + e) * VTS + kj) = (unsigned)(unsigned short)vreg[ps][0][e] | ((unsigned)(unsigned short)vreg[ps][1][e] << 16); }
    }
    __syncthreads();
    const size_t tok = (size_t)b * SEQ + (size_t)(n * 128 + 16 * wave + ll) * dil + r;
    bf16_t* op = (bf16_t*)(p.ws + OFF_O) + tok * DM + O_DIL + h * 64 + 4 * qd;
    float* st = (float*)(p.ws + OFF_DSTAT) + (tok * 4 + h) * 2;
    u32x2 pv[4]; float mo = 0.f, dd = 0.f;
    if (pat > 0) { mo = st[0]; dd = st[1];
#pragma unroll
        for (int c = 0; c < 4; ++c) pv[c] = *(const u32x2*)(op + 16 * c); }
    bf16x8 qf[2];
#pragma unroll
    for (int k2 = 0; k2 < 2; ++k2) qf[k2] = *(const LAS bf16x8*)(qs + (16 * wave + ll) * RS + k2 * 32 + qd * 8);
    f32x4 s[10]; float mx = -INFINITY;
    {   bf16x8 kf[10][2];
#pragma unroll
        for (int gi = 0; gi < 10; ++gi) { const int g = wave + gi, gc = g < 16 ? g : 15;
#pragma unroll
            for (int k2 = 0; k2 < 2; ++k2) kf[gi][k2] = *(const LAS bf16x8*)(ks + (16 * gc + ll) * RS + k2 * 32 + qd * 8); }
        __builtin_amdgcn_sched_barrier(0);
#pragma unroll
        for (int gi = 0; gi < 10; ++gi) { s[gi] = (f32x4){0.f, 0.f, 0.f, 0.f};
#pragma unroll
            for (int k2 = 0; k2 < 2; ++k2) s[gi] = MFMA16(kf[gi][k2], qf[k2], s[gi]); }
    }
#pragma unroll
    for (int gi = 0; gi < 10; ++gi) {
        const int g = wave + gi;
#pragma unroll
        for (int rr = 0; rr < 4; ++rr) { const int kj = 16 * g + 4 * qd + rr, m = (16 * wave + ll) + 128 - kj;
            const bool valid = (g < 16) && (m >= 0) && (m <= 128) && (n * 128 - 128 + kj >= 0);
            const float v = valid ? s[gi][rr] * 0.18033688011112042f : -INFINITY;     s[gi][rr] = v; mx = fmaxf(mx, v); }
    }
    mx = fmaxf(mx, __shfl_xor(mx, 16)); mx = fmaxf(mx, __shfl_xor(mx, 32));
    float den = 0.f; bf16x8 pf[5];
#pragma unroll
    for (int gi = 0; gi < 10; ++gi)
#pragma unroll
        for (int rr = 0; rr < 4; ++rr) { const float e = __builtin_amdgcn_exp2f(s[gi][rr] - mx); s[gi][rr] = e; den += e; }
    den += __shfl_xor(den, 16); den += __shfl_xor(den, 32);
#pragma unroll
    for (int g2 = 0; g2 < 5; ++g2) pf[g2] = pk8(s[2 * g2], s[2 * g2 + 1]);
    f32x4 oacc[4];
    {   bf16x8 af[4][5];
#pragma unroll
        for (int c = 0; c < 4; ++c)
#pragma unroll
            for (int g2 = 0; g2 < 5; ++g2) {
                const int ga = wave + 2 * g2, gb = ga + 1, gac = ga < 16 ? ga : 15, gbc = gb < 16 ? gb : 15;
                const LAS bf16_t* vr = vt + (16 * c + ll) * VTS + 4 * qd;
                af[c][g2] = mk8(*(const LAS u32x2*)(vr + 16 * gac), *(const LAS u32x2*)(vr + 16 * gbc)); }
        __builtin_amdgcn_sched_barrier(0);
#pragma unroll
        for (int c = 0; c < 4; ++c) { oacc[c] = (f32x4){0.f, 0.f, 0.f, 0.f};
#pragma unroll
            for (int g2 = 0; g2 < 5; ++g2) oacc[c] = MFMA16(af[c][g2], pf[g2], oacc[c]); }
    }
    float wa = 0.f, wb = 1.f, D = den, M = mx;
    if (pat > 0) { M = fmaxf(mo, mx); wa = dd * __builtin_amdgcn_exp2f(mo - M); wb = __builtin_amdgcn_exp2f(mx - M); D = wa + den * wb; }
    const float inv = __builtin_amdgcn_rcpf(D);
#pragma unroll
    for (int c = 0; c < 4; ++c) { f32x4 o = oacc[c] * wb;
        if (pat > 0) { const u32x2 u = pv[c]; o[0] += wa * bflo(u.x); o[1] += wa * bfhi(u.x); o[2] += wa * bflo(u.y); o[3] += wa * bfhi(u.y); }
        u32x2 q; q.x = pk2(o[0] * inv, o[1] * inv); q.y = pk2(o[2] * inv, o[3] * inv); *(u32x2*)(op + 16 * c) = q; }
    if (pat < 2 && qd == 0) { st[0] = M; st[1] = D; }
    __syncthreads();
}

__device__ __forceinline__ void gla_load(const Params& p, int l, const bf16_t* prow  , int h, LAS float* qL, LAS float* kL, LAS float* bL, LAS float* lrL, LAS float* w2L) {
    const int tid = TIDX;
    if (tid < 128) { const int t = tid >> 1, c8 = (tid & 1) * 8; const u32x4 u = *(const u32x4*)(prow + (size_t)t * NP + C_GLR + c8); LAS float* d = lrL + t * 16 + c8;
        d[0] = bflo(u.x); d[1] = bfhi(u.x); d[2] = bflo(u.y); d[3] = bfhi(u.y); d[4] = bflo(u.z); d[5] = bfhi(u.z); d[6] = bflo(u.w); d[7] = bfhi(u.w); }
    { const int j = tid >> 5, c = tid & 31; w2L[tid] = p.gla_w_lr2[(size_t)l * 16 * 128 + j * 128 + h * 32 + c]; }
    if (tid < 32) w2L[512 + tid] = p.gla_b_lr[l * 128 + h * 32 + tid];
    { const int isk = tid >> 8, t = (tid & 255) >> 2, c8 = (tid & 3) * 8; const u32x4 u = *(const u32x4*)(prow + (size_t)t * NP + (isk ? C_GK : C_GQ) + h * 32 + c8);
        const float sc = isk ? 1.f : 0.17677669529663687f; LAS float* d = (isk ? kL : qL) + t * 33 + c8;
        d[0] = bflo(u.x) * sc; d[1] = bfhi(u.x) * sc; d[2] = bflo(u.y) * sc; d[3] = bfhi(u.y) * sc; d[4] = bflo(u.z) * sc; d[5] = bfhi(u.z) * sc; d[6] = bflo(u.w) * sc; d[7] = bfhi(u.w) * sc; }
    __syncthreads();
    for (int i = tid; i < 64 * 32; i += 512) { const int t = i >> 5, c = i & 31; float a = w2L[512 + c];
#pragma unroll
        for (int j = 0; j < 16; ++j) a += lrL[t * 16 + j] * w2L[j * 32 + c];
        bL[t * 33 + c] = -softplusf_(-a) * (1.4426950408889634f / 16.f); }
    __syncthreads();
    {
        const int wv = tid >> 6, ln = tid & 63;
#pragma unroll
        for (int q = 0; q < 4; ++q) { const int c = wv * 4 + q; float v = bL[ln * 33 + c];
#pragma unroll
            for (int o = 1; o < 64; o <<= 1) { const float u = __shfl_up(v, o); if (ln >= o) v += u; }
            bL[ln * 33 + c] = v; }
    }
    __syncthreads();
}
__device__ __forceinline__ void gla_a_task(const Params& p, int l, LAS unsigned char* lds, int task) {
    const int tid = TIDX, wave = tid >> 6, lane = tid & 63, ll = lane & 15, qd = lane >> 4, bh = task >> 8, ch = task & 255, b = bh >> 2, h = bh & 3;
    const bf16_t* prow = (const bf16_t*)(p.ws + OFF_B) + ((size_t)b * SEQ + ch * 64) * NP;
    LAS float* qL = (LAS float*)lds; LAS float* kL = qL + 64 * 33; LAS float* bL = kL + 64 * 33; LAS float* lrL = bL + 64 * 33; LAS float* w2L = lrL + 1024;
    LAS bf16_t* vt = (LAS bf16_t*)(w2L + 576);
    LAS bf16_t* kT = vt + 64 * 72;
    { const int tp = tid >> 4, c4 = (tid & 15) * 4;
      const u32x2 u0 = *(const u32x2*)(prow + (size_t)(2 * tp) * NP + C_GV + h * 64 + c4), u1 = *(const u32x2*)(prow + (size_t)(2 * tp + 1) * NP + C_GV + h * 64 + c4);
      *(LAS unsigned*)(vt + (c4 + 0) * 72 + 2 * tp) = (u0.x & 0xffffu) | (u1.x << 16); *(LAS unsigned*)(vt + (c4 + 1) * 72 + 2 * tp) = (u0.x >> 16) | (u1.x & 0xffff0000u);
      *(LAS unsigned*)(vt + (c4 + 2) * 72 + 2 * tp) = (u0.y & 0xffffu) | (u1.y << 16); *(LAS unsigned*)(vt + (c4 + 3) * 72 + 2 * tp) = (u0.y >> 16) | (u1.y & 0xffff0000u); }
    gla_load(p, l, prow, h, qL, kL, bL, lrL, w2L);
    { const int c = tid >> 4, t4 = (tid & 15) * 4; const float bl = bL[63 * 33 + c]; float kv[4];
#pragma unroll
      for (int e = 0; e < 4; ++e) kv[e] = kL[(t4 + e) * 33 + c] * __builtin_amdgcn_exp2f(bl - bL[(t4 + e) * 33 + c]);
      *(LAS unsigned*)(kT + c * 72 + t4) = pk2(kv[0], kv[1]); *(LAS unsigned*)(kT + c * 72 + t4 + 2) = pk2(kv[2], kv[3]); }
    __syncthreads();
    const int ct = wave >> 2, dt = wave & 3; f32x4 acc = {0.f, 0.f, 0.f, 0.f};
#pragma unroll
    for (int k2 = 0; k2 < 2; ++k2) acc = MFMA16(*(const LAS bf16x8*)(kT + (16 * ct + ll) * 72 + k2 * 32 + qd * 8), *(const LAS bf16x8*)(vt + (16 * dt + ll) * 72 + k2 * 32 + qd * 8), acc);
    float* U = (float*)(p.ws + OFF_GLAU) + (size_t)task * 2048;
#pragma unroll
    for (int r = 0; r < 4; ++r) U[(16 * ct + 4 * qd + r) * 64 + 16 * dt + ll] = acc[r];
    if (tid < 32) ((float*)(p.ws + OFF_GLAA))[(size_t)task * 32 + tid] = __builtin_amdgcn_exp2f(bL[63 * 33 + tid]);
    __syncthreads();
}
__device__ __forceinline__ void gla_scan_task(const Params& p, LAS unsigned char* lds, int task, unsigned* ready) {
    const int tid = TIDX, bh = task >> 2, qt = task & 3, e = qt * 512 + tid, cl = tid >> 6;
    float* U = (float*)(p.ws + OFF_GLAU) + (size_t)bh * 256 * 2048 + e;
    const float* A = (const float*)(p.ws + OFF_GLAA) + (size_t)bh * 256 * 32 + qt * 8;
    LAS float* aL = (LAS float*)lds;
#pragma unroll
    for (int k = 0; k < 4; ++k) { const int idx = tid + 512 * k; aL[idx] = A[(idx >> 3) * 32 + (idx & 7)]; }
    __syncthreads();
    float st = 0.f;
    for (int n0 = 0; n0 < 256; n0 += 16) {
        float u[16];
#pragma unroll
        for (int k = 0; k < 16; ++k) u[k] = U[(size_t)(n0 + k) * 2048];
#pragma unroll
        for (int k = 0; k < 16; ++k) { U[(size_t)(n0 + k) * 2048] = st; st = aL[(n0 + k) * 8 + cl] * st + u[k]; }
    }
    asm volatile("s_waitcnt vmcnt(0)" ::: "memory");
    __syncthreads();
    if (tid == 0) { __builtin_amdgcn_fence(__ATOMIC_RELEASE, "agent"); asm volatile("s_waitcnt vmcnt(0)" ::: "memory");
        __hip_atomic_fetch_add(ready, 1u, __ATOMIC_RELAXED, __HIP_MEMORY_SCOPE_AGENT); }
    __syncthreads();
}
__device__ __forceinline__ void gla_c_task(const Params& p, int l, LAS unsigned char* lds, int task, unsigned* ready) {
    const int tid = TIDX, wave = tid >> 6, lane = tid & 63, ll = lane & 15, qd = lane >> 4, bh = task >> 8, ch = task & 255, b = bh >> 2, h = bh & 3;
    if (tid == 0) {
        unsigned sp = 0; while (__hip_atomic_load(ready + bh, __ATOMIC_RELAXED, __HIP_MEMORY_SCOPE_AGENT) < 4u && ++sp < (1u << 24)) __builtin_amdgcn_s_sleep(2);
        __builtin_amdgcn_fence(__ATOMIC_ACQUIRE, "agent"); asm volatile("s_waitcnt vmcnt(0)" ::: "memory"); }
    __syncthreads();
    const bf16_t* prow = (const bf16_t*)(p.ws + OFF_B) + ((size_t)b * SEQ + ch * 64) * NP;
    LAS float* qL = (LAS float*)lds; LAS float* kL = qL + 64 * 33; LAS float* bL = kL + 64 * 33; LAS float* lrL = bL + 64 * 33; LAS float* w2L = lrL + 1024;
    LAS float* ssL = w2L + 576;
    LAS bf16_t* vt = (LAS bf16_t*)(ssL + 512);
    LAS bf16_t* sT = vt + 64 * 72;
    { const int tp = tid >> 4, c4 = (tid & 15) * 4;
      const u32x2 u0 = *(const u32x2*)(prow + (size_t)(2 * tp) * NP + C_GV + h * 64 + c4), u1 = *(const u32x2*)(prow + (size_t)(2 * tp + 1) * NP + C_GV + h * 64 + c4);
      *(LAS unsigned*)(vt + (c4 + 0) * 72 + 2 * tp) = (u0.x & 0xffffu) | (u1.x << 16); *(LAS unsigned*)(vt + (c4 + 1) * 72 + 2 * tp) = (u0.x >> 16) | (u1.x & 0xffff0000u);
      *(LAS unsigned*)(vt + (c4 + 2) * 72 + 2 * tp) = (u0.y & 0xffffu) | (u1.y << 16); *(LAS unsigned*)(vt + (c4 + 3) * 72 + 2 * tp) = (u0.y >> 16) | (u1.y & 0xffff0000u); }
    { const float* U = (const float*)(p.ws + OFF_GLAU) + (size_t)task * 2048; const int c = tid >> 4, d4 = (tid & 15) * 4; const f32x4 u = *(const f32x4*)(U + c * 64 + d4);
#pragma unroll
      for (int e = 0; e < 4; ++e) sT[(d4 + e) * 40 + c] = f2bf(u[e]); }
    const int I = wave >> 1, dh = wave & 1, t = 16 * I + ll;
    u32x2 rgl[2];
#pragma unroll
    for (int cc = 0; cc < 2; ++cc) rgl[cc] = *(const u32x2*)(prow + (size_t)t * NP + C_GR + h * 64 + 16 * (2 * dh + cc) + 4 * qd);
    gla_load(p, l, prow, h, qL, kL, bL, lrL, w2L);
    float qv[8], bt[8], rI[8];
#pragma unroll
    for (int e = 0; e < 8; ++e) { qv[e] = qL[t * 33 + 8 * qd + e]; bt[e] = bL[t * 33 + 8 * qd + e]; rI[e] = I > 0 ? bL[(16 * I - 1) * 33 + 8 * qd + e] : 0.f; }
    f32x4 qa, qb2, qc, qd2;
#pragma unroll
    for (int e = 0; e < 4; ++e) { qa[e] = qv[e] * __builtin_amdgcn_exp2f(bt[e] - rI[e]); qb2[e] = qv[4 + e] * __builtin_amdgcn_exp2f(bt[4 + e] - rI[4 + e]); qc[e] = qv[e] * __builtin_amdgcn_exp2f(bt[e]); qd2[e] = qv[4 + e] * __builtin_amdgcn_exp2f(bt[4 + e]); }
    const bf16x8 qfI = pk8(qa, qb2), qfin = pk8(qc, qd2);
    f32x4 at[4];
#pragma unroll
    for (int J = 0; J < 4; ++J) { at[J] = (f32x4){0.f, 0.f, 0.f, 0.f};
        if (J < I) { const int j = 16 * J + ll; f32x4 ka, kb2;
#pragma unroll
            for (int e = 0; e < 4; ++e) { ka[e] = kL[j * 33 + 8 * qd + e] * __builtin_amdgcn_exp2f(rI[e] - bL[j * 33 + 8 * qd + e]); kb2[e] = kL[j * 33 + 8 * qd + 4 + e] * __builtin_amdgcn_exp2f(rI[4 + e] - bL[j * 33 + 8 * qd + 4 + e]); }
            at[J] = MFMA16(pk8(ka, kb2), qfI, at[J]); } }
    {
        f32x4 dsum = {0.f, 0.f, 0.f, 0.f};
#pragma unroll 8
        for (int c = 0; c < 32; ++c) { const float q_ = qL[t * 33 + c], b_ = bL[t * 33 + c];
#pragma unroll
            for (int r = 0; r < 4; ++r) { const int j = 16 * I + 4 * qd + r; dsum[r] += q_ * kL[j * 33 + c] * __builtin_amdgcn_exp2f(fminf(b_ - bL[j * 33 + c], 0.f)); } }
#pragma unroll
        for (int r = 0; r < 4; ++r) dsum[r] = (4 * qd + r <= ll) ? dsum[r] : 0.f;
#pragma unroll
        for (int J = 0; J < 4; ++J) if (J == I) at[J] = dsum;
    }
    bf16x8 pf[2]; pf[0] = pk8(at[0], at[1]); pf[1] = pk8(at[2], at[3]);
    f32x4 oacc[2]; float ss = 0.f;
#pragma unroll
    for (int cc = 0; cc < 2; ++cc) { const int cg = 2 * dh + cc; f32x4 acc = {0.f, 0.f, 0.f, 0.f};
#pragma unroll
        for (int g2 = 0; g2 < 2; ++g2) { const LAS bf16_t* vr = vt + (16 * cg + ll) * 72 + 32 * g2 + 4 * qd; acc = MFMA16(mk8(*(const LAS u32x2*)vr, *(const LAS u32x2*)(vr + 16)), pf[g2], acc); }
        acc = MFMA16(*(const LAS bf16x8*)(sT + (16 * cg + ll) * 40 + 8 * qd), qfin, acc);
        oacc[cc] = acc; ss += acc[0] * acc[0] + acc[1] * acc[1] + acc[2] * acc[2] + acc[3] * acc[3]; }
    ssL[t * 8 + dh * 4 + qd] = ss;
    __syncthreads();
    float tot = 0.f;
#pragma unroll
    for (int e = 0; e < 8; ++e) tot += ssL[t * 8 + e];
    const float rstd = rsqrtf(tot * (1.f / 64.f) + EPS);
#pragma unroll
    for (int cc = 0; cc < 2; ++cc) { const int d = 16 * (2 * dh + cc) + 4 * qd;
        const u32x2 rg = rgl[cc];
        const float rr[4] = {bflo(rg.x), bfhi(rg.x), bflo(rg.y), bfhi(rg.y)}; float ov[4];
#pragma unroll
        for (int e = 0; e < 4; ++e) ov[e] = oacc[cc][e] * rstd * p.gla_norm_g[l * 64 + d + e] * rr[e] * sigmoidf_(rr[e]);
        u32x2 o; o.x = pk2(ov[0], ov[1]); o.y = pk2(ov[2], ov[3]);
        *(u32x2*)((bf16_t*)(p.ws + OFF_O) + ((size_t)b * SEQ + ch * 64 + t) * DM + O_GLA + h * 64 + d) = o; }
    __syncthreads();
}

__device__ __forceinline__ void dn_prep_task(const Params& p, int l, LAS unsigned char* lds, int task) {
    const int tid = TIDX, bh = task >> 8, ch = task & 255, b = bh >> 2, h = bh & 3, t0 = ch * 64;
    const bf16_t* pb = (const bf16_t*)(p.ws + OFF_B) + (size_t)b * SEQ * NP;
    LAS float* qn = (LAS float*)lds; LAS float* kn = qn + 64 * 65; LAS float* vv = kn + 64 * 65; LAS float* Lw = vv + 64 * 65; LAS float* X = Lw + 64 * 65;
    LAS float* Gc = X + 64 * 129; LAS float* be = Gc + 64;
    LAS bf16_t* qb = (LAS bf16_t*)(be + 64); LAS bf16_t* kb = qb + 64 * 72;
    bf16_t graw_a = 0, graw_b = 0;
    if (tid < 64) { const bf16_t* pr0 = pb + (size_t)(t0 + tid) * NP; graw_a = pr0[C_DA + h]; graw_b = pr0[C_DB + h]; }
    {
        LAS float* cwL = (LAS float*)(kb + 64 * 72);
        if (tid < 192) *(LAS f32x4*)(cwL + tid * 4) = *(const f32x4*)(p.dn_conv_w + ((size_t)l * 768 + (tid >> 6) * 256 + h * 64 + (tid & 63)) * 4);
        u32x4 xd[3][4];
#pragma unroll
        for (int it = 0; it < 3; ++it) { const int q = tid + 512 * it, t = q / 24, cc8 = (q % 24) * 8, chg = (cc8 >> 6) * 256 + h * 64 + (cc8 & 63);
#pragma unroll
            for (int i = 0; i < 4; ++i) { const int tt = t0 + t - 3 + i; xd[it][i] = tt >= 0 ? *(const u32x4*)(pb + (size_t)tt * NP + C_DQKV + chg) : (u32x4){0u, 0u, 0u, 0u}; } }
        __syncthreads();
#pragma unroll
        for (int it = 0; it < 3; ++it) { const int q = tid + 512 * it, t = q / 24, cc8 = (q % 24) * 8, sec = cc8 >> 6, c = cc8 & 63;
            float acc[8];
#pragma unroll
            for (int e = 0; e < 8; ++e) acc[e] = 0.f;
#pragma unroll
            for (int i = 0; i < 4; ++i) { const u32x4 u = xd[it][i]; const float xs[8] = {bflo(u.x), bfhi(u.x), bflo(u.y), bfhi(u.y), bflo(u.z), bfhi(u.z), bflo(u.w), bfhi(u.w)};
#pragma unroll
                for (int e = 0; e < 8; ++e) acc[e] += cwL[(cc8 + e) * 4 + i] * xs[e]; }
            LAS float* dst = (sec == 0 ? qn : (sec == 1 ? kn : vv)) + t * 65 + c;
#pragma unroll
            for (int e = 0; e < 8; ++e) dst[e] = acc[e] * sigmoidf_(acc[e]); }
    }
    __syncthreads();
    { LAS float* row = ((tid >> 2) < 64 ? qn : kn) + ((tid >> 2) & 63) * 65 + (tid & 3) * 16; float ss = 0.f;
#pragma unroll
        for (int c = 0; c < 16; ++c) ss += row[c] * row[c];
        ss += __shfl_xor(ss, 1); ss += __shfl_xor(ss, 2);
        const float sc = rsqrtf(ss + EPS) * ((tid >> 2) < 64 ? 0.125f : 1.f);
        LAS bf16_t* rb = ((tid >> 2) < 64 ? qb : kb) + ((tid >> 2) & 63) * 72 + (tid & 3) * 16;
#pragma unroll
        for (int c = 0; c < 16; c += 2) { const float v0 = row[c] * sc, v1 = row[c + 1] * sc; row[c] = v0; row[c + 1] = v1; *(LAS unsigned*)(rb + c) = pk2(v0, v1); } }
    if (tid < 64) {
        be[tid] = sigmoidf_(bf2f(graw_b));
        float g = -__expf(p.dn_a_log[l * 4 + h]) * softplusf_(bf2f(graw_a) + p.dn_dt_bias[l * 4 + h]);
#pragma unroll
        for (int o = 1; o < 64; o <<= 1) { const float v = __shfl_up(g, o); if (tid >= o) g += v; }
        Gc[tid] = g; }
    __syncthreads();
    bf16_t* ob = (bf16_t*)(p.ws + OFF_DN) + (size_t)task * 5 * 4096;
    {
        const int wave = tid >> 6, lane = tid & 63, ll = lane & 15, qd = lane >> 4, ti = wave >> 1;
#pragma unroll
        for (int tt = 0; tt < 2; ++tt) { const int tj = (wave & 1) * 2 + tt;
            f32x4 ck = {0.f, 0.f, 0.f, 0.f}, cs = {0.f, 0.f, 0.f, 0.f};
            if (tj <= ti) {
#pragma unroll
                for (int k2 = 0; k2 < 2; ++k2) {
                    const bf16x8 ki = *(const LAS bf16x8*)(kb + (16 * ti + ll) * 72 + k2 * 32 + qd * 8), kj = *(const LAS bf16x8*)(kb + (16 * tj + ll) * 72 + k2 * 32 + qd * 8);
                    const bf16x8 qi = *(const LAS bf16x8*)(qb + (16 * ti + ll) * 72 + k2 * 32 + qd * 8);
                    ck = MFMA16(ki, kj, ck);
                    cs = MFMA16(kj, qi, cs);
                } }
#pragma unroll
            for (int r = 0; r < 4; ++r) { const int i = 16 * ti + 4 * qd + r, j = 16 * tj + ll;
                Lw[i * 65 + j] = j < i ? be[i] * ck[r] * __expf(Gc[i] - Gc[j]) : 0.f; }
            { const int i = 16 * ti + ll; float sv[4];
#pragma unroll
              for (int r = 0; r < 4; ++r) { const int j = 16 * tj + 4 * qd + r; sv[r] = j <= i ? cs[r] * __expf(Gc[i] - Gc[j]) : 0.f; }
              u32x2 o; o.x = pk2(sv[0], sv[1]); o.y = pk2(sv[2], sv[3]); *(u32x2*)(ob + 4 * 4096 + i * 64 + 16 * tj + 4 * qd) = o; }
        }
    }
    for (int idx = tid; idx < 4096; idx += 512) { const int i = idx >> 6, j = idx & 63;
        X[i * 129 + j] = vv[i * 65 + j] * be[i]; X[i * 129 + 64 + j] = kn[i * 65 + j] * be[i] * __expf(Gc[i]); }
    __syncthreads();
    {
        const int col = tid >> 2, part = tid & 3;
        float xr[16];
#pragma unroll
        for (int k = 0; k < 16; ++k) xr[k] = 0.f;
#pragma unroll
        for (int i = 0; i < 64; ++i) { float s0 = 0.f, s1 = 0.f;
#pragma unroll
            for (int k = 0; k < (i + 3) / 4; ++k) { const float t_ = Lw[i * 65 + 4 * k + part] * xr[k]; if (k & 1) s1 += t_; else s0 += t_; }
            s0 += s1; s0 += __shfl_xor(s0, 1); s0 += __shfl_xor(s0, 2);
            const float xi = X[i * 129 + col] - s0;
            if (part == (i & 3)) xr[i >> 2] = xi; }
#pragma unroll
        for (int k = 0; k < 16; ++k) X[(4 * k + part) * 129 + col] = xr[k];
    }
    __syncthreads();
    const float Gl = Gc[63];
    for (int i2 = tid; i2 < 2048; i2 += 512) { const int a = i2 >> 5, c = (i2 & 31) * 2;
        *(unsigned*)(ob + 0 * 4096 + a * 64 + c) = pk2(X[a * 129 + 64 + c], X[a * 129 + 65 + c]);
        *(unsigned*)(ob + 1 * 4096 + a * 64 + c) = pk2(kn[c * 65 + a] * __expf(Gl - Gc[c]), kn[(c + 1) * 65 + a] * __expf(Gl - Gc[c + 1]));
        *(unsigned*)(ob + 2 * 4096 + a * 64 + c) = pk2(X[c * 129 + a], X[(c + 1) * 129 + a]);
        const float eg = __expf(Gc[a]);
        *(unsigned*)(ob + 3 * 4096 + a * 64 + c) = pk2(qn[a * 65 + c] * eg, qn[a * 65 + c + 1] * eg); }
    if (tid == 0) ((float*)(p.ws + OFF_DNA))[task] = __expf(Gl);
    __syncthreads();
}
__device__ __forceinline__ void dn_scan_task(const Params& p, int l, LAS unsigned char* lds, int task) {
    constexpr int RS = 72, MATB = 64 * RS * 2  , STG = 4 * MATB + 16 * RS * 2;
    const int tid = TIDX, wave = tid >> 6, lane = tid & 63, ll = lane & 15, qd = lane >> 4, bh = task >> 2, b = bh >> 2, h = bh & 3;
    const bf16_t* cb = (const bf16_t*)(p.ws + OFF_DN) + (size_t)bh * 256 * 5 * 4096;
    const float* al = (const float*)(p.ws + OFF_DNA) + bh * 256;
    const int lrow = tid >> 3, lc8 = tid & 7;
    LAS float* alL = (LAS float*)(lds + 3 * STG);
    if (tid < 256) alL[tid] = al[tid];
    u32x4 pre[3][5];
    const int d0 = (task & 3) * 16;
#define DN_ISSUE(n, st) do { const int n_ = (n) < 255 ? (n) : 255; _Pragma("unroll") for (int m_ = 0; m_ < 4; ++m_) pre[st][m_] = *(const u32x4*)(cb + ((size_t)n_ * 5 + (m_ < 2 ? m_ : m_ + 1)) * 4096 + tid * 8); \
        pre[st][4] = *(const u32x4*)(cb + ((size_t)n_ * 5 + 2) * 4096 + d0 * 64 + (tid & 127) * 8); } while (0)
#define DN_COMMIT(st) do { LAS unsigned char* sb_ = lds + (st) * STG; _Pragma("unroll") for (int m_ = 0; m_ < 4; ++m_) *(LAS u32x4*)(sb_ + m_ * MATB + lrow * (RS * 2) + lc8 * 16) = pre[st][m_]; \
        if (tid < 128) *(LAS u32x4*)(sb_ + 4 * MATB + lrow * (RS * 2) + lc8 * 16) = pre[st][4]; } while (0)
    DN_ISSUE(0, 0); DN_ISSUE(1, 1); DN_COMMIT(0); DN_COMMIT(1); DN_ISSUE(2, 2); DN_ISSUE(3, 0); DN_ISSUE(4, 1);
    f32x4 S[4];
#pragma unroll
    for (int m = 0; m < 4; ++m) S[m] = (f32x4){0.f, 0.f, 0.f, 0.f};
    __syncthreads();
#define DN_FRAG(mat, mt, k2) ({ const LAS bf16_t* _r = (const LAS bf16_t*)(sb + (mat) * MATB) + (16 * (mt) + ll) * RS + 32 * (k2) + 4 * qd; mk8(*(const LAS u32x2*)_r, *(const LAS u32x2*)(_r + 16)); })
#define DN_STEP(n, st) do { \
        DN_COMMIT(((st) + 2) % 3); \
        DN_ISSUE((n) + 5, ((st) + 2) % 3); \
        if (wave < 1) { \
            const LAS unsigned char* sb = lds + (st) * STG; \
              \
            u32x2 uc[4]; bf16x8 fw[4][2], fk[4][2], fq[4][2], fs[4][2]; \
            _Pragma("unroll") for (int m = 0; m < 4; ++m) _Pragma("unroll") for (int k2 = 0; k2 < 2; ++k2) fw[m][k2] = DN_FRAG(0, m, k2); \
            _Pragma("unroll") for (int m = 0; m < 4; ++m) uc[m] = *(const LAS u32x2*)((const LAS bf16_t*)(sb + 4 * MATB) + ll * RS + 16 * m + 4 * qd); \
            _Pragma("unroll") for (int m = 0; m < 4; ++m) _Pragma("unroll") for (int k2 = 0; k2 < 2; ++k2) fk[m][k2] = DN_FRAG(1, m, k2); \
            const float a = alL[n]; \
            __builtin_amdgcn_sched_barrier(0); \
            bf16x8 Sb[2], Vb[2]; \
            Sb[0] = pk8(S[0], S[1]); Sb[1] = pk8(S[2], S[3]); \
            f32x4 vn[4], oo[4]; \
            _Pragma("unroll") for (int m = 0; m < 4; ++m) { f32x4 acc = {0.f, 0.f, 0.f, 0.f}; \
                _Pragma("unroll") for (int k2 = 0; k2 < 2; ++k2) acc = MFMA16(fw[m][k2], Sb[k2], acc); \
                vn[m][0] = bflo(uc[m].x) - acc[0]; vn[m][1] = bfhi(uc[m].x) - acc[1]; vn[m][2] = bflo(uc[m].y) - acc[2]; vn[m][3] = bfhi(uc[m].y) - acc[3]; } \
            Vb[0] = pk8(vn[0], vn[1]); Vb[1] = pk8(vn[2], vn[3]); \
            _Pragma("unroll") for (int m = 0; m < 4; ++m) _Pragma("unroll") for (int k2 = 0; k2 < 2; ++k2) { fq[m][k2] = DN_FRAG(2, m, k2); fs[m][k2] = DN_FRAG(3, m, k2); } \
            __builtin_amdgcn_sched_barrier(0); \
            _Pragma("unroll") for (int m = 0; m < 4; ++m) { f32x4 acc = S[m] * a; \
                _Pragma("unroll") for (int k2 = 0; k2 < 2; ++k2) acc = MFMA16(fk[m][k2], Vb[k2], acc); \
                S[m] = acc; } \
            _Pragma("unroll") for (int m = 0; m < 4; ++m) { f32x4 acc = {0.f, 0.f, 0.f, 0.f};   \
                _Pragma("unroll") for (int k2 = 0; k2 < 2; ++k2) { acc = MFMA16(Sb[k2], fq[m][k2], acc); acc = MFMA16(Vb[k2], fs[m][k2], acc); } \
                oo[m] = acc; } \
            bf16_t* op = (bf16_t*)(p.ws + OFF_O) + ((size_t)b * SEQ + (n) * 64 + ll) * DM + O_DN + h * 64 + d0 + 4 * qd; \
            _Pragma("unroll") for (int m = 0; m < 4; ++m) { u32x2 o; o.x = pk2(oo[m][0], oo[m][1]); o.y = pk2(oo[m][2], oo[m][3]); *(u32x2*)(op + (size_t)(16 * m) * DM) = o; } \
        } \
        __syncthreads(); \
    } while (0)
    for (int n = 0; n < 255; n += 3) { DN_STEP(n, 0); DN_STEP(n + 1, 1); DN_STEP(n + 2, 2); }
    DN_STEP(255, 0);
#undef DN_STEP
#undef DN_FRAG
#undef DN_ISSUE
#undef DN_COMMIT
}
__device__ __forceinline__ void dn_norm_task(const Params& p, int l, int task8) {
    const int tid = TIDX, d8 = (tid & 7) * 8;
    u32x4 uu[8], gg[8];
#pragma unroll
    for (int sub = 0; sub < 8; ++sub) { const int pair = (task8 * 8 + sub) * 64 + (tid >> 3), tok = pair >> 2, h = pair & 3;
        uu[sub] = *(const u32x4*)((const bf16_t*)(p.ws + OFF_O) + (size_t)tok * DM + O_DN + h * 64 + d8);
        gg[sub] = *(const u32x4*)((const bf16_t*)(p.ws + OFF_B) + (size_t)tok * NP + C_DG + h * 64 + d8); }
    float gn[8];
#pragma unroll
    for (int e = 0; e < 8; ++e) gn[e] = p.dn_norm_g[l * 64 + d8 + e];
#pragma unroll
    for (int sub = 0; sub < 8; ++sub) { const int pair = (task8 * 8 + sub) * 64 + (tid >> 3), tok = pair >> 2, h = pair & 3;
        const u32x4 u = uu[sub], gt = gg[sub];
        const float ov[8] = {bflo(u.x), bfhi(u.x), bflo(u.y), bfhi(u.y), bflo(u.z), bfhi(u.z), bflo(u.w), bfhi(u.w)};
        const float gv[8] = {bflo(gt.x), bfhi(gt.x), bflo(gt.y), bfhi(gt.y), bflo(gt.z), bfhi(gt.z), bflo(gt.w), bfhi(gt.w)};
        float ss = 0.f;
#pragma unroll
        for (int e = 0; e < 8; ++e) ss += ov[e] * ov[e];
        ss += __shfl_xor(ss, 1); ss += __shfl_xor(ss, 2); ss += __shfl_xor(ss, 4);
        const float rstd = rsqrtf(ss * (1.f / 64.f) + EPS);
        float r[8];
#pragma unroll
        for (int e = 0; e < 8; ++e) r[e] = ov[e] * rstd * gn[e] * gv[e] * sigmoidf_(gv[e]);
        u32x4 o; o.x = pk2(r[0], r[1]); o.y = pk2(r[2], r[3]); o.z = pk2(r[4], r[5]); o.w = pk2(r[6], r[7]);
        *(u32x4*)((bf16_t*)(p.ws + OFF_O) + (size_t)tok * DM + O_DN + h * 64 + d8) = o; }
}

__device__ __forceinline__ int next_task(int* cnt, LAS int* slot, int& pre) {
    __syncthreads();
    if (TIDX == 0) *slot = pre;
    __syncthreads();
    const int t = __builtin_amdgcn_readfirstlane(*slot);
    if (TIDX == 0) pre = atomicAdd(cnt, 1);
    return t;
}
__device__ __forceinline__ void mix_phase(const Params& p, int l, int k, LAS unsigned char* lds) {
    int* cnt = (int*)(p.ws + OFF_CNT) + l * 3 + k;
    LAS int* slot = (LAS int*)(lds + LDS_BYTES + 16);
    int pre = 0; if (TIDX == 0) pre = atomicAdd(cnt, 1);
    unsigned* gready = (unsigned*)(p.ws + OFF_CNT) + 32 + l * 8;
    if (k == 0) {
        for (;;) { int t = next_task(cnt, slot, pre);
            if (t < 2048) { dn_prep_task(p, l, lds, t); continue; } t -= 2048;
            if (t < 1024) { dil_task(p, l, lds, 0, t); continue; } t -= 1024;
            if (t < 2048) { gla_a_task(p, l, lds, t); continue; }
            break; }
    } else if (k == 1) {
        for (;;) { int t = next_task(cnt, slot, pre);
            if (t < 32) { dn_scan_task(p, l, lds, t); continue; } t -= 32;
            if (t < 32) { gla_scan_task(p, lds, t, gready + (t >> 2)); continue; } t -= 32;
            if (t < 1024) { sb_task(p, l, lds, t); continue; } t -= 1024;
            if (t < 1024) { dil_task(p, l, lds, 1, t); continue; } t -= 1024;
            if (t < 2048) { gla_c_task(p, l, lds, t, gready); continue; }
            break; }
    } else {
        for (;;) { int t = next_task(cnt, slot, pre);
            if (t < 1024) { dil_task(p, l, lds, 2, t); continue; } t -= 1024;
            if (t < 256) { dn_norm_task(p, l, t); continue; }
            break; }
    }
}

#define XB_TMO      128
#define XB_XCNT(j)  (256  + 64 * (j))
#define XB_XSUB(j)  (1280 + 64 * (j))
#define XB_XGEN(j)  (2304 + 64 * (j))
#define XB_TOP      3328
#define XB_TOPGEN   3392
#define XCD_BAR_WORDS 3456
#define XB_SPIN_CAP (1u << 22)
__device__ __forceinline__ unsigned xb_ld(unsigned* p)              { return __hip_atomic_load(p, __ATOMIC_RELAXED, __HIP_MEMORY_SCOPE_AGENT); }
__device__ __forceinline__ unsigned xb_add(unsigned* p, unsigned v) { return __hip_atomic_fetch_add(p, v, __ATOMIC_RELAXED, __HIP_MEMORY_SCOPE_AGENT); }
__device__ __forceinline__ unsigned xb_xcc_id() { return (unsigned)__builtin_amdgcn_s_getreg((3 << 11) | 20) & 0xFu; }
#define XB_SPIN(cond, bar) do { unsigned _sp = 0; while (cond) { __builtin_amdgcn_s_sleep(1); \
    if ((++_sp & 255u) == 0u) { if (xb_ld(&(bar)[XB_TMO])) break; if (_sp > XB_SPIN_CAP) { atomicAdd(&(bar)[XB_TMO], 1u); break; } } } } while (0)
struct XcdBarrier { unsigned* bar; unsigned x; volatile LAS unsigned* st; };
__device__ __forceinline__ XcdBarrier xcd_barrier_post(unsigned* bar, volatile LAS unsigned* st) {
    XcdBarrier b; b.bar = bar; b.x = xb_xcc_id(); b.st = st;
    if (TIDX == 0) (void)xb_add(&bar[XB_XCNT(b.x)], 1u);
    return b;
}
__device__ __forceinline__ void xcd_barrier_complete(unsigned* bar, unsigned x, unsigned& nloc, unsigned& nx) {
    const unsigned G = gridDim.x * gridDim.y * gridDim.z;
    unsigned sum, cnt, mine, sp = 0u;
    for (;;) {
        sum = 0u; cnt = 0u; mine = 0u;
#pragma unroll
        for (unsigned j = 0; j < 16; ++j) { const unsigned c = xb_ld(&bar[XB_XCNT(j)]); sum += c; cnt += (c > 0u) ? 1u : 0u; mine = (j == x) ? c : mine; }
        if (sum == G) break;
        __builtin_amdgcn_s_sleep(1);
        if ((++sp & 255u) == 0u) { if (xb_ld(&bar[XB_TMO])) break; if (sp > XB_SPIN_CAP) { atomicAdd(&bar[XB_TMO], 1u); break; } }
    }
    nloc = mine > 0u ? mine : 1u; nx = cnt > 0u ? cnt : 1u;
}
__device__ __forceinline__ void xcd_barrier(const XcdBarrier& b) {
    asm volatile("s_waitcnt vmcnt(0)" ::: "memory");
    __syncthreads();
    if (TIDX == 0) {
        unsigned* bar = b.bar;
        __builtin_amdgcn_s_waitcnt(0);
        unsigned nloc = b.st[0], nx = b.st[1];
        if (nloc == 0u) { xcd_barrier_complete(bar, b.x, nloc, nx); b.st[0] = nloc; b.st[1] = nx; }
        const unsigned old = xb_add(&bar[XB_XSUB(b.x)], 1u);
        const unsigned gen = old / nloc;
        if (old + 1u == (gen + 1u) * nloc) {
            __builtin_amdgcn_fence(__ATOMIC_RELEASE, "agent");
            asm volatile("s_waitcnt vmcnt(0)" ::: "memory");
            const unsigned og = xb_add(&bar[XB_TOP], 1u);
            const unsigned tg = og / nx;
            if (og + 1u == (tg + 1u) * nx) xb_add(&bar[XB_TOPGEN], 1u);
            else XB_SPIN(xb_ld(&bar[XB_TOPGEN]) == tg, bar);
            __builtin_amdgcn_fence(__ATOMIC_ACQUIRE, "agent");
            xb_add(&bar[XB_XGEN(b.x)], 1u);
            asm volatile("s_waitcnt vmcnt(0)" ::: "memory");
        } else {
            XB_SPIN(xb_ld(&bar[XB_XGEN(b.x)]) == gen, bar);
            __builtin_amdgcn_fence(__ATOMIC_ACQUIRE, "agent");
            asm volatile("s_waitcnt vmcnt(0)" ::: "memory");
        }
    }
    __syncthreads();
}

__global__ void __launch_bounds__(512) fwd_kernel(Params p) {
    extern __shared__ __attribute__((aligned(16))) unsigned char shm[];
    LAS unsigned char* lds = (LAS unsigned char*)shm;
    cg::grid_group grid = cg::this_grid();
    unsigned char* ws = p.ws;
    volatile LAS unsigned* bst = (volatile LAS unsigned*)(lds + LDS_BYTES);
    if (TIDX < 2) bst[TIDX] = 0u;
    __syncthreads();
    XcdBarrier gbar; gbar.bar = (unsigned*)(ws + OFF_BAR); gbar.x = 0; gbar.st = bst;
    if (p.ph_hi - p.ph_lo > 1) gbar = xcd_barrier_post((unsigned*)(ws + OFF_BAR), bst);
    if (p.ph_hi > 1000000) grid.sync();
    for (int ph = p.ph_lo; ph < p.ph_hi; ++ph) {
        const int l = ph / NPH, k = ph % NPH;
        const float* xin = (l == 0) ? p.x : p.out;
        if (k == 0) {
            wconv_phase(p, l, lds);
            rmsnorm_phase(xin, p.g_mix + l * DM, (bf16_t*)(ws + OFF_H));
        } else if (k == 8) {
            rmsnorm_phase(p.out, p.g_mlp + l * DM, (bf16_t*)(ws + OFF_H));
        } else if (k >= 2 && k <= 4) {
            mix_phase(p, l, k - 2, lds);
        } else {
            pg8::Epi E; E.mode = 0; E.O = (bf16_t*)(ws + OFF_B); E.ldc = NP; E.Xin = xin; E.Xout = p.out; E.Y = (const bf16_t*)(ws + OFF_B);
            const bf16_t* A = (const bf16_t*)(ws + OFF_H); const bf16_t* Bt = (const bf16_t*)(ws + OFF_WIN); int lda = DM, a_sh = 0, a_mul = 0, N = NP, K = DM;
            if (k == 5) { E.ldc = 4096; A = (const bf16_t*)(ws + OFF_O); a_sh = 2; a_mul = 256; Bt = (const bf16_t*)(ws + OFF_WB); N = 4096; K = 256; }
            else if (k == 6) { E.mode = 3; E.O = (bf16_t*)(ws + OFF_O); Bt = (const bf16_t*)(ws + OFF_WG); N = 4096; }
            else if (k == 7) { E.mode = 2; A = (const bf16_t*)(ws + OFF_O); Bt = (const bf16_t*)(ws + OFF_WO); N = DM; }
            else if (k == 9) { E.mode = 1; E.ldc = DFF; Bt = (const bf16_t*)(ws + OFF_W1); N = DFF; }
            else if (k == 10) { E.mode = 2; E.Xin = p.out; A = (const bf16_t*)(ws + OFF_B); lda = DFF; Bt = (const bf16_t*)(ws + OFF_W2); N = DM; K = DFF; }
            run_gemm(lds, A, lda, a_sh, a_mul, Bt, N, K, E);
        }
        if (ph + 1 < p.ph_hi) xcd_barrier(gbar);
    }
}

#ifndef ONE_LAUNCH
#define ONE_LAUNCH 1
#endif
extern "C" void kernel_launch(void* const* d_in, const int* in_sizes, int n_in, void* d_out, int out_size, void* d_ws, size_t ws_size, hipStream_t stream) {
    static int grid = 0;
    if (grid == 0) {
        if (n_in != 17 || out_size != T_TOK * DM || ws_size < WS_END) { fprintf(stderr, "kernel_launch: unexpected shapes / workspace (%zu < %zu)\n", ws_size, (size_t)WS_END); grid = -1; return; }
        int dev = 0, cus = 0, per_cu = 0;
        hipGetDevice(&dev); hipDeviceGetAttribute(&cus, hipDeviceAttributeMultiprocessorCount, dev);
        if (hipFuncSetAttribute((const void*)fwd_kernel, hipFuncAttributeMaxDynamicSharedMemorySize, LDS_TOTAL) != hipSuccess) { fprintf(stderr, "hipFuncSetAttribute failed\n"); grid = -1; return; }
        if (hipOccupancyMaxActiveBlocksPerMultiprocessor(&per_cu, (const void*)fwd_kernel, 512, LDS_TOTAL) != hipSuccess || per_cu < 1) per_cu = 1;
        grid = cus * per_cu;
    }
    if (grid < 0) return;
    Params p{};
    p.x = (const float*)d_in[0]; p.g_mix = (const float*)d_in[1]; p.g_mlp = (const float*)d_in[2]; p.w_in = (const float*)d_in[3]; p.gla_w_lr2 = (const float*)d_in[4];
    p.gla_b_lr = (const float*)d_in[5]; p.gla_norm_g = (const float*)d_in[6]; p.dn_conv_w = (const float*)d_in[7]; p.dn_a_log = (const float*)d_in[8]; p.dn_dt_bias = (const float*)d_in[9];
    p.dn_norm_g = (const float*)d_in[10]; p.dil_q_g = (const float*)d_in[11]; p.dil_k_g = (const float*)d_in[12]; p.w_branch = (const float*)d_in[13]; p.w_out = (const float*)d_in[14];
    p.w_mlp_in = (const float*)d_in[15]; p.w_mlp_out = (const float*)d_in[16]; p.out = (float*)d_out; p.ws = (unsigned char*)d_ws;
    if (hipMemsetAsync((char*)d_ws + OFF_CNT, 0, 256 + 16384, stream) != hipSuccess) { fprintf(stderr, "memset failed\n"); return; }
#if ONE_LAUNCH
    p.ph_lo = 0; p.ph_hi = NLAYER * NPH;
    void* args[] = {&p};
    hipError_t e = hipLaunchCooperativeKernel((const void*)fwd_kernel, dim3(grid), dim3(512), args, LDS_TOTAL, stream);
    if (e != hipSuccess) fprintf(stderr, "cooperative launch failed: %s (grid %d)\n", hipGetErrorString(e), grid);
#else
    for (int ph = 0; ph < NLAYER * NPH; ++ph) { p.ph_lo = ph; p.ph_hi = ph + 1; hipLaunchKernelGGL(fwd_kernel, dim3(grid), dim3(512), LDS_TOTAL, stream, p); }
#endif
}
```
